# Optimizing an MI355X kernel written in HIP

```python
import math
import jax, jax.numpy as jnp
from jax import lax
import numpy as np

D_MODEL = 2048
BATCH = 1
SEQ = 16384
DEPTH = 4

HEAD_DIM = 128
N_HEADS_A = D_MODEL // HEAD_DIM
N_HEADS_B = D_MODEL // HEAD_DIM
N_KV_GROUPS = 4
HEADS_PER_GROUP = N_HEADS_B // N_KV_GROUPS
D_FF = 4 * D_MODEL
N_A_LAYERS = DEPTH // 2
N_B_LAYERS = DEPTH - N_A_LAYERS
Q_BLOCK = 128
CMP_BLOCK = 32
CMP_STRIDE = 16
CMP_HIDDEN = 256
SEL_BLOCK = 64
N_SELECTED = 16
SEL_RATIO = SEL_BLOCK // CMP_STRIDE
WINDOW = 512
N_BUCKETS = 32
REL_MAX_DIST = 2048
ALPHA = (2.0 * DEPTH) ** 0.25
BETA = (8.0 * DEPTH) ** -0.25
LN_EPS = 1e-5
FORCED_SCORE = 1e4
NEG_BIG = -1e30

kernel_name = "yoco_fox_nsa_deepnorm_trunk"


def layer_norm(x, g, b):
    xf = x.astype(jnp.float32)
    mu = jnp.mean(xf, axis=-1, keepdims=True)
    var = jnp.mean(jnp.square(xf - mu), axis=-1, keepdims=True)
    y = (xf - mu) * lax.rsqrt(var + LN_EPS)
    return (y * g + b).astype(x.dtype)


def masked_softmax(logits, mask):
    logits = jnp.where(mask, logits, NEG_BIG)
    m = jnp.max(logits, axis=-1, keepdims=True)
    e = jnp.where(mask, jnp.exp(logits - m), 0.0)
    return e / jnp.maximum(jnp.sum(e, axis=-1, keepdims=True), 1e-30)


def rel_bucket(dist):
    n = jnp.maximum(dist, 0)
    exact = N_BUCKETS // 2
    nf = jnp.maximum(n, 1).astype(jnp.float32)
    large = exact + (jnp.log(nf / exact) / math.log(REL_MAX_DIST / exact) * (N_BUCKETS - exact)).astype(jnp.int32)
    large = jnp.minimum(large, N_BUCKETS - 1)
    return jnp.where(n < exact, n, large)


def sq_relu_mlp(x, w1, w2):
    return jnp.square(jax.nn.relu(x @ w1)) @ w2


def fox_attention(x, w_in, b_f, w_o):
    B, S, _ = x.shape
    H, dh = N_HEADS_A, HEAD_DIM
    proj = x @ w_in
    q = proj[..., :H * dh].reshape(B, S, H, dh).transpose(0, 2, 1, 3) * (dh ** -0.5)
    k = proj[..., H * dh:2 * H * dh].reshape(B, S, H, dh).transpose(0, 2, 1, 3)
    v = proj[..., 2 * H * dh:3 * H * dh].reshape(B, S, H, dh).transpose(0, 2, 1, 3)
    log_f = jax.nn.log_sigmoid((proj[..., 3 * H * dh:] + b_f).astype(jnp.float32))
    cum = jnp.cumsum(log_f, axis=1).transpose(0, 2, 1)
    key_pos = jnp.arange(S)

    def block(i):
        t0 = i * Q_BLOCK
        t = t0 + jnp.arange(Q_BLOCK)
        qb = lax.dynamic_slice_in_dim(q, t0, Q_BLOCK, axis=2)
        cb = lax.dynamic_slice_in_dim(cum, t0, Q_BLOCK, axis=2)
        logits = jnp.einsum('bhqd,bhkd->bhqk', qb, k).astype(jnp.float32) + (cb[..., :, None] - cum[..., None, :])
        p = masked_softmax(logits, key_pos[None, :] <= t[:, None])
        o = jnp.einsum('bhqk,bhkd->bqhd', p.astype(v.dtype), v)
        return o.reshape(B, Q_BLOCK, H * dh)

    out = lax.map(block, jnp.arange(S // Q_BLOCK))
    out = out.transpose(1, 0, 2, 3).reshape(B, S, H * dh)
    return out @ w_o


def compress_blocks(kv_raw, pos, w1, w2):
    B, G, S, dh = kv_raw.shape
    chunks = kv_raw.reshape(B, G, S // CMP_STRIDE, CMP_STRIDE, dh)
    blocks = jnp.concatenate([chunks[:, :, :-1], chunks[:, :, 1:]], axis=3) + pos
    flat = blocks.reshape(B, G, blocks.shape[2], CMP_BLOCK * dh)
    return jax.nn.gelu(flat @ w1) @ w2


def shared_kv(h, kv_w, cmp_pos_k, cmp_pos_v, cmp_k_w1, cmp_k_w2, cmp_v_w1, cmp_v_w2):
    B, S, _ = h.shape
    kv = (h @ kv_w).reshape(B, S, 6, N_KV_GROUPS, HEAD_DIM).transpose(2, 0, 3, 1, 4)
    k_cmp = compress_blocks(kv[0], cmp_pos_k, cmp_k_w1, cmp_k_w2)
    v_cmp = compress_blocks(kv[1], cmp_pos_v, cmp_v_w1, cmp_v_w2)
    return k_cmp, v_cmp, kv[2], kv[3], kv[4], kv[5]


def nsa_attention(x, w_in, w_o, rel_bias, k_cmp, v_cmp, k_sel, v_sel, k_win, v_win):
    B, S, _ = x.shape
    H, G, R, dh = N_HEADS_B, N_KV_GROUPS, HEADS_PER_GROUP, HEAD_DIM
    proj = x @ w_in
    q = proj[..., :H * dh].reshape(B, S, G, R, dh).transpose(0, 2, 3, 1, 4) * (dh ** -0.5)
    gates = jax.nn.sigmoid(proj[..., H * dh:].astype(jnp.float32)).reshape(B, S, H, 3).astype(x.dtype)
    n_cmp = k_cmp.shape[2]
    n_sel_blocks = S // SEL_BLOCK
    n_top = min(N_SELECTED, n_sel_blocks)
    table = rel_bias.T.reshape(G, R, N_BUCKETS)
    cmp_end = jnp.arange(n_cmp) * CMP_STRIDE + CMP_BLOCK - 1
    k_win_p = jnp.pad(k_win, ((0, 0), (0, 0), (WINDOW, 0), (0, 0)))
    v_win_p = jnp.pad(v_win, ((0, 0), (0, 0), (WINDOW, 0), (0, 0)))
    b_idx = jnp.arange(B)[:, None, None, None]
    g_idx = jnp.arange(G)[:, None, None, None][None]
    g_idx = g_idx.reshape(1, G, 1, 1)
    gi = jnp.arange(G).reshape(1, G, 1, 1, 1)
    ri = jnp.arange(R).reshape(1, 1, R, 1, 1)
    j_blk = jnp.arange(n_sel_blocks)

    def block(i):
        t0 = i * Q_BLOCK
        t = t0 + jnp.arange(Q_BLOCK)
        qb = lax.dynamic_slice_in_dim(q, t0, Q_BLOCK, axis=3)
        d_c = t[:, None] - cmp_end[None, :]
        lg = jnp.einsum('bgrqd,bgnd->bgrqn', qb, k_cmp).astype(jnp.float32) + table[:, :, rel_bucket(d_c)]
        p_cmp = masked_softmax(lg, d_c >= 0)
        o_cmp = jnp.einsum('bgrqn,bgnd->bgrqd', p_cmp.astype(v_cmp.dtype), v_cmp)
        imp = jnp.pad(jnp.sum(p_cmp, axis=2), ((0, 0), (0, 0), (0, 0), (1, 1)))
        imp_sel = imp[..., :-1].reshape(B, G, Q_BLOCK, n_sel_blocks, SEL_RATIO).sum(-1) + imp[..., SEL_RATIO::SEL_RATIO]
        blk_t = t // SEL_BLOCK
        forced = (j_blk[None, :] == 0) | (j_blk[None, :] == blk_t[:, None]) | (j_blk[None, :] == blk_t[:, None] - 1)
        valid = j_blk[None, :] <= blk_t[:, None]
        score = jnp.where(forced, FORCED_SCORE, jnp.where(valid, imp_sel, -1.0))
        _, top = lax.top_k(score, n_top)
        tok = (top[..., None] * SEL_BLOCK + jnp.arange(SEL_BLOCK)).reshape(B, G, Q_BLOCK, n_top * SEL_BLOCK)
        ks = k_sel[b_idx, g_idx, tok]
        vs = v_sel[b_idx, g_idx, tok]
        d_s = t[:, None] - tok
        lg = jnp.einsum('bgrqd,bgqld->bgrql', qb, ks).astype(jnp.float32) + table[gi, ri, rel_bucket(d_s)[:, :, None]]
        p = masked_softmax(lg, (d_s >= 0)[:, :, None])
        o_sel = jnp.einsum('bgrql,bgqld->bgrqd', p.astype(vs.dtype), vs)
        kw = lax.dynamic_slice_in_dim(k_win_p, t0, WINDOW + Q_BLOCK, axis=2)
        vw = lax.dynamic_slice_in_dim(v_win_p, t0, WINDOW + Q_BLOCK, axis=2)
        s = t0 - WINDOW + jnp.arange(WINDOW + Q_BLOCK)
        d_w = t[:, None] - s[None, :]
        mask_w = (s[None, :] >= 0) & (d_w >= 0) & (d_w < WINDOW)
        lg = jnp.einsum('bgrqd,bgkd->bgrqk', qb, kw).astype(jnp.float32) + table[:, :, rel_bucket(d_w)]
        p = masked_softmax(lg, mask_w)
        o_win = jnp.einsum('bgrqk,bgkd->bgrqd', p.astype(vw.dtype), vw)
        to_bqhd = lambda o: o.transpose(0, 3, 1, 2, 4).reshape(B, Q_BLOCK, H, dh)
        g = lax.dynamic_slice_in_dim(gates, t0, Q_BLOCK, axis=1)
        out = g[..., 0:1] * to_bqhd(o_cmp) + g[..., 1:2] * to_bqhd(o_sel) + g[..., 2:3] * to_bqhd(o_win)
        return out.reshape(B, Q_BLOCK, H * dh)

    out = lax.map(block, jnp.arange(S // Q_BLOCK))
    out = out.transpose(1, 0, 2, 3).reshape(B, S, H * dh)
    return out @ w_o


def setup_inputs(seed: int = 0) -> dict:
    key = jax.random.key(seed)
    ks = jax.random.split(key, 24)
    D, dh, G = D_MODEL, HEAD_DIM, N_KV_GROUPS
    nrm = lambda k, shape, scale: jax.random.normal(k, shape, jnp.float32) * scale
    x = nrm(ks[0], (BATCH, SEQ, D), 1.0)
    fox_w_in = jnp.concatenate([
        nrm(ks[1], (N_A_LAYERS, D, 2 * N_HEADS_A * dh), D ** -0.5),
        nrm(ks[2], (N_A_LAYERS, D, N_HEADS_A * dh), BETA * D ** -0.5),
        nrm(ks[3], (N_A_LAYERS, D, N_HEADS_A), D ** -0.5),
    ], axis=-1)
    fox_b_f = 2.0 + nrm(ks[4], (N_A_LAYERS, N_HEADS_A), 1.0)
    fox_w_o = nrm(ks[5], (N_A_LAYERS, D, D), BETA * D ** -0.5)
    nsa_w_in = nrm(ks[6], (N_B_LAYERS, D, N_HEADS_B * dh + 3 * N_HEADS_B), D ** -0.5)
    nsa_w_o = nrm(ks[7], (N_B_LAYERS, D, D), BETA * D ** -0.5)
    slot_scale = jnp.array([1.0, BETA, 1.0, BETA, 1.0, BETA], jnp.float32)[None, :, None]
    kv_w = (nrm(ks[8], (D, 6, G * dh), D ** -0.5) * slot_scale).reshape(D, 6 * G * dh)
    cmp_pos_k = nrm(ks[9], (CMP_BLOCK, dh), 0.1)
    cmp_pos_v = nrm(ks[10], (CMP_BLOCK, dh), 0.1)
    cmp_k_w1 = nrm(ks[11], (CMP_BLOCK * dh, CMP_HIDDEN), (CMP_BLOCK * dh) ** -0.5)
    cmp_k_w2 = nrm(ks[12], (CMP_HIDDEN, dh), CMP_HIDDEN ** -0.5)
    cmp_v_w1 = nrm(ks[13], (CMP_BLOCK * dh, CMP_HIDDEN), (CMP_BLOCK * dh) ** -0.5)
    cmp_v_w2 = nrm(ks[14], (CMP_HIDDEN, dh), CMP_HIDDEN ** -0.5)
    rel_bias = nrm(ks[15], (N_BUCKETS, N_HEADS_B), 0.5)
    mlp_w1 = nrm(ks[16], (DEPTH, D, D_FF), D ** -0.5)
    mlp_w2 = nrm(ks[17], (DEPTH, D_FF, D), BETA * D_FF ** -0.5)
    ln1_g = 1.0 + nrm(ks[18], (DEPTH, D), 0.02)
    ln1_b = nrm(ks[19], (DEPTH, D), 0.02)
    ln2_g = 1.0 + nrm(ks[20], (DEPTH, D), 0.02)
    ln2_b = nrm(ks[21], (DEPTH, D), 0.02)
    return {"x": x, "fox_w_in": fox_w_in, "fox_b_f": fox_b_f, "fox_w_o": fox_w_o,
            "nsa_w_in": nsa_w_in, "nsa_w_o": nsa_w_o, "kv_w": kv_w,
            "cmp_pos_k": cmp_pos_k, "cmp_pos_v": cmp_pos_v,
            "cmp_k_w1": cmp_k_w1, "cmp_k_w2": cmp_k_w2, "cmp_v_w1": cmp_v_w1, "cmp_v_w2": cmp_v_w2,
            "rel_bias": rel_bias, "mlp_w1": mlp_w1, "mlp_w2": mlp_w2,
            "ln1_g": ln1_g, "ln1_b": ln1_b, "ln2_g": ln2_g, "ln2_b": ln2_b}


def reference(x, fox_w_in, fox_b_f, fox_w_o, nsa_w_in, nsa_w_o, kv_w,
              cmp_pos_k, cmp_pos_v, cmp_k_w1, cmp_k_w2, cmp_v_w1, cmp_v_w2,
              rel_bias, mlp_w1, mlp_w2, ln1_g, ln1_b, ln2_g, ln2_b):
    h = x
    kv = None
    for layer in range(DEPTH):
        if layer < N_A_LAYERS:
            mix = fox_attention(h, fox_w_in[layer], fox_b_f[layer], fox_w_o[layer])
        else:
            b = layer - N_A_LAYERS
            mix = nsa_attention(h, nsa_w_in[b], nsa_w_o[b], rel_bias, *kv)
        h = layer_norm(ALPHA * h + mix, ln1_g[layer], ln1_b[layer])
        h = layer_norm(ALPHA * h + sq_relu_mlp(h, mlp_w1[layer], mlp_w2[layer]), ln2_g[layer], ln2_b[layer])
        if layer == N_A_LAYERS - 1:
            kv = shared_kv(h, kv_w, cmp_pos_k, cmp_pos_v, cmp_k_w1, cmp_k_w2, cmp_v_w1, cmp_v_w2)
    return h
```

```cpp
#include <hip/hip_runtime.h>
#include <hip/hip_cooperative_groups.h>
#include <hip/hip_fp16.h>
#include <cstdio>
#include <cstdint>
namespace cg = cooperative_groups;
namespace pg8 {
#define PG8_LAS __attribute__((address_space(3)))
typedef unsigned short bf16_t;
typedef short bf16x8 __attribute__((ext_vector_type(8)));
typedef float f32x4 __attribute__((ext_vector_type(4)));
typedef unsigned u32x4 __attribute__((ext_vector_type(4)));
constexpr int BM = 256, BK = 64, HALF = 128, HTB = HALF * BK * 2  , STAGE_BYTES = 8 * HTB, NXCD = 8, WGM = 8;

__host__ __device__ __forceinline__ int lds_byte(int r, int c) { const int st = (r >> 4) * 2 + (c >> 5), rr = r & 15, cc = c & 31, ob = rr * 64 + cc * 2; return st * 1024 + (ob ^ (((ob >> 9) & 1) << 5)); }
__host__ __device__ __forceinline__ void stage_rc(int b, int& R, int& C) { const int st = b / 1024, sb = b % 1024, swz = sb ^ (((sb >> 9) & 1) << 5); R = (st >> 1) * 16 + swz / 64; C = (st & 1) * 32 + (swz % 64) / 2; }
__host__ __device__ __forceinline__ int perm32(int rho) { const int n = rho >> 4, i = rho & 15; return 8 * (i >> 2) + 4 * n + (i & 3); }

struct Unit { int pm, pn; };
struct Gemm { const bf16_t* A; const bf16_t* Bt; int M, N, K, lda; };

struct StaticOrder {
    int nM, nN, nwg, G, c;
    __host__ __device__ void init(int M, int N, int G_, int c_) { nM = M / BM; nN = N / BM; nwg = nM * nN; G = G_; c = c_; }
    __host__ __device__ bool next(int i, Unit& u) const {
        const long L = (long)i * G + c; if (L >= nwg) return false;
        int wgid = (int)L; { const int q = nwg / NXCD, r = nwg % NXCD, xcd = wgid % NXCD, off = wgid / NXCD; wgid = (xcd < r ? xcd * (q + 1) : r * (q + 1) + (xcd - r) * q) + off; }
        const int nig = WGM * nN, gid = wgid / nig, fm = gid * WGM, gsz = (nM - fm) < WGM ? (nM - fm) : WGM;
        u.pm = fm + ((wgid % nig) % gsz); u.pn = (wgid % nig) / gsz; return true;
    }
    __device__ __forceinline__ void a_ready(const Unit&) const {}
    __device__ __forceinline__ void done(const Unit&) const {}
};


__device__ __forceinline__ unsigned cvt_pk_bf16(float lo, float hi) { unsigned r; asm volatile("v_cvt_pk_bf16_f32 %0, %1, %2" : "=v"(r) : "v"(lo), "v"(hi)); return r; }
typedef float f32x2 __attribute__((ext_vector_type(2)));
template <class Epi, class Sched, bool ALIGN_EPI = false, bool SP2 = false>
__device__ __forceinline__ void gemm_phase(PG8_LAS unsigned char* lds, const Gemm g, const Sched& S, const Epi& E) {
    int tid_ = threadIdx.x; asm volatile("" : "+v"(tid_));
    const int tid = tid_, wid = __builtin_amdgcn_readfirstlane(tid >> 6), lane = tid & 63, wr = wid >> 2, wc = wid & 3, fr = lane & 15, fq = lane >> 4;
    const int K = g.K, nt = K / BK;
    unsigned voffA[2], voffB[2];
#pragma unroll
    for (int i = 0; i < 2; ++i) { int R, C; stage_rc(tid * 16 + i * 8192, R, C); const int Rb = Epi::PERM ? ((R & ~31) + perm32(R & 31)) : R;
        voffA[i] = (unsigned)(R * g.lda + C) * 2u; voffB[i] = (unsigned)(Rb * K + C) * 2u; }
    const size_t kstep = (size_t)(BK * 2);
    const size_t hstepB = (size_t)HALF * K * 2, hstepA = (size_t)HALF * g.lda * 2;
    const size_t tstepB = 2 * hstepB, tstepA = 2 * hstepA;
    const unsigned ldsw = (unsigned)wid * 1024u;
    const int aoff = lds_byte(wr * 64 + fr, fq * 8), boff = lds_byte(wc * 32 + fr, fq * 8);
#define PG8_SA(b, h) (((b) * 2 + (h)) * HTB)
#define PG8_SB(b, h) ((4 + (b) * 2 + (h)) * HTB)
#define PG8_STAGE(bufoff, gbase, voff) do { _Pragma("unroll") for (int _i = 0; _i < 2; ++_i) \
        __builtin_amdgcn_global_load_lds((const unsigned*)((const char*)(gbase) + (voff)[_i]), (PG8_LAS unsigned*)(lds + (bufoff) + ldsw + _i * 8192), 16, 0, 0); } while (0)
#define PG8_LDA(dst, b, h) do { _Pragma("unroll") for (int m = 0; m < 4; ++m) _Pragma("unroll") for (int k = 0; k < 2; ++k) dst[m][k] = *(const PG8_LAS bf16x8*)(lds + PG8_SA(b, h) + aoff + m * 2048 + k * 1024); } while (0)
#define PG8_LDB(dst, b, h) do { _Pragma("unroll") for (int n = 0; n < 2; ++n) _Pragma("unroll") for (int k = 0; k < 2; ++k) dst[n][k] = *(const PG8_LAS bf16x8*)(lds + PG8_SB(b, h) + boff + n * 2048 + k * 1024); } while (0)
#define PG8_MMA(ai, bj, At, Bt) do { __builtin_amdgcn_s_setprio(1); _Pragma("unroll") for (int m = 0; m < 4; ++m) _Pragma("unroll") for (int n = 0; n < 2; ++n) _Pragma("unroll") for (int k = 0; k < 2; ++k) \
        acc[ai][bj][m][n] = __builtin_amdgcn_mfma_f32_16x16x32_bf16(Bt[n][k], At[m][k], acc[ai][bj][m][n], 0, 0, 0); __builtin_amdgcn_s_setprio(0); } while (0)
#define PG8_WAIT_V(n) asm volatile("s_waitcnt vmcnt(" #n ")" ::: "memory")
#define PG8_WAIT_L(n) asm volatile("s_waitcnt lgkmcnt(" #n ")" ::: "memory")
#define PG8_BAR __builtin_amdgcn_s_barrier()
#define PG8_SCHED __builtin_amdgcn_sched_barrier(0)
    Unit cur, nxt; int ui = 0;
    if (!S.next(0, cur)) return;
    f32x4 acc[2][2][4][2];
#pragma unroll
    for (int a = 0; a < 2; ++a)
#pragma unroll
        for (int b = 0; b < 2; ++b)
#pragma unroll
            for (int m = 0; m < 4; ++m)
#pragma unroll
                for (int n = 0; n < 2; ++n) acc[a][b][m][n] = (f32x4){0.f, 0.f, 0.f, 0.f};
    bf16x8 At[4][2], B0[2][2], B1[2][2];
    const char* cA = (const char*)g.A + (size_t)cur.pm * tstepA; const char* cB = (const char*)g.Bt + (size_t)cur.pn * tstepB;
    S.a_ready(cur);
    if constexpr (SP2) {
        PG8_STAGE(PG8_SB(0, 0), cB, voffB); PG8_STAGE(PG8_SB(0, 1), cB + hstepB, voffB); PG8_STAGE(PG8_SA(0, 0), cA, voffA); PG8_STAGE(PG8_SA(0, 1), cA + hstepA, voffA);
        if (wr == 1) PG8_BAR;
        PG8_WAIT_V(2); PG8_BAR;
        PG8_STAGE(PG8_SB(1, 0), cB + kstep, voffB); PG8_STAGE(PG8_SA(1, 0), cA + kstep, voffA); PG8_STAGE(PG8_SB(1, 1), cB + hstepB + kstep, voffB);
        PG8_WAIT_V(6); PG8_BAR;
    } else {
        PG8_STAGE(PG8_SB(0, 0), cB, voffB); PG8_STAGE(PG8_SA(0, 0), cA, voffA); PG8_STAGE(PG8_SB(0, 1), cB + hstepB, voffB); PG8_STAGE(PG8_SA(0, 1), cA + hstepA, voffA);
        if (wr == 1) PG8_BAR;
        PG8_WAIT_V(4); PG8_BAR;
        PG8_STAGE(PG8_SB(1, 0), cB + kstep, voffB); PG8_STAGE(PG8_SA(1, 0), cA + kstep, voffA); PG8_STAGE(PG8_SB(1, 1), cB + hstepB + kstep, voffB);
        PG8_WAIT_V(6); PG8_BAR;
    }
    for (;;) {
        const bool has_next = S.next(ui + 1, nxt);
        const char* nA = has_next ? (const char*)g.A + (size_t)nxt.pm * tstepA : cA; const char* nB = has_next ? (const char*)g.Bt + (size_t)nxt.pn * tstepB : cB;
        for (int t = 0; t < nt; t += 2) {
            const bool last = (t == nt - 2);
            const char* a1 = cA + (size_t)(t + 1) * kstep;
            const char* a2 = last ? nA : cA + (size_t)(t + 2) * kstep; const char* b2 = last ? nB : cB + (size_t)(t + 2) * kstep;
            const char* a3 = a2 + kstep; const char* b3 = b2 + kstep;
            if (last && has_next) S.a_ready(nxt);
            if constexpr (SP2) {
            PG8_LDB(B0, 0, 0); PG8_LDB(B1, 0, 1); PG8_SCHED; PG8_LDA(At, 0, 0); PG8_STAGE(PG8_SA(1, 1), a1 + hstepA, voffA);
            PG8_WAIT_V(8); PG8_WAIT_L(0); PG8_BAR; PG8_MMA(0, 0, At, B0); PG8_MMA(0, 1, At, B1); PG8_BAR; PG8_SCHED;
            PG8_LDA(At, 0, 1); PG8_STAGE(PG8_SB(0, 0), b2, voffB); PG8_STAGE(PG8_SB(0, 1), b2 + hstepB, voffB); PG8_STAGE(PG8_SA(0, 0), a2, voffA);
            PG8_WAIT_V(8); PG8_WAIT_L(0); PG8_BAR; PG8_MMA(1, 0, At, B0); PG8_MMA(1, 1, At, B1); PG8_BAR; PG8_SCHED;
            PG8_LDB(B0, 1, 0); PG8_LDB(B1, 1, 1); PG8_SCHED; PG8_LDA(At, 1, 0); PG8_STAGE(PG8_SA(0, 1), a2 + hstepA, voffA);
            PG8_WAIT_V(8); PG8_WAIT_L(0); PG8_BAR; PG8_MMA(0, 0, At, B0); PG8_MMA(0, 1, At, B1); PG8_BAR; PG8_SCHED;
            PG8_LDA(At, 1, 1); PG8_STAGE(PG8_SB(1, 0), b3, voffB); PG8_STAGE(PG8_SB(1, 1), b3 + hstepB, voffB); PG8_STAGE(PG8_SA(1, 0), a3, voffA);
            PG8_WAIT_V(8); PG8_WAIT_L(0); PG8_BAR; PG8_MMA(1, 0, At, B0); PG8_MMA(1, 1, At, B1); PG8_BAR; PG8_SCHED;
            }
        }
        if constexpr (ALIGN_EPI) { if (wr == 0) PG8_BAR; }
        if constexpr (!Epi::AFTER_DRAIN) { E(acc, cur, wr, wc, fr, fq); S.done(cur); }
        if (!has_next) break;
#pragma unroll
        for (int a = 0; a < 2; ++a)
#pragma unroll
            for (int b = 0; b < 2; ++b)
#pragma unroll
                for (int m = 0; m < 4; ++m)
#pragma unroll
                    for (int n = 0; n < 2; ++n) acc[a][b][m][n] = (f32x4){0.f, 0.f, 0.f, 0.f};
        cur = nxt; cA = nA; cB = nB; ++ui;
        if constexpr (ALIGN_EPI) { if (wr == 1) PG8_BAR; }
    }
    PG8_WAIT_V(0);
    if constexpr (!ALIGN_EPI) { if (wr == 0) PG8_BAR; }
    PG8_BAR;
    if constexpr (Epi::AFTER_DRAIN) { E.fused(acc, cur, wr, wc, fr, fq, lds, wid, lane); S.done(cur); }
#undef PG8_SA
#undef PG8_SB
#undef PG8_STAGE
#undef PG8_LDA
#undef PG8_LDB
#undef PG8_MMA
#undef PG8_WAIT_V
#undef PG8_WAIT_L
#undef PG8_BAR
#undef PG8_SCHED
}
}

#define LAS __attribute__((address_space(3)))
using pg8::bf16_t; using pg8::bf16x8; using pg8::f32x4; using pg8::u32x4; using pg8::Unit; using pg8::cvt_pk_bf16;
typedef short s16x4 __attribute__((ext_vector_type(4)));
typedef float f32x16 __attribute__((ext_vector_type(16)));
typedef unsigned u32x2 __attribute__((ext_vector_type(2)));

constexpr int S_ = 16384, DM = 2048, FF = 8192, NH = 16, DH = 128, NG = 4;
constexpr int NFOX = 6400, NNSA = 2304, NKV = 3072;
constexpr float ALPHA_ = 1.6817928305074292f;
constexpr float QSCALE = 0.08838834764831845f;
constexpr float L2E = 1.4426950408889634f;
constexpr float LN_EPS_ = 1e-5f;

constexpr size_t MiB = 1u << 20;
constexpr size_t WS_WFOXIN = 0;
constexpr size_t WS_WFOXO  = 50 * MiB;
constexpr size_t WS_WNSAIN = 66 * MiB;
constexpr size_t WS_WNSAO  = 84 * MiB;
constexpr size_t WS_WKV    = 100 * MiB;
constexpr size_t WS_W1     = 112 * MiB;
constexpr size_t WS_W2     = 240 * MiB;
constexpr size_t WS_WC1    = 368 * MiB;
constexpr size_t WS_HBF    = 372 * MiB;
constexpr size_t WS_PRE    = 436 * MiB;
constexpr size_t WS_A      = 564 * MiB;
constexpr size_t WS_KV     = 820 * MiB;
constexpr size_t WS_RAWK   = 916 * MiB;
constexpr size_t WS_RAWV   = 933 * MiB;
constexpr size_t WS_VT     = 950 * MiB;
constexpr size_t WS_CH     = 966 * MiB;
constexpr size_t WS_KC     = 970 * MiB;
constexpr size_t WS_VC     = 971 * MiB;
constexpr size_t WS_CUM    = 972 * MiB;
constexpr size_t WS_FLOG   = 973 * MiB;
constexpr size_t WS_GATE   = 974 * MiB;
constexpr size_t WS_LUT    = 977 * MiB;
constexpr size_t WS_CBP    = 977 * MiB + 256 * 1024;
constexpr size_t WS_CB     = 977 * MiB + 512 * 1024;
constexpr size_t WS_END    = 978 * MiB;

constexpr int SHM_K = 16384, SHM_V = 16384;
constexpr int L_V = 0, L_K = 32768, L_WS = 65536, L_CK = 65536 + 2048, L_LUT = 69632, L_END = 69632 + 32768;
constexpr int LDS_BYTES = 147456;

__device__ __forceinline__ u32x4 pack8bf(f32x4 a, f32x4 b) { u32x4 w; w.x = cvt_pk_bf16(a[0], a[1]); w.y = cvt_pk_bf16(a[2], a[3]); w.z = cvt_pk_bf16(b[0], b[1]); w.w = cvt_pk_bf16(b[2], b[3]); return w; }
__device__ __forceinline__ float log_sigmoid_f(float x) { return fminf(x, 0.f) - log1pf(__expf(-fabsf(x))); }
__device__ __forceinline__ float sigmoid_f(float x) { return 1.f / (1.f + __expf(-x)); }
__device__ __forceinline__ float gelu_tanh_f(float x) { const float u = 0.7978845608028654f * (x + 0.044715f * x * x * x); const float t = 1.f - 2.f / (__expf(2.f * u) + 1.f); return 0.5f * x * (1.f + t); }

struct EpiFoxQKV {
    static constexpr bool PERM = true, AFTER_DRAIN = false;
    bf16_t* q; float* flog; const float* bfg;
    __device__ __forceinline__ void operator()(const f32x4 (&acc)[2][2][4][2], const Unit& u, int wr, int wc, int fr, int fq) const {
        const int row0 = u.pm * 256 + wr * 64 + fr; const int colt = u.pn * 256;
        if (colt < 6144) {
            const int t = colt >> 11; bf16_t* base = q + (size_t)t * ((size_t)S_ * DM); const float sc = t == 0 ? QSCALE : 1.f;
            const int c0 = colt - t * 2048 + wc * 32 + 8 * fq;
#pragma unroll
            for (int ai = 0; ai < 2; ++ai)
#pragma unroll
                for (int m = 0; m < 4; ++m) { bf16_t* rowp = base + (size_t)(row0 + ai * 128 + m * 16) * DM + c0;
#pragma unroll
                    for (int bj = 0; bj < 2; ++bj) *(u32x4*)(rowp + bj * 128) = pack8bf(acc[ai][bj][m][0] * sc, acc[ai][bj][m][1] * sc); }
        } else if (wc == 0 && fq < 2) {
            float bb[8];
#pragma unroll
            for (int e = 0; e < 8; ++e) bb[e] = bfg[8 * fq + e];
#pragma unroll
            for (int ai = 0; ai < 2; ++ai)
#pragma unroll
                for (int m = 0; m < 4; ++m) { float* rowp = flog + (size_t)(row0 + ai * 128 + m * 16) * 16 + 8 * fq;
                    f32x4 a = acc[ai][0][m][0], b = acc[ai][0][m][1], oa, ob;
#pragma unroll
                    for (int e = 0; e < 4; ++e) { oa[e] = log_sigmoid_f(a[e] + bb[e]); ob[e] = log_sigmoid_f(b[e] + bb[4 + e]); }
                    *(f32x4*)rowp = oa; *(f32x4*)(rowp + 4) = ob; }
        }
    }
};
struct EpiNsaQ {
    static constexpr bool PERM = true, AFTER_DRAIN = false;
    bf16_t* q; float* gates;
    __device__ __forceinline__ void operator()(const f32x4 (&acc)[2][2][4][2], const Unit& u, int wr, int wc, int fr, int fq) const {
        const int row0 = u.pm * 256 + wr * 64 + fr; const int colt = u.pn * 256;
        if (colt < 2048) {
            const int c0 = colt + wc * 32 + 8 * fq;
#pragma unroll
            for (int ai = 0; ai < 2; ++ai)
#pragma unroll
                for (int m = 0; m < 4; ++m) { bf16_t* rowp = q + (size_t)(row0 + ai * 128 + m * 16) * DM + c0;
#pragma unroll
                    for (int bj = 0; bj < 2; ++bj) *(u32x4*)(rowp + bj * 128) = pack8bf(acc[ai][bj][m][0] * QSCALE, acc[ai][bj][m][1] * QSCALE); }
        } else { const int c0 = wc * 32 + 8 * fq;
            if (c0 < 48) {
#pragma unroll
            for (int ai = 0; ai < 2; ++ai)
#pragma unroll
                for (int m = 0; m < 4; ++m) { float* rowp = gates + (size_t)(row0 + ai * 128 + m * 16) * 48 + c0;
                    f32x4 a = acc[ai][0][m][0], b = acc[ai][0][m][1], oa, ob;
#pragma unroll
                    for (int e = 0; e < 4; ++e) { oa[e] = sigmoid_f(a[e]); ob[e] = sigmoid_f(b[e]); }
                    *(f32x4*)rowp = oa; *(f32x4*)(rowp + 4) = ob; } }
        }
    }
};
struct EpiRes {
    static constexpr bool PERM = true, AFTER_DRAIN = false;
    const float* res; float* out;
    __device__ __forceinline__ void operator()(const f32x4 (&acc)[2][2][4][2], const Unit& u, int wr, int wc, int fr, int fq) const {
        const int row0 = u.pm * 256 + wr * 64 + fr; const int c0 = u.pn * 256 + wc * 32 + 8 * fq;
#pragma unroll
        for (int ai = 0; ai < 2; ++ai)
#pragma unroll
            for (int m = 0; m < 4; ++m) { const size_t off = (size_t)(row0 + ai * 128 + m * 16) * DM + c0;
#pragma unroll
                for (int bj = 0; bj < 2; ++bj) { const f32x4 r0 = *(const f32x4*)(res + off + bj * 128), r1 = *(const f32x4*)(res + off + bj * 128 + 4);
                    *(f32x4*)(out + off + bj * 128) = r0 * ALPHA_ + acc[ai][bj][m][0]; *(f32x4*)(out + off + bj * 128 + 4) = r1 * ALPHA_ + acc[ai][bj][m][1]; } }
    }
};
struct EpiRelu2 {
    static constexpr bool PERM = true, AFTER_DRAIN = false;
    bf16_t* O;
    __device__ __forceinline__ void operator()(const f32x4 (&acc)[2][2][4][2], const Unit& u, int wr, int wc, int fr, int fq) const {
        const int row0 = u.pm * 256 + wr * 64 + fr; const int c0 = u.pn * 256 + wc * 32 + 8 * fq;
#pragma unroll
        for (int ai = 0; ai < 2; ++ai)
#pragma unroll
            for (int m = 0; m < 4; ++m) { bf16_t* rowp = O + (size_t)(row0 + ai * 128 + m * 16) * FF + c0;
#pragma unroll
                for (int bj = 0; bj < 2; ++bj) { f32x4 a = acc[ai][bj][m][0], b = acc[ai][bj][m][1];
#pragma unroll
                    for (int e = 0; e < 4; ++e) { a[e] = fmaxf(a[e], 0.f); a[e] *= a[e]; b[e] = fmaxf(b[e], 0.f); b[e] *= b[e]; }
                    *(u32x4*)(rowp + bj * 128) = pack8bf(a, b); } }
    }
};
__device__ __forceinline__ int vt_pos(int ko) { return ((ko & 15) >> 2) * 8 + ((ko >> 4) << 2) + (ko & 3); }
struct EpiKV {
    static constexpr bool PERM = true, AFTER_DRAIN = false;
    bf16_t* kv; bf16_t* rawk; bf16_t* rawv; bf16_t* vt;
    __device__ __forceinline__ void operator()(const f32x4 (&acc)[2][2][4][2], const Unit& u, int wr, int wc, int fr, int fq) const {
        const int row0 = u.pm * 256 + wr * 64 + fr;
#pragma unroll
        for (int bj = 0; bj < 2; ++bj) {
            const int cg_ = u.pn * 256 + bj * 128; const int slot = cg_ >> 9, g = (cg_ & 511) >> 7; const int d0 = wc * 32 + 8 * fq;
#pragma unroll
            for (int ai = 0; ai < 2; ++ai)
#pragma unroll
                for (int m = 0; m < 4; ++m) { const int row = row0 + ai * 128 + m * 16; const f32x4 a = acc[ai][bj][m][0], b = acc[ai][bj][m][1];
                    if (slot < 2) { bf16_t* dst = (slot == 0 ? rawk : rawv) + ((size_t)g * S_ + row) * 128 + d0; *(u32x4*)dst = pack8bf(a, b); }
                    else if (slot == 3) { const u32x4 w = pack8bf(a, b); bf16_t* dst = vt + ((size_t)g * 128 + d0) * S_ + (row & ~31) + vt_pos(row & 31);
                        dst[0 * (size_t)S_] = (bf16_t)(w.x & 0xffffu); dst[1 * (size_t)S_] = (bf16_t)(w.x >> 16); dst[2 * (size_t)S_] = (bf16_t)(w.y & 0xffffu); dst[3 * (size_t)S_] = (bf16_t)(w.y >> 16);
                        dst[4 * (size_t)S_] = (bf16_t)(w.z & 0xffffu); dst[5 * (size_t)S_] = (bf16_t)(w.z >> 16); dst[6 * (size_t)S_] = (bf16_t)(w.w & 0xffffu); dst[7 * (size_t)S_] = (bf16_t)(w.w >> 16); }
                    else { *(u32x4*)(kv + (size_t)row * NKV + cg_ + d0) = pack8bf(a, b); } }
        }
    }
};
struct EpiCmp1 {
    static constexpr bool PERM = true, AFTER_DRAIN = false;
    bf16_t* O; const float* bias;
    __device__ __forceinline__ void operator()(const f32x4 (&acc)[2][2][4][2], const Unit& u, int wr, int wc, int fr, int fq) const {
        const int row0 = u.pm * 256 + wr * 64 + fr; const int c0 = wc * 32 + 8 * fq;
#pragma unroll
        for (int bj = 0; bj < 2; ++bj) { const f32x4 b0 = *(const f32x4*)(bias + c0 + bj * 128), b1 = *(const f32x4*)(bias + c0 + bj * 128 + 4);
#pragma unroll
            for (int ai = 0; ai < 2; ++ai)
#pragma unroll
                for (int m = 0; m < 4; ++m) { f32x4 a = acc[ai][bj][m][0] + b0, b = acc[ai][bj][m][1] + b1;
#pragma unroll
                    for (int e = 0; e < 4; ++e) { a[e] = gelu_tanh_f(a[e]); b[e] = gelu_tanh_f(b[e]); }
                    *(u32x4*)(O + (size_t)(row0 + ai * 128 + m * 16) * 256 + c0 + bj * 128) = pack8bf(a, b); } }
    }
};

__device__ __forceinline__ unsigned f2bf(float f) { unsigned u = __builtin_bit_cast(unsigned, f); return (u + 0x7fffu + ((u >> 16) & 1u)) >> 16; }
__device__ __forceinline__ unsigned pk2(float lo, float hi) { return f2bf(lo) | (f2bf(hi) << 16); }
__device__ __forceinline__ float wave_sum(float v) {
#pragma unroll
    for (int o = 1; o < 64; o <<= 1) v += __shfl_xor(v, o);
    return v;
}
__device__ __forceinline__ float wave_max(float v) {
#pragma unroll
    for (int o = 1; o < 64; o <<= 1) v = fmaxf(v, __shfl_xor(v, o));
    return v;
}
__device__ __forceinline__ void transpose_item(const float* W, int K, int ld, int ncols, bf16_t* WT, LAS float* scr, int item, int lane) {
    const int nblk = ncols / 32, kb = item / nblk, nb = item % nblk, k0 = 64 * kb, n0 = 32 * nb;
#pragma unroll 8
    for (int i = 0; i < 32; ++i) { const int kk = 2 * i + (lane >> 5); scr[kk * 33 + (lane & 31)] = W[(size_t)(k0 + kk) * ld + n0 + (lane & 31)]; }
    asm volatile("s_waitcnt lgkmcnt(0)" ::: "memory");
    const int c = lane & 7;
#pragma unroll
    for (int j = 0; j < 4; ++j) { const int n = (lane >> 3) + 8 * j; const LAS float* s = scr + (8 * c) * 33 + n;
        u32x4 o; o.x = pk2(s[0 * 33], s[1 * 33]); o.y = pk2(s[2 * 33], s[3 * 33]); o.z = pk2(s[4 * 33], s[5 * 33]); o.w = pk2(s[6 * 33], s[7 * 33]);
        *(u32x4*)(WT + (size_t)(n0 + n) * K + k0 + 8 * c) = o; }
    asm volatile("s_waitcnt lgkmcnt(0)" ::: "memory");
}
__device__ __forceinline__ int rel_bucket_dev(int n) {
    if (n < 16) return n;
    int lg = 16 + (int)(__logf((float)n / 16.0f) / 4.852030263919617f * 16.0f);
    return lg > 31 ? 31 : lg;
}

struct Params { const float* in[20]; float* out; unsigned char* ws; };
typedef const Params __attribute__((address_space(4)))* KP;
#define KARGS() ({ KP q_ = (KP)__builtin_amdgcn_kernarg_segment_ptr(); asm volatile("" : "+s"(q_)); q_; })
enum { I_X = 0, I_FOXWIN, I_FOXBF, I_FOXWO, I_NSAWIN, I_NSAWO, I_KVW, I_POSK, I_POSV, I_CK1, I_CK2, I_CV1, I_CV2, I_RELB, I_W1, I_W2, I_LN1G, I_LN1B, I_LN2G, I_LN2B };

__device__ __forceinline__ void prologue(KP p, LAS unsigned char* lds) {
    int tid_ = threadIdx.x; asm volatile("" : "+v"(tid_));
    const int tid = tid_, lane = tid & 63, wave = tid >> 6;
    const int gw = blockIdx.x * 8 + wave, NGW = gridDim.x * 8;
    LAS float* scr = (LAS float*)(lds + wave * 16384);
    unsigned char* ws = p->ws;
    long base = 0;
#define TR(src, K, ld, ncols, dst) do { const long n_ = (long)((K) / 64) * ((ncols) / 32); \
        for (long it = gw; it < n_; it += NGW) transpose_item((src), (K), (ld), (ncols), (dst), scr, (int)it, lane); } while (0)
    for (int L = 0; L < 2; ++L) {
        TR(p->in[I_FOXWIN] + (size_t)L * DM * 6160, DM, 6160, 6144, (bf16_t*)(ws + WS_WFOXIN) + (size_t)L * NFOX * DM);
        TR(p->in[I_FOXWO] + (size_t)L * DM * DM, DM, DM, DM, (bf16_t*)(ws + WS_WFOXO) + (size_t)L * DM * DM);
        TR(p->in[I_NSAWIN] + (size_t)L * DM * 2096, DM, 2096, 2048, (bf16_t*)(ws + WS_WNSAIN) + (size_t)L * NNSA * DM);
        TR(p->in[I_NSAWO] + (size_t)L * DM * DM, DM, DM, DM, (bf16_t*)(ws + WS_WNSAO) + (size_t)L * DM * DM);
    }
    TR(p->in[I_KVW], DM, NKV, NKV, (bf16_t*)(ws + WS_WKV));
    for (int L = 0; L < 4; ++L) {
        TR(p->in[I_W1] + (size_t)L * DM * FF, DM, FF, FF, (bf16_t*)(ws + WS_W1) + (size_t)L * FF * DM);
        TR(p->in[I_W2] + (size_t)L * FF * DM, FF, DM, DM, (bf16_t*)(ws + WS_W2) + (size_t)L * DM * FF);
    }
    TR(p->in[I_CK1], 4096, 256, 256, (bf16_t*)(ws + WS_WC1));
    TR(p->in[I_CV1], 4096, 256, 256, (bf16_t*)(ws + WS_WC1) + (size_t)256 * 4096);
#undef TR
    (void)base;
    const int gt = blockIdx.x * 512 + tid, NGT = gridDim.x * 512;
    for (int i = gt; i < 2 * 256 * DM; i += NGT) { const int L = i / (256 * DM), r = (i / DM) % 256, k = i % DM;
        const float v = r < 16 ? p->in[I_FOXWIN][(size_t)L * DM * 6160 + (size_t)k * 6160 + 6144 + r] : 0.f;
        ((bf16_t*)(ws + WS_WFOXIN))[(size_t)L * NFOX * DM + (size_t)(6144 + r) * DM + k] = (bf16_t)f2bf(v); }
    for (int i = gt; i < 2 * 256 * DM; i += NGT) { const int L = i / (256 * DM), r = (i / DM) % 256, k = i % DM;
        const float v = r < 48 ? p->in[I_NSAWIN][(size_t)L * DM * 2096 + (size_t)k * 2096 + 2048 + r] : 0.f;
        ((bf16_t*)(ws + WS_WNSAIN))[(size_t)L * NNSA * DM + (size_t)(2048 + r) * DM + k] = (bf16_t)f2bf(v); }
    { const f32x4* x4 = (const f32x4*)p->in[I_X]; u32x2* o = (u32x2*)(ws + WS_HBF);
      for (int i = gt; i < S_ * DM / 4; i += NGT) { const f32x4 v = x4[i]; u32x2 w; w.x = pk2(v[0], v[1]); w.y = pk2(v[2], v[3]); o[i] = w; } }
    { float* lut = (float*)(ws + WS_LUT);
      for (int i = gt; i < 16 * 2048; i += NGT) { const int h = i >> 11, d = i & 2047; lut[i] = p->in[I_RELB][rel_bucket_dev(d) * 16 + h]; } }
    { float* part = (float*)(ws + WS_CBP);
      for (int i = gt; i < 2 * 64 * 256; i += NGT) { const int mat = i / (64 * 256), ch = (i / 256) % 64, c = i % 256;
          const float* pos = p->in[mat ? I_POSV : I_POSK]; const float* w1 = p->in[mat ? I_CV1 : I_CK1]; float s = 0.f;
          for (int j = ch * 64; j < ch * 64 + 64; ++j) s += pos[j] * w1[(size_t)j * 256 + c];
          part[i] = s; } }
    { bf16_t* rk = (bf16_t*)(ws + WS_RAWK) + (size_t)4 * S_ * 128; bf16_t* rv = (bf16_t*)(ws + WS_RAWV) + (size_t)4 * S_ * 128;
      for (int i = gt; i < 32 * 128; i += NGT) { rk[i] = 0; rv[i] = 0; } }
}

__device__ __forceinline__ void ln_phase(const float* pre, const float* gam, const float* bet, float* h32, bf16_t* hbf) {
    int tid_ = threadIdx.x; asm volatile("" : "+v"(tid_));
    const int tid = tid_, lane = tid & 63, wave = tid >> 6;
    const int gw = blockIdx.x * 8 + wave, NGW = gridDim.x * 8;
    for (int row = gw; row < S_; row += NGW) {
        const f32x4* xr = (const f32x4*)(pre + (size_t)row * DM) + lane;
        f32x4 v[8]; float s = 0.f;
#pragma unroll
        for (int j = 0; j < 8; ++j) { v[j] = xr[64 * j]; s += (v[j][0] + v[j][1]) + (v[j][2] + v[j][3]); }
        const float mean = wave_sum(s) * (1.f / DM); float s2 = 0.f;
#pragma unroll
        for (int j = 0; j < 8; ++j) { v[j] = v[j] - mean; s2 += (v[j][0] * v[j][0] + v[j][1] * v[j][1]) + (v[j][2] * v[j][2] + v[j][3] * v[j][3]); }
        const float rstd = 1.f / sqrtf(wave_sum(s2) * (1.f / DM) + LN_EPS_);
        f32x4* o4 = (f32x4*)(h32 + (size_t)row * DM) + lane; u32x2* o2 = (u32x2*)(hbf + (size_t)row * DM) + lane;
#pragma unroll
        for (int j = 0; j < 8; ++j) { const f32x4 g4 = ((const f32x4*)gam)[lane + 64 * j], b4 = ((const f32x4*)bet)[lane + 64 * j];
            const f32x4 y = v[j] * rstd * g4 + b4; o4[64 * j] = y; u32x2 w; w.x = pk2(y[0], y[1]); w.y = pk2(y[2], y[3]); o2[64 * j] = w; }
    }
}

__device__ __forceinline__ void scan_phase(KP p, LAS unsigned char* lds, bool do_cbias) {
    int tid_ = threadIdx.x; asm volatile("" : "+v"(tid_));
    const int tid = tid_; unsigned char* ws = p->ws;
    if (blockIdx.x < 16) {
        const int h = blockIdx.x; const float* fl = (const float*)(ws + WS_FLOG); float* cum = (float*)(ws + WS_CUM) + (size_t)h * S_;
        LAS float* sh = (LAS float*)lds;
        float loc[32]; float tot = 0.f;
#pragma unroll
        for (int i = 0; i < 32; ++i) { loc[i] = fl[(size_t)(tid * 32 + i) * 16 + h]; }
#pragma unroll
        for (int i = 0; i < 32; ++i) { tot += loc[i]; loc[i] = tot; }
        sh[tid] = tot; __syncthreads();
        for (int off = 1; off < 512; off <<= 1) { const float v = tid >= off ? sh[tid - off] : 0.f; __syncthreads(); sh[tid] += v; __syncthreads(); }
        const float excl = sh[tid] - tot;
#pragma unroll
        for (int i = 0; i < 32; ++i) cum[tid * 32 + i] = excl + loc[i];
        __syncthreads();
    } else if (blockIdx.x == 16 && do_cbias) {
        const float* part = (const float*)(ws + WS_CBP); float* cb = (float*)(ws + WS_CB);
        const int mat = tid >> 8, c = tid & 255; float s = 0.f;
        for (int ch = 0; ch < 64; ++ch) s += part[(mat * 64 + ch) * 256 + c];
        cb[tid] = s;
    }
}

__device__ __forceinline__ void cmp2_phase(KP p) {
    int tid_ = threadIdx.x; asm volatile("" : "+v"(tid_));
    const int tid = tid_; unsigned char* ws = p->ws;
    const int rr = tid >> 7, d = tid & 127;
    for (int it = blockIdx.x; it < 2 * 1024; it += gridDim.x) {
        const int mat = it >> 10, row = (it & 1023) * 4 + rr;
        const bf16_t* hid = (const bf16_t*)(ws + WS_CH) + (size_t)mat * 4096 * 256 + (size_t)row * 256;
        const float* w2 = p->in[mat ? I_CV2 : I_CK2];
        float s = 0.f;
        for (int k = 0; k < 256; k += 2) { const unsigned hv = *(const unsigned*)(hid + k);
            s += __uint_as_float(hv << 16) * w2[k * 128 + d]; s += __uint_as_float(hv & 0xffff0000u) * w2[(k + 1) * 128 + d]; }
        if ((row & 1023) == 1023) s = 0.f;
        ((bf16_t*)(ws + (mat ? WS_VC : WS_KC)))[(size_t)row * 128 + d] = (bf16_t)f2bf(s);
    }
}

#define KSWZ(row, colB) ((row) * 256 + ((colB) ^ (((row) & 7) << 4)))
#define SBAR() __builtin_amdgcn_sched_barrier(0)
__device__ __forceinline__ int v_st(int k, int c) { const int kk = (k & ~0xC) | ((k & 4) << 1) | ((k & 8) >> 1); return ((kk >> 3) * 4 + (c >> 5)) * 512 + ((kk & 7) * 32 + (c & 31)) * 2; }
__device__ __forceinline__ int v_rd_base(int lane) { return ((lane & 3) << 3) | (((lane >> 2) & 3) << 6) | (((lane >> 4) & 1) << 5) | (((lane >> 5) & 1) << 8); }
constexpr int v_rd_off(int d0, int ks, int half) { return d0 * 512 + ks * 4096 + half * 2048; }
__device__ __forceinline__ int crow(int r, int hi) { return (r & 3) + 8 * (r >> 2) + 4 * hi; }

__device__ __forceinline__ void qkt(f32x16& p0, f32x16& p1, const LAS unsigned char* Kb, int r32, int hi, const bf16x8* qr) {
#pragma unroll
    for (int r = 0; r < 16; ++r) { p0[r] = 0.f; p1[r] = 0.f; }
    const LAS unsigned char* kb[4];
#pragma unroll
    for (int dd = 0; dd < 4; ++dd) kb[dd] = Kb + KSWZ(r32, (dd * 16 + hi * 8) * 2);
#pragma unroll
    for (int d0 = 0; d0 < 8; ++d0) { const LAS unsigned char* a = kb[d0 & 3] + (d0 >> 2) * 128;
        const bf16x8 b0 = *(const LAS bf16x8*)a;
        const bf16x8 b1 = *(const LAS bf16x8*)(a + 32 * 256);
        p0 = __builtin_amdgcn_mfma_f32_32x32x16_bf16(b0, qr[d0], p0, 0, 0, 0);
        p1 = __builtin_amdgcn_mfma_f32_32x32x16_bf16(b1, qr[d0], p1, 0, 0, 0); }
}
__device__ __forceinline__ void pv_tile(f32x16* o, int vb, bf16x8 pa0, bf16x8 pa1, bf16x8 pa2, bf16x8 pa3) {
#define TRRD(dst, off) asm volatile("ds_read_b64_tr_b16 %0, %1 offset:%2" : "=&v"(dst) : "v"(vb), "i"(off) : "memory")
#define PV_D0(d0) do { s16x4 l0, l1, l2, l3, h0, h1, h2, h3; constexpr int b_ = v_rd_off(d0, 0, 0); \
        TRRD(l0, b_); TRRD(h0, b_ + 2048); TRRD(l1, b_ + 4096); TRRD(h1, b_ + 6144); TRRD(l2, b_ + 8192); TRRD(h2, b_ + 10240); TRRD(l3, b_ + 12288); TRRD(h3, b_ + 14336); \
        asm volatile("s_waitcnt lgkmcnt(0)" ::: "memory"); SBAR(); \
        o[d0] = __builtin_amdgcn_mfma_f32_32x32x16_bf16(pa0, (bf16x8){l0[0], l0[1], l0[2], l0[3], h0[0], h0[1], h0[2], h0[3]}, o[d0], 0, 0, 0);   \
        o[d0] = __builtin_amdgcn_mfma_f32_32x32x16_bf16(pa1, (bf16x8){l1[0], l1[1], l1[2], l1[3], h1[0], h1[1], h1[2], h1[3]}, o[d0], 0, 0, 0);   \
        o[d0] = __builtin_amdgcn_mfma_f32_32x32x16_bf16(pa2, (bf16x8){l2[0], l2[1], l2[2], l2[3], h2[0], h2[1], h2[2], h2[3]}, o[d0], 0, 0, 0);   \
        o[d0] = __builtin_amdgcn_mfma_f32_32x32x16_bf16(pa3, (bf16x8){l3[0], l3[1], l3[2], l3[3], h3[0], h3[1], h3[2], h3[3]}, o[d0], 0, 0, 0); } while (0)
    PV_D0(0); PV_D0(1); PV_D0(2); PV_D0(3);
#undef PV_D0
#undef TRRD
}
__device__ __forceinline__ void p_to_frags(const f32x16& p0, const f32x16& p1, bf16x8& pa0, bf16x8& pa1, bf16x8& pa2, bf16x8& pa3) {
#define PK4(P, B_, OUT) do { unsigned a0 = cvt_pk_bf16(P[B_+0], P[B_+1]), a1 = cvt_pk_bf16(P[B_+2], P[B_+3]);                          \
        unsigned b0 = cvt_pk_bf16(P[B_+4], P[B_+5]), b1 = cvt_pk_bf16(P[B_+6], P[B_+7]);                                             \
        auto r0 = __builtin_amdgcn_permlane32_swap(a0, b0, false, false); auto r1 = __builtin_amdgcn_permlane32_swap(a1, b1, false, false); \
        u32x4 w = {r0[0], r1[0], r0[1], r1[1]}; OUT = *reinterpret_cast<bf16x8*>(&w); } while (0)
    PK4(p0, 0, pa0); PK4(p0, 8, pa1); PK4(p1, 0, pa2); PK4(p1, 8, pa3);
#undef PK4
}
__device__ __forceinline__ float half_swap_max(float v) { auto rr = __builtin_amdgcn_permlane32_swap(__float_as_uint(v), __float_as_uint(v), false, false); return fmaxf(__uint_as_float(rr[0]), __uint_as_float(rr[1])); }
__device__ __forceinline__ float half_swap_sum(float v) { auto rr = __builtin_amdgcn_permlane32_swap(__float_as_uint(v), __float_as_uint(v), false, false); return __uint_as_float(rr[0]) + __uint_as_float(rr[1]); }
__device__ __forceinline__ float online_sm(f32x16& p0, f32x16& p1, float& m, float& l) {
    float pmax = p0[0];
#pragma unroll
    for (int r = 1; r < 16; ++r) pmax = fmaxf(pmax, p0[r]);
#pragma unroll
    for (int r = 0; r < 16; ++r) pmax = fmaxf(pmax, p1[r]);
    pmax = half_swap_max(pmax);
    const float mn = fmaxf(m, pmax); const float alpha = __builtin_amdgcn_exp2f((m - mn) * L2E); m = mn;
    const float mnL = -mn * L2E; float ps = 0.f;
#pragma unroll
    for (int r = 0; r < 16; ++r) { p0[r] = __builtin_amdgcn_exp2f(fmaf(p0[r], L2E, mnL)); p1[r] = __builtin_amdgcn_exp2f(fmaf(p1[r], L2E, mnL)); ps += p0[r] + p1[r]; }
    ps = half_swap_sum(ps);
    l = l * alpha + ps;
    return alpha;
}

struct FL {
    const bf16_t* K; const bf16_t* V; int kstride, vstride;
    int j_lo, j_hi;
    const float* cum; float cq;
    int t_lane, t_w0;
    const LAS float* lut;
    __half* imp;
};
template <int MODE>
__device__ __forceinline__ void flash_loop(LAS unsigned char* lds, const FL& a, const bf16x8* qr, float& m, float& l, f32x16* o, float inv_l) {
    int tid_ = threadIdx.x; asm volatile("" : "+v"(tid_));
    const int tid = tid_, wid = __builtin_amdgcn_readfirstlane(tid >> 6), lane = tid & 63, r32 = lane & 31, hi = lane >> 5;
    LAS unsigned char* V_lds = lds + L_V; LAS unsigned char* K_lds = lds + L_K;
    LAS float* al_l = (LAS float*)(lds + L_WS) + wid * 64 + 32;
    LAS float* ckb = (LAS float*)(lds + L_CK);
    const int sr = tid >> 4, sc = (tid & 15) * 8, vst0 = v_st(sr, sc), vst1 = v_st(32 + sr, sc), kws = KSWZ(sr, sc * 2);
    const int vb0 = (int)(size_t)V_lds + v_rd_base(lane);
    constexpr bool HASV = (MODE != 1);
    bf16x8 sk0, sk1, sv0, sv1; float sck = 0.f;
    const float NEG = -__builtin_inff();
    float carry = 0.f;
#define FL_LOAD(j) do { const int kb_ = (j) * 64; \
        sk0 = *(const bf16x8*)(a.K + (size_t)(kb_ + sr) * a.kstride + sc); sk1 = *(const bf16x8*)(a.K + (size_t)(kb_ + 32 + sr) * a.kstride + sc); \
        if (HASV) { sv0 = *(const bf16x8*)(a.V + (size_t)(kb_ + sr) * a.vstride + sc); sv1 = *(const bf16x8*)(a.V + (size_t)(kb_ + 32 + sr) * a.vstride + sc); } \
        if (MODE == 0) { if (tid < 64) sck = a.cum[kb_ + tid]; } } while (0)
#define FL_WRITE(buf) do { *(LAS bf16x8*)(K_lds + (buf) * SHM_K + kws) = sk0; *(LAS bf16x8*)(K_lds + (buf) * SHM_K + kws + 32 * 256) = sk1; \
        if (HASV) { *(LAS bf16x8*)(V_lds + (buf) * SHM_V + vst0) = sv0; *(LAS bf16x8*)(V_lds + (buf) * SHM_V + vst1) = sv1; } \
        if (MODE == 0) { if (tid < 64) ckb[(buf) * 64 + tid] = sck; } } while (0)
    __syncthreads();
    FL_LOAD(a.j_lo); FL_WRITE(0); __syncthreads();
#pragma nounroll
    for (int j = a.j_lo; j < a.j_hi; ++j) {
        const int buf = (j - a.j_lo) & 1; const int kb = j * 64;
        if (j + 1 < a.j_hi) FL_LOAD(j + 1);
        const bool act = (MODE != 0) || (kb <= a.t_w0 + 31);
        if (act) {
            f32x16 p0, p1;
            qkt(p0, p1, K_lds + buf * SHM_K, r32, hi, qr);
            if (MODE == 0) {
#pragma unroll
                for (int i = 0; i < 4; ++i) { const f32x4 c0 = *(const LAS f32x4*)(ckb + buf * 64 + 4 * hi + 8 * i), c1 = *(const LAS f32x4*)(ckb + buf * 64 + 32 + 4 * hi + 8 * i);
#pragma unroll
                    for (int e = 0; e < 4; ++e) { p0[4 * i + e] += a.cq - c0[e]; p1[4 * i + e] += a.cq - c1[e]; } }
                if (kb + 63 > a.t_w0) { const int dq = a.t_lane - kb - 4 * hi;
#pragma unroll
                    for (int r = 0; r < 16; ++r) { const int c = (r & 3) + 8 * (r >> 2); if (dq - c < 0) p0[r] = NEG; if (dq - c - 32 < 0) p1[r] = NEG; } }
            } else if (MODE == 1 || MODE == 2) {
                const int dq = a.t_lane - 16 * kb - 31 - 64 * hi;
#pragma unroll
                for (int r = 0; r < 16; ++r) { const int d0_ = dq - 16 * (r & 3) - 128 * (r >> 2), d1_ = d0_ - 512;
                    const unsigned i0 = (unsigned)d0_ < 2047u ? (unsigned)d0_ : 2047u, i1 = (unsigned)d1_ < 2047u ? (unsigned)d1_ : 2047u;
                    const float b0 = a.lut[i0], b1 = a.lut[i1];
                    p0[r] = d0_ >= 0 ? p0[r] + b0 : NEG; p1[r] = d1_ >= 0 ? p1[r] + b1 : NEG; }
            } else {
                const int dq = a.t_lane - kb - 4 * hi;
#pragma unroll
                for (int r = 0; r < 16; ++r) { const int d0_ = dq - ((r & 3) + 8 * (r >> 2)), d1_ = d0_ - 32;
                    const unsigned i0 = (unsigned)d0_ < 2047u ? (unsigned)d0_ : 2047u, i1 = (unsigned)d1_ < 2047u ? (unsigned)d1_ : 2047u;
                    const float b0 = a.lut[i0], b1 = a.lut[i1];
                    p0[r] = (unsigned)d0_ < 512u ? p0[r] + b0 : NEG; p1[r] = (unsigned)d1_ < 512u ? p1[r] + b1 : NEG; }
            }
            if (MODE == 1) { (void)online_sm(p0, p1, m, l); }
            else if (MODE == 2) {
                const float mnL = -m * L2E;
#pragma unroll
                for (int r = 0; r < 16; ++r) { p0[r] = __builtin_amdgcn_exp2f(fmaf(p0[r], L2E, mnL)) * inv_l; p1[r] = __builtin_amdgcn_exp2f(fmaf(p1[r], L2E, mnL)) * inv_l; }
                float a0[4], a1[4], x0[4], x1[4];
#pragma unroll
                for (int i = 0; i < 4; ++i) { a0[i] = (p0[4 * i] + p0[4 * i + 1]) + (p0[4 * i + 2] + p0[4 * i + 3]); a1[i] = (p1[4 * i] + p1[4 * i + 1]) + (p1[4 * i + 2] + p1[4 * i + 3]);
                    x0[i] = __shfl_xor(p0[4 * i + 3], 32); x1[i] = __shfl_xor(p1[4 * i + 3], 32); }
                __half* ip = a.imp + 16 * j + hi;
#pragma unroll
                for (int i = 0; i < 4; ++i) { const float e0 = hi ? x0[i] : (i ? x0[i > 0 ? i - 1 : 0] : carry); const float e1 = hi ? x1[i] : (i ? x1[i > 0 ? i - 1 : 0] : x0[3]);
                    ip[2 * i] = __float2half(a0[i] + e0); ip[8 + 2 * i] = __float2half(a1[i] + e1); }
                carry = x1[3];
                bf16x8 pa0, pa1, pa2, pa3; p_to_frags(p0, p1, pa0, pa1, pa2, pa3);
                pv_tile(o, vb0 + buf * SHM_V, pa0, pa1, pa2, pa3);
            } else {
                const float alpha = online_sm(p0, p1, m, l);
                if (__any(alpha < 1.f)) { if (hi == 0) al_l[r32] = alpha; asm volatile("s_waitcnt lgkmcnt(0)" ::: "memory");
#pragma unroll
                    for (int d_ = 0; d_ < 4; ++d_)
#pragma unroll
                        for (int r = 0; r < 16; ++r) o[d_][r] *= al_l[crow(r, hi)]; }
                bf16x8 pa0, pa1, pa2, pa3; p_to_frags(p0, p1, pa0, pa1, pa2, pa3);
                pv_tile(o, vb0 + buf * SHM_V, pa0, pa1, pa2, pa3);
            }
        }
        if (j + 1 < a.j_hi) FL_WRITE(buf ^ 1);
        __syncthreads();
    }
#undef FL_LOAD
#undef FL_WRITE
}

__device__ __forceinline__ void fox_attn_phase(KP p, LAS unsigned char* lds) {
    const int wid = __builtin_amdgcn_readfirstlane(threadIdx.x >> 6);
    unsigned char* ws = p->ws;
    const bf16_t* Q = (const bf16_t*)(ws + WS_A); const bf16_t* K = Q + (size_t)S_ * DM; const bf16_t* V = K + (size_t)S_ * DM; bf16_t* O = (bf16_t*)(V + (size_t)S_ * DM);
    const float* cumall = (const float*)(ws + WS_CUM);
    LAS float* li_l = (LAS float*)(lds + L_WS) + wid * 64;
    for (int u = blockIdx.x; u < 512; u += gridDim.x) {
        const int h = u >> 5, x = u & 31;
        for (int pass = 0; pass < 2; ++pass) {
            const int qb = pass == 0 ? 63 - x : x;
            int tid_ = threadIdx.x; asm volatile("" : "+v"(tid_));
            const int lane = tid_ & 63, r32 = lane & 31, hi = lane >> 5;
            const int t_w0 = qb * 256 + wid * 32, t_lane = t_w0 + r32;
            bf16x8 qr[8];
#pragma unroll
            for (int d0 = 0; d0 < 8; ++d0) qr[d0] = *(const bf16x8*)(Q + (size_t)t_lane * DM + h * 128 + d0 * 16 + hi * 8);
            FL a; a.K = K + h * 128; a.V = V + h * 128; a.kstride = DM; a.vstride = DM; a.j_lo = 0; a.j_hi = qb * 4 + 4;
            a.cum = cumall + (size_t)h * S_; a.cq = a.cum[t_lane]; a.t_lane = t_lane; a.t_w0 = t_w0; a.lut = nullptr; a.imp = nullptr;
            float m = -1e30f, l = 0.f; f32x16 o[4];
#pragma unroll
            for (int d_ = 0; d_ < 4; ++d_)
#pragma unroll
                for (int r = 0; r < 16; ++r) o[d_][r] = 0.f;
            flash_loop<0>(lds, a, qr, m, l, o, 0.f);
            if (hi == 0) li_l[r32] = l; asm volatile("s_waitcnt lgkmcnt(0)" ::: "memory");
            bf16_t* Ow = O + (size_t)t_w0 * DM + h * 128;
            int lo_ = 4 * hi * DM + r32; asm volatile("" : "+v"(lo_));
#pragma unroll
            for (int r = 0; r < 16; ++r) { const int orow = crow(r, hi); const float rli = __builtin_amdgcn_rcpf(li_l[orow]);
#pragma unroll
                for (int d0 = 0; d0 < 4; ++d0) { const float v = o[d0][r] * rli; const float vn = __shfl_xor(v, 1);
                    if ((r32 & 1) == 0) *(unsigned*)(Ow + (lo_ + ((r & 3) + 8 * (r >> 2)) * DM + d0 * 32)) = cvt_pk_bf16(v, vn); } }
        }
    }
}

__device__ __forceinline__ void nsa_attn_phase(KP p, LAS unsigned char* lds) {
    const int tid = threadIdx.x, wid = __builtin_amdgcn_readfirstlane(tid >> 6);
    unsigned char* ws = p->ws;
    const bf16_t* Q = (const bf16_t*)(ws + WS_A); bf16_t* attn = (bf16_t*)(ws + WS_A) + (size_t)S_ * DM; __half* imp = (__half*)(ws + WS_A + 128 * MiB);
    float* partial = (float*)(ws + WS_PRE); const float* gates = (const float*)(ws + WS_GATE);
    const bf16_t* kv = (const bf16_t*)(ws + WS_KV); const bf16_t* kc = (const bf16_t*)(ws + WS_KC); const bf16_t* vc = (const bf16_t*)(ws + WS_VC);
    const bf16_t* vt = (const bf16_t*)(ws + WS_VT); const float* lutg = (const float*)(ws + WS_LUT);
    LAS float* lut = (LAS float*)(lds + L_LUT);
    LAS float* li_l = (LAS float*)(lds + L_WS) + wid * 64;
    const float NEG = -__builtin_inff();
    for (int u = blockIdx.x; u < 512; u += gridDim.x) {
        const int g = u >> 7, x = u & 127;
        __syncthreads();
        for (int i = tid; i < 4 * 2048; i += 512) lut[i] = lutg[g * 4 * 2048 + i];
        __syncthreads();
        for (int pass = 0; pass < 2; ++pass) {
            const int tile = pass == 0 ? 255 - x : x; const int t0 = tile * 64;
            {
                const int r = wid & 3, th = wid >> 2, h = g * 4 + r;
                int tid_ = threadIdx.x; asm volatile("" : "+v"(tid_));
                const int lane = tid_ & 63, r32 = lane & 31, hi = lane >> 5;
                const int t_w0 = t0 + 32 * th, t_lane = t_w0 + r32;
                bf16x8 qr[8];
#pragma unroll
                for (int d0 = 0; d0 < 8; ++d0) qr[d0] = *(const bf16x8*)(Q + (size_t)t_lane * DM + h * 128 + d0 * 16 + hi * 8);
                const float g0 = gates[(size_t)t_lane * 48 + h * 3 + 0], g2 = gates[(size_t)t_lane * 48 + h * 3 + 2];
                FL a; a.K = kc + (size_t)g * 1024 * 128; a.V = vc + (size_t)g * 1024 * 128; a.kstride = 128; a.vstride = 128; a.j_lo = 0; a.j_hi = (t0 / 16 + 2) / 64 + 1;
                a.cum = nullptr; a.cq = 0.f; a.t_lane = t_lane; a.t_w0 = t_w0; a.lut = lut + r * 2048; a.imp = imp + ((size_t)h * S_ + t_lane) * 256;
                float m = -1e30f, l = 0.f; f32x16 o[4];
#pragma unroll
                for (int d_ = 0; d_ < 4; ++d_)
#pragma unroll
                    for (int rr = 0; rr < 16; ++rr) o[d_][rr] = 0.f;
                flash_loop<1>(lds, a, qr, m, l, o, 0.f);
                const float inv_l = l > 0.f ? 1.f / l : 0.f;
                flash_loop<2>(lds, a, qr, m, l, o, inv_l);
                float* Pw = partial + (size_t)t_w0 * DM + h * 128;
                int lo_ = 4 * hi * DM + r32; asm volatile("" : "+v"(lo_));
                if (hi == 0) li_l[r32] = g0; asm volatile("s_waitcnt lgkmcnt(0)" ::: "memory");
#pragma unroll
                for (int rr = 0; rr < 16; ++rr) { const int orow = crow(rr, hi); const float f = li_l[orow];
#pragma unroll
                    for (int d0 = 0; d0 < 4; ++d0) Pw[lo_ + ((rr & 3) + 8 * (rr >> 2)) * DM + d0 * 32] = o[d0][rr] * f; }
                a.K = kv + 4 * 512 + g * 128; a.V = kv + 5 * 512 + g * 128; a.kstride = NKV; a.vstride = NKV; a.j_lo = tile >= 8 ? tile - 8 : 0; a.j_hi = tile + 1;
                m = -1e30f; l = 0.f;
#pragma unroll
                for (int d_ = 0; d_ < 4; ++d_)
#pragma unroll
                    for (int rr = 0; rr < 16; ++rr) o[d_][rr] = 0.f;
                flash_loop<3>(lds, a, qr, m, l, o, 0.f);
                asm volatile("s_waitcnt lgkmcnt(0)" ::: "memory");
                int lo2_ = 4 * hi * DM + r32; asm volatile("" : "+v"(lo2_));
                if (hi == 0) li_l[r32] = g2 * (l > 0.f ? 1.f / l : 0.f); asm volatile("s_waitcnt lgkmcnt(0)" ::: "memory");
#pragma unroll
                for (int rr = 0; rr < 16; ++rr) { const int orow = crow(rr, hi); const float f = li_l[orow];
#pragma unroll
                    for (int d0 = 0; d0 < 4; ++d0) { float* pp = Pw + (lo2_ + ((rr & 3) + 8 * (rr >> 2)) * DM + d0 * 32); *pp = *pp + o[d0][rr] * f; } }
            }
            __syncthreads();
            {
#pragma nounroll
                for (int tt = 0; tt < 8; ++tt) {
                    int tid_ = threadIdx.x; asm volatile("" : "+v"(tid_));
                    const int lane = tid_ & 63;
                    const int n = lane & 15, kq = lane >> 4, hn = n & 3; const bool hv = n < 4;
                    const LAS float* lutn = lut + hn * 2048;
                    const int t = t0 + 8 * wid + tt; const int blk = tile;
                    float sc[4] = {0.f, 0.f, 0.f, 0.f};
#pragma unroll
                    for (int r = 0; r < 4; ++r) { const u32x2 raw = *(const u32x2*)(imp + ((size_t)(g * 4 + r) * S_ + t) * 256 + lane * 4);
                        sc[0] += __half2float(__ushort_as_half((unsigned short)(raw.x & 0xffffu))); sc[1] += __half2float(__ushort_as_half((unsigned short)(raw.x >> 16)));
                        sc[2] += __half2float(__ushort_as_half((unsigned short)(raw.y & 0xffffu))); sc[3] += __half2float(__ushort_as_half((unsigned short)(raw.y >> 16))); }
#pragma unroll
                    for (int e = 0; e < 4; ++e) { const int j = lane * 4 + e; const bool forced = (j == 0) | (j == blk) | (j == blk - 1);
                        sc[e] = forced ? 1e4f : (j <= blk ? sc[e] : -1.f); }
                    int mysel = -1;
#pragma nounroll
                    for (int k = 0; k < 16; ++k) {
                        float bv = sc[0]; int be = 0;
#pragma unroll
                        for (int e = 1; e < 4; ++e) if (sc[e] > bv) { bv = sc[e]; be = e; }
                        const float wmax = wave_max(bv);
                        if (wmax < 0.f) break;
                        const unsigned long long msk = __ballot(bv == wmax);
                        const int src = __ffsll((long long)msk) - 1;
                        const int jw = __shfl(lane * 4 + be, src);
                        if (lane == k) mysel = jw;
                        if (lane == src) {
#pragma unroll
                            for (int e = 0; e < 4; ++e) if (be == e) sc[e] = -2.f; }
                    }
                    bf16x8 qb[4];
#pragma unroll
                    for (int ks = 0; ks < 4; ++ks) { qb[ks] = *(const bf16x8*)(Q + (size_t)t * DM + (g * 4 + hn) * 128 + 32 * ks + kq * 8);
                        if (!hv) qb[ks] = (bf16x8){0, 0, 0, 0, 0, 0, 0, 0}; }
                    float m = -1e30f, l = 0.f; f32x4 o[8];
#pragma unroll
                    for (int d_ = 0; d_ < 8; ++d_) o[d_] = (f32x4){0.f, 0.f, 0.f, 0.f};
#pragma nounroll
                    for (int b = 0; b < 16; ++b) {
                        const int sb = __builtin_amdgcn_readfirstlane(__shfl(mysel, b));
                        if (sb < 0) continue;
                        const bf16_t* Kp = kv + (size_t)(sb * 64 + n) * NKV + 2 * 512 + g * 128 + kq * 8;
                        f32x4 s[4];
#pragma unroll
                        for (int sub = 0; sub < 4; ++sub) { s[sub] = (f32x4){0.f, 0.f, 0.f, 0.f};
#pragma unroll
                            for (int ks = 0; ks < 4; ++ks) { const bf16x8 kf = *(const bf16x8*)(Kp + (size_t)(16 * sub) * NKV + 32 * ks);
                                s[sub] = __builtin_amdgcn_mfma_f32_16x16x32_bf16(kf, qb[ks], s[sub], 0, 0, 0); } }
                        const int dq = t - sb * 64 - 4 * kq; float pmax = NEG;
#pragma unroll
                        for (int sub = 0; sub < 4; ++sub)
#pragma unroll
                            for (int i = 0; i < 4; ++i) { const int d = dq - 16 * sub - i; const unsigned idx = (unsigned)d < 2047u ? (unsigned)d : 2047u;
                                const float v = d >= 0 ? s[sub][i] + lutn[idx] : NEG; s[sub][i] = v; pmax = fmaxf(pmax, v); }
                        pmax = fmaxf(pmax, __shfl_xor(pmax, 16)); pmax = fmaxf(pmax, __shfl_xor(pmax, 32));
                        const float mn = fmaxf(m, pmax); const float alpha = __builtin_amdgcn_exp2f((m - mn) * L2E); m = mn;
                        const float mnL = -mn * L2E; float ps = 0.f;
#pragma unroll
                        for (int sub = 0; sub < 4; ++sub)
#pragma unroll
                            for (int i = 0; i < 4; ++i) { s[sub][i] = __builtin_amdgcn_exp2f(fmaf(s[sub][i], L2E, mnL)); ps += s[sub][i]; }
                        ps += __shfl_xor(ps, 16); ps += __shfl_xor(ps, 32);
                        l = l * alpha + ps;
#pragma unroll
                        for (int d_ = 0; d_ < 8; ++d_) o[d_] = o[d_] * alpha;
                        bf16x8 pb[2];
                        { const u32x4 w0 = pack8bf(s[0], s[1]), w1 = pack8bf(s[2], s[3]); pb[0] = *reinterpret_cast<const bf16x8*>(&w0); pb[1] = *reinterpret_cast<const bf16x8*>(&w1); }
                        const bf16_t* Vp = vt + ((size_t)g * 128 + n) * S_ + sb * 64 + kq * 8;
#pragma unroll
                        for (int d_ = 0; d_ < 8; ++d_)
#pragma unroll
                            for (int s2 = 0; s2 < 2; ++s2) { const bf16x8 vf = *(const bf16x8*)(Vp + (size_t)(16 * d_) * S_ + 32 * s2);
                                o[d_] = __builtin_amdgcn_mfma_f32_16x16x32_bf16(vf, pb[s2], o[d_], 0, 0, 0); }
                    }
                    const float g1 = gates[(size_t)t * 48 + (g * 4 + hn) * 3 + 1];
                    const float f = g1 * (l > 0.f ? 1.f / l : 0.f);
                    if (hv) {
#pragma unroll
                        for (int d_ = 0; d_ < 8; ++d_) { const size_t off = (size_t)t * DM + (g * 4 + n) * 128 + 16 * d_ + 4 * kq;
                            const f32x4 pp = *(const f32x4*)(partial + off); const f32x4 r4 = pp + o[d_] * f;
                            u32x2 w; w.x = cvt_pk_bf16(r4[0], r4[1]); w.y = cvt_pk_bf16(r4[2], r4[3]); *(u32x2*)(attn + off) = w; }
                    }
                }
            }
        }
    }
}

#define RUN_GEMM(EpiT, epi, Aptr, Btptr, Mv, Nv, Kv, ldav, cidx) do { const pg8::Gemm g_{(Aptr), (Btptr), (Mv), (Nv), (Kv), (ldav)}; pg8::StaticOrder so_; so_.init((Mv), (Nv), (int)gridDim.x, (cidx)); \
        pg8::gemm_phase<EpiT, pg8::StaticOrder, true, true>(lds, g_, so_, (epi)); } while (0)

__global__ void __launch_bounds__(512, 2) mega_fwd(Params p_unused) {
    extern __shared__ __attribute__((aligned(16))) unsigned char lds_raw[];
    LAS unsigned char* lds = (LAS unsigned char*)lds_raw;
    cg::grid_group grid = cg::this_grid();
    const size_t SD = (size_t)S_ * DM;
#define WSP(off) (KARGS()->ws + (off))
    prologue(KARGS(), lds);
    grid.sync();
#pragma nounroll
    for (int L = 0; L < 4; ++L) {
        const int bid = (int)blockIdx.x, G = (int)gridDim.x;
        if (L < 2) {
            { KP p = KARGS(); unsigned char* ws = p->ws; bf16_t* A0 = (bf16_t*)(ws + WS_A);
              EpiFoxQKV E{A0, (float*)(ws + WS_FLOG), p->in[I_FOXBF] + L * 16};
              RUN_GEMM(EpiFoxQKV, E, (const bf16_t*)(ws + WS_HBF), (const bf16_t*)(ws + WS_WFOXIN) + (size_t)L * NFOX * DM, S_, NFOX, DM, DM, bid); }
            grid.sync();
            scan_phase(KARGS(), lds, L == 0);
            grid.sync();
            fox_attn_phase(KARGS(), lds);
            grid.sync();
        } else {
            if (L == 2) {
                { KP p = KARGS(); unsigned char* ws = p->ws;
                  EpiKV E{(bf16_t*)(ws + WS_KV), (bf16_t*)(ws + WS_RAWK), (bf16_t*)(ws + WS_RAWV), (bf16_t*)(ws + WS_VT)};
                  RUN_GEMM(EpiKV, E, (const bf16_t*)(ws + WS_HBF), (const bf16_t*)(ws + WS_WKV), S_, NKV, DM, DM, bid); }
                grid.sync();
#pragma nounroll
                for (int mat = 0; mat < 2; ++mat) { KP p = KARGS(); unsigned char* ws = p->ws;
                    EpiCmp1 E{(bf16_t*)(ws + WS_CH) + (size_t)mat * 4096 * 256, (const float*)(ws + WS_CB) + mat * 256};
                    RUN_GEMM(EpiCmp1, E, (const bf16_t*)(ws + (mat ? WS_RAWV : WS_RAWK)), (const bf16_t*)(ws + WS_WC1) + (size_t)mat * 256 * 4096, 4096, 256, 4096, 2048, (bid + G - 16 * mat) % G);
                }
                grid.sync();
                cmp2_phase(KARGS());
                grid.sync();
            }
            { KP p = KARGS(); unsigned char* ws = p->ws;
              EpiNsaQ E{(bf16_t*)(ws + WS_A), (float*)(ws + WS_GATE)};
              RUN_GEMM(EpiNsaQ, E, (const bf16_t*)(ws + WS_HBF), (const bf16_t*)(ws + WS_WNSAIN) + (size_t)(L - 2) * NNSA * DM, S_, NNSA, DM, DM, bid); }
            grid.sync();
            nsa_attn_phase(KARGS(), lds);
            grid.sync();
        }
        { KP p = KARGS(); unsigned char* ws = p->ws; bf16_t* A0 = (bf16_t*)(ws + WS_A);
          const float* hres = L == 0 ? p->in[I_X] : p->out;
          const bf16_t* attn = L < 2 ? A0 + 3 * SD : A0 + SD;
          const bf16_t* wo = L < 2 ? (const bf16_t*)(ws + WS_WFOXO) + (size_t)L * DM * DM : (const bf16_t*)(ws + WS_WNSAO) + (size_t)(L - 2) * DM * DM;
          EpiRes E{hres, (float*)(ws + WS_PRE)}; RUN_GEMM(EpiRes, E, attn, wo, S_, DM, DM, DM, bid); }
        grid.sync();
        { KP p = KARGS(); ln_phase((const float*)(p->ws + WS_PRE), p->in[I_LN1G] + L * DM, p->in[I_LN1B] + L * DM, p->out, (bf16_t*)(p->ws + WS_HBF)); }
        grid.sync();
        { KP p = KARGS(); unsigned char* ws = p->ws;
          EpiRelu2 E{(bf16_t*)(ws + WS_A)}; RUN_GEMM(EpiRelu2, E, (const bf16_t*)(ws + WS_HBF), (const bf16_t*)(ws + WS_W1) + (size_t)L * FF * DM, S_, FF, DM, DM, bid); }
        grid.sync();
        { KP p = KARGS(); unsigned char* ws = p->ws;
          EpiRes E{p->out, (float*)(ws + WS_PRE)}; RUN_GEMM(EpiRes, E, (const bf16_t*)(ws + WS_A), (const bf16_t*)(ws + WS_W2) + (size_t)L * DM * FF, S_, DM, FF, FF, bid); }
        grid.sync();
        { KP p = KARGS(); ln_phase((const float*)(p->ws + WS_PRE), p->in[I_LN2G] + L * DM, p->in[I_LN2B] + L * DM, p->out, (bf16_t*)(p->ws + WS_HBF)); }
        grid.sync();
    }
}

extern "C" void kernel_launch(void* const* d_in, const int* in_sizes, int n_in, void* d_out, int out_size, void* d_ws, size_t ws_size, hipStream_t stream) {
    static int grid = 0;
    if (grid == 0) {
        if (n_in != 20 || out_size != S_ * DM || ws_size < WS_END) { fprintf(stderr, "kernel_launch: unexpected shapes (n_in %d out %d ws %zu)\n", n_in, out_size, ws_size); grid = -1; return; }
        int dev = 0, cus = 0, per_cu = 0;
        (void)hipGetDevice(&dev); (void)hipDeviceGetAttribute(&cus, hipDeviceAttributeMultiprocessorCount, dev);
        if (hipFuncSetAttribute((const void*)mega_fwd, hipFuncAttributeMaxDynamicSharedMemorySize, LDS_BYTES) != hipSuccess) fprintf(stderr, "kernel_launch: hipFuncSetAttribute failed\n");
        if (hipOccupancyMaxActiveBlocksPerMultiprocessor(&per_cu, (const void*)mega_fwd, 512, LDS_BYTES) != hipSuccess || per_cu < 1) per_cu = 1;
        (void)hipGetLastError();
        if (cus <= 0) cus = 256;
        grid = cus * per_cu;
    }
    if (grid < 0) return;
    Params p{};
    for (int i = 0; i < 20; ++i) p.in[i] = (const float*)d_in[i];
    p.out = (float*)d_out; p.ws = (unsigned char*)d_ws;
    void* args[] = {&p};
    hipError_t e = hipLaunchCooperativeKernel((const void*)mega_fwd, dim3(grid), dim3(512), args, LDS_BYTES, stream);
    if (e != hipSuccess) fprintf(stderr, "kernel_launch: cooperative launch failed: %s (grid %d)\n", hipGetErrorString(e), grid);
}
```

```cpp
#include <hip/hip_runtime.h>
#include <hip/hip_cooperative_groups.h>
#include <hip/hip_fp16.h>
#include <cstdio>
#include <cstdint>
namespace cg = cooperative_groups;
namespace pg8 {
#define PG8_LAS __attribute__((address_space(3)))
typedef unsigned short bf16_t;
typedef short bf16x8 __attribute__((ext_vector_type(8)));
typedef float f32x4 __attribute__((ext_vector_type(4)));
typedef unsigned u32x4 __attribute__((ext_vector_type(4)));
constexpr int BM = 256, BK = 64, HALF = 128, HTB = HALF * BK * 2  , STAGE_BYTES = 8 * HTB, NXCD = 8, WGM = 8;

__host__ __device__ __forceinline__ int lds_byte(int r, int c) { const int st = (r >> 4) * 2 + (c >> 5), rr = r & 15, cc = c & 31, ob = rr * 64 + cc * 2; return st * 1024 + (ob ^ (((ob >> 9) & 1) << 5)); }
__host__ __device__ __forceinline__ void stage_rc(int b, int& R, int& C) { const int st = b / 1024, sb = b % 1024, swz = sb ^ (((sb >> 9) & 1) << 5); R = (st >> 1) * 16 + swz / 64; C = (st & 1) * 32 + (swz % 64) / 2; }
__host__ __device__ __forceinline__ int perm32(int rho) { const int n = rho >> 4, i = rho & 15; return 8 * (i >> 2) + 4 * n + (i & 3); }

struct Unit { int pm, pn; };
struct Gemm { const bf16_t* A; const bf16_t* Bt; int M, N, K, lda; };

struct StaticOrder {
    int nM, nN, nwg, G, c;
    __host__ __device__ void init(int M, int N, int G_, int c_) { nM = M / BM; nN = N / BM; nwg = nM * nN; G = G_; c = c_; }
    __host__ __device__ bool next(int i, Unit& u) const {
        const long L = (long)i * G + c; if (L >= nwg) return false;
        int wgid = (int)L; { const int q = nwg / NXCD, r = nwg % NXCD, xcd = wgid % NXCD, off = wgid / NXCD; wgid = (xcd < r ? xcd * (q + 1) : r * (q + 1) + (xcd - r) * q) + off; }
        const int nig = WGM * nN, gid = wgid / nig, fm = gid * WGM, gsz = (nM - fm) < WGM ? (nM - fm) : WGM;
        u.pm = fm + ((wgid % nig) % gsz); u.pn = (wgid % nig) / gsz; return true;
    }
    __device__ __forceinline__ void a_ready(const Unit&) const {}
    __device__ __forceinline__ void done(const Unit&) const {}
};


__device__ __forceinline__ unsigned cvt_pk_bf16(float lo, float hi) { unsigned r; asm volatile("v_cvt_pk_bf16_f32 %0, %1, %2" : "=v"(r) : "v"(lo), "v"(hi)); return r; }
typedef float f32x2 __attribute__((ext_vector_type(2)));
template <class Epi, class Sched, bool ALIGN_EPI = false, bool SP2 = false>
__device__ __forceinline__ void gemm_phase(PG8_LAS unsigned char* lds, const Gemm g, const Sched& S, const Epi& E) {
    int tid_ = threadIdx.x; asm volatile("" : "+v"(tid_));
    const int tid = tid_, wid = __builtin_amdgcn_readfirstlane(tid >> 6), lane = tid & 63, wr = wid >> 2, wc = wid & 3, fr = lane & 15, fq = lane >> 4;
    const int K = g.K, nt = K / BK;
    unsigned voffA[2], voffB[2];
#pragma unroll
    for (int i = 0; i < 2; ++i) { int R, C; stage_rc(tid * 16 + i * 8192, R, C); const int Rb = Epi::PERM ? ((R & ~31) + perm32(R & 31)) : R;
        voffA[i] = (unsigned)(R * g.lda + C) * 2u; voffB[i] = (unsigned)(Rb * K + C) * 2u; }
    const size_t kstep = (size_t)(BK * 2);
    const size_t hstepB = (size_t)HALF * K * 2, hstepA = (size_t)HALF * g.lda * 2;
    const size_t tstepB = 2 * hstepB, tstepA = 2 * hstepA;
    const unsigned ldsw = (unsigned)wid * 1024u;
    const int aoff = lds_byte(wr * 64 + fr, fq * 8), boff = lds_byte(wc * 32 + fr, fq * 8);
#define PG8_SA(b, h) (((b) * 2 + (h)) * HTB)
#define PG8_SB(b, h) ((4 + (b) * 2 + (h)) * HTB)
#define PG8_STAGE(bufoff, gbase, voff) do { _Pragma("unroll") for (int _i = 0; _i < 2; ++_i) \
        __builtin_amdgcn_global_load_lds((const unsigned*)((const char*)(gbase) + (voff)[_i]), (PG8_LAS unsigned*)(lds + (bufoff) + ldsw + _i * 8192), 16, 0, 0); } while (0)
#define PG8_LDA(dst, b, h) do { _Pragma("unroll") for (int m = 0; m < 4; ++m) _Pragma("unroll") for (int k = 0; k < 2; ++k) dst[m][k] = *(const PG8_LAS bf16x8*)(lds + PG8_SA(b, h) + aoff + m * 2048 + k * 1024); } while (0)
#define PG8_LDB(dst, b, h) do { _Pragma("unroll") for (int n = 0; n < 2; ++n) _Pragma("unroll") for (int k = 0; k < 2; ++k) dst[n][k] = *(const PG8_LAS bf16x8*)(lds + PG8_SB(b, h) + boff + n * 2048 + k * 1024); } while (0)
#define PG8_MMA(ai, bj, At, Bt) do { __builtin_amdgcn_s_setprio(1); _Pragma("unroll") for (int m = 0; m < 4; ++m) _Pragma("unroll") for (int n = 0; n < 2; ++n) _Pragma("unroll") for (int k = 0; k < 2; ++k) \
        acc[ai][bj][m][n] = __builtin_amdgcn_mfma_f32_16x16x32_bf16(Bt[n][k], At[m][k], acc[ai][bj][m][n], 0, 0, 0); __builtin_amdgcn_s_setprio(0); } while (0)
#define PG8_WAIT_V(n) asm volatile("s_waitcnt vmcnt(" #n ")" ::: "memory")
#define PG8_WAIT_L(n) asm volatile("s_waitcnt lgkmcnt(" #n ")" ::: "memory")
#define PG8_BAR __builtin_amdgcn_s_barrier()
#define PG8_SCHED __builtin_amdgcn_sched_barrier(0)
    Unit cur, nxt; int ui = 0;
    if (!S.next(0, cur)) return;
    f32x4 acc[2][2][4][2];
#pragma unroll
    for (int a = 0; a < 2; ++a)
#pragma unroll
        for (int b = 0; b < 2; ++b)
#pragma unroll
            for (int m = 0; m < 4; ++m)
#pragma unroll
                for (int n = 0; n < 2; ++n) acc[a][b][m][n] = (f32x4){0.f, 0.f, 0.f, 0.f};
    bf16x8 At[4][2], B0[2][2], B1[2][2];
    const char* cA = (const char*)g.A + (size_t)cur.pm * tstepA; const char* cB = (const char*)g.Bt + (size_t)cur.pn * tstepB;
    S.a_ready(cur);
    if constexpr (SP2) {
        PG8_STAGE(PG8_SB(0, 0), cB, voffB); PG8_STAGE(PG8_SB(0, 1), cB + hstepB, voffB); PG8_STAGE(PG8_SA(0, 0), cA, voffA); PG8_STAGE(PG8_SA(0, 1), cA + hstepA, voffA);
        if (wr == 1) PG8_BAR;
        PG8_WAIT_V(2); PG8_BAR;
        PG8_STAGE(PG8_SB(1, 0), cB + kstep, voffB); PG8_STAGE(PG8_SA(1, 0), cA + kstep, voffA); PG8_STAGE(PG8_SB(1, 1), cB + hstepB + kstep, voffB);
        PG8_WAIT_V(6); PG8_BAR;
    } else {
        PG8_STAGE(PG8_SB(0, 0), cB, voffB); PG8_STAGE(PG8_SA(0, 0), cA, voffA); PG8_STAGE(PG8_SB(0, 1), cB + hstepB, voffB); PG8_STAGE(PG8_SA(0, 1), cA + hstepA, voffA);
        if (wr == 1) PG8_BAR;
        PG8_WAIT_V(4); PG8_BAR;
        PG8_STAGE(PG8_SB(1, 0), cB + kstep, voffB); PG8_STAGE(PG8_SA(1, 0), cA + kstep, voffA); PG8_STAGE(PG8_SB(1, 1), cB + hstepB + kstep, voffB);
        PG8_WAIT_V(6); PG8_BAR;
    }
    for (;;) {
        const bool has_next = S.next(ui + 1, nxt);
        const char* nA = has_next ? (const char*)g.A + (size_t)nxt.pm * tstepA : cA; const char* nB = has_next ? (const char*)g.Bt + (size_t)nxt.pn * tstepB : cB;
        for (int t = 0; t < nt; t += 2) {
            const bool last = (t == nt - 2);
            const char* a1 = cA + (size_t)(t + 1) * kstep;
            const char* a2 = last ? nA : cA + (size_t)(t + 2) * kstep; const char* b2 = last ? nB : cB + (size_t)(t + 2) * kstep;
            const char* a3 = a2 + kstep; const char* b3 = b2 + kstep;
            if (last && has_next) S.a_ready(nxt);
            if constexpr (SP2) {
            PG8_LDB(B0, 0, 0); PG8_LDB(B1, 0, 1); PG8_SCHED; PG8_LDA(At, 0, 0); PG8_STAGE(PG8_SA(1, 1), a1 + hstepA, voffA);
            PG8_WAIT_V(8); PG8_WAIT_L(0); PG8_BAR; PG8_MMA(0, 0, At, B0); PG8_MMA(0, 1, At, B1); PG8_BAR; PG8_SCHED;
            PG8_LDA(At, 0, 1); PG8_STAGE(PG8_SB(0, 0), b2, voffB); PG8_STAGE(PG8_SB(0, 1), b2 + hstepB, voffB); PG8_STAGE(PG8_SA(0, 0), a2, voffA);
            PG8_WAIT_V(8); PG8_WAIT_L(0); PG8_BAR; PG8_MMA(1, 0, At, B0); PG8_MMA(1, 1, At, B1); PG8_BAR; PG8_SCHED;
            PG8_LDB(B0, 1, 0); PG8_LDB(B1, 1, 1); PG8_SCHED; PG8_LDA(At, 1, 0); PG8_STAGE(PG8_SA(0, 1), a2 + hstepA, voffA);
            PG8_WAIT_V(8); PG8_WAIT_L(0); PG8_BAR; PG8_MMA(0, 0, At, B0); PG8_MMA(0, 1, At, B1); PG8_BAR; PG8_SCHED;
            PG8_LDA(At, 1, 1); PG8_STAGE(PG8_SB(1, 0), b3, voffB); PG8_STAGE(PG8_SB(1, 1), b3 + hstepB, voffB); PG8_STAGE(PG8_SA(1, 0), a3, voffA);
            PG8_WAIT_V(8); PG8_WAIT_L(0); PG8_BAR; PG8_MMA(1, 0, At, B0); PG8_MMA(1, 1, At, B1); PG8_BAR; PG8_SCHED;
            }
        }
        if constexpr (ALIGN_EPI) { if (wr == 0) PG8_BAR; }
        if constexpr (!Epi::AFTER_DRAIN) { E(acc, cur, wr, wc, fr, fq); S.done(cur); }
        if (!has_next) break;
#pragma unroll
        for (int a = 0; a < 2; ++a)
#pragma unroll
            for (int b = 0; b < 2; ++b)
#pragma unroll
                for (int m = 0; m < 4; ++m)
#pragma unroll
                    for (int n = 0; n < 2; ++n) acc[a][b][m][n] = (f32x4){0.f, 0.f, 0.f, 0.f};
        cur = nxt; cA = nA; cB = nB; ++ui;
        if constexpr (ALIGN_EPI) { if (wr == 1) PG8_BAR; }
    }
    PG8_WAIT_V(0);
    if constexpr (!ALIGN_EPI) { if (wr == 0) PG8_BAR; }
    PG8_BAR;
    if constexpr (Epi::AFTER_DRAIN) { E.fused(acc, cur, wr, wc, fr, fq, lds, wid, lane); S.done(cur); }
#undef PG8_SA
#undef PG8_SB
#undef PG8_STAGE
#undef PG8_LDA
#undef PG8_LDB
#undef PG8_MMA
#undef PG8_WAIT_V
#undef PG8_WAIT_L
#undef PG8_BAR
#undef PG8_SCHED
}
}

#define LAS __attribute__((address_space(3)))
using pg8::bf16_t; using pg8::bf16x8; using pg8::f32x4; using pg8::u32x4; using pg8::Unit; using pg8::cvt_pk_bf16;
typedef short s16x4 __attribute__((ext_vector_type(4)));
typedef float f32x16 __attribute__((ext_vector_type(16)));
typedef unsigned u32x2 __attribute__((ext_vector_type(2)));

constexpr int S_ = 16384, DM = 2048, FF = 8192, NH = 16, DH = 128, NG = 4;
constexpr int NFOX = 6400, NNSA = 2304, NKV = 3072;
constexpr float ALPHA_ = 1.6817928305074292f;
constexpr float QSCALE = 0.08838834764831845f;
constexpr float L2E = 1.4426950408889634f;
constexpr float LN_EPS_ = 1e-5f;

constexpr size_t MiB = 1u << 20;
constexpr size_t WS_WFOXIN = 0;
constexpr size_t WS_WFOXO  = 50 * MiB;
constexpr size_t WS_WNSAIN = 66 * MiB;
constexpr size_t WS_WNSAO  = 84 * MiB;
constexpr size_t WS_WKV    = 100 * MiB;
constexpr size_t WS_W1     = 112 * MiB;
constexpr size_t WS_W2     = 240 * MiB;
constexpr size_t WS_WC1    = 368 * MiB;
constexpr size_t WS_HBF    = 372 * MiB;
constexpr size_t WS_PRE    = 436 * MiB;
constexpr size_t WS_A      = 564 * MiB;
constexpr size_t WS_KV     = 820 * MiB;
constexpr size_t WS_RAWK   = 916 * MiB;
constexpr size_t WS_RAWV   = 933 * MiB;
constexpr size_t WS_VT     = 950 * MiB;
constexpr size_t WS_CH     = 966 * MiB;
constexpr size_t WS_KC     = 970 * MiB;
constexpr size_t WS_VC     = 971 * MiB;
constexpr size_t WS_CUM    = 972 * MiB;
constexpr size_t WS_FLOG   = 973 * MiB;
constexpr size_t WS_GATE   = 974 * MiB;
constexpr size_t WS_LUT    = 977 * MiB;
constexpr size_t WS_CBP    = 977 * MiB + 256 * 1024;
constexpr size_t WS_CB     = 977 * MiB + 512 * 1024;
constexpr size_t WS_NRM    = 977 * MiB + 768 * 1024;
constexpr size_t WS_END    = 978 * MiB;

constexpr int SHM_K = 16384, SHM_V = 16384;
constexpr int L_V = 0, L_K = 32768, L_WS = 65536, L_CK = 65536 + 2048, L_LUT = 69632, L_END = 69632 + 32768;
constexpr int LDS_BYTES = 147456;

__device__ __forceinline__ u32x4 pack8bf(f32x4 a, f32x4 b) { u32x4 w; w.x = cvt_pk_bf16(a[0], a[1]); w.y = cvt_pk_bf16(a[2], a[3]); w.z = cvt_pk_bf16(b[0], b[1]); w.w = cvt_pk_bf16(b[2], b[3]); return w; }
__device__ __forceinline__ float log_sigmoid_f(float x) { return fminf(x, 0.f) - log1pf(__expf(-fabsf(x))); }
__device__ __forceinline__ float sigmoid_f(float x) { return 1.f / (1.f + __expf(-x)); }
__device__ __forceinline__ float gelu_tanh_f(float x) { const float u = 0.7978845608028654f * (x + 0.044715f * x * x * x); const float t = 1.f - 2.f / (__expf(2.f * u) + 1.f); return 0.5f * x * (1.f + t); }

struct EpiFoxQKV {
    static constexpr bool PERM = true, AFTER_DRAIN = false;
    bf16_t* q; float* flog; const float* bfg;
    __device__ __forceinline__ void operator()(const f32x4 (&acc)[2][2][4][2], const Unit& u, int wr, int wc, int fr, int fq) const {
        const int row0 = u.pm * 256 + wr * 64 + fr; const int colt = u.pn * 256;
        if (colt < 6144) {
            const int t = colt >> 11; bf16_t* base = q + (size_t)t * ((size_t)S_ * DM); const float sc = t == 0 ? QSCALE : 1.f;
            const int c0 = colt - t * 2048 + wc * 32 + 8 * fq;
#pragma unroll
            for (int ai = 0; ai < 2; ++ai)
#pragma unroll
                for (int m = 0; m < 4; ++m) { bf16_t* rowp = base + (size_t)(row0 + ai * 128 + m * 16) * DM + c0;
#pragma unroll
                    for (int bj = 0; bj < 2; ++bj) *(u32x4*)(rowp + bj * 128) = pack8bf(acc[ai][bj][m][0] * sc, acc[ai][bj][m][1] * sc); }
        } else if (wc == 0 && fq < 2) {
            float bb[8];
#pragma unroll
            for (int e = 0; e < 8; ++e) bb[e] = bfg[8 * fq + e];
#pragma unroll
            for (int ai = 0; ai < 2; ++ai)
#pragma unroll
                for (int m = 0; m < 4; ++m) { float* rowp = flog + (size_t)(row0 + ai * 128 + m * 16) * 16 + 8 * fq;
                    f32x4 a = acc[ai][0][m][0], b = acc[ai][0][m][1], oa, ob;
#pragma unroll
                    for (int e = 0; e < 4; ++e) { oa[e] = log_sigmoid_f(a[e] + bb[e]); ob[e] = log_sigmoid_f(b[e] + bb[4 + e]); }
                    *(f32x4*)rowp = oa; *(f32x4*)(rowp + 4) = ob; }
        }
    }
};
struct EpiNsaQ {
    static constexpr bool PERM = true, AFTER_DRAIN = false;
    bf16_t* q; float* gates;
    __device__ __forceinline__ void operator()(const f32x4 (&acc)[2][2][4][2], const Unit& u, int wr, int wc, int fr, int fq) const {
        const int row0 = u.pm * 256 + wr * 64 + fr; const int colt = u.pn * 256;
        if (colt < 2048) {
            const int c0 = colt + wc * 32 + 8 * fq;
#pragma unroll
            for (int ai = 0; ai < 2; ++ai)
#pragma unroll
                for (int m = 0; m < 4; ++m) { bf16_t* rowp = q + (size_t)(row0 + ai * 128 + m * 16) * DM + c0;
#pragma unroll
                    for (int bj = 0; bj < 2; ++bj) *(u32x4*)(rowp + bj * 128) = pack8bf(acc[ai][bj][m][0] * QSCALE, acc[ai][bj][m][1] * QSCALE); }
        } else { const int c0 = wc * 32 + 8 * fq;
            if (c0 < 48) {
#pragma unroll
            for (int ai = 0; ai < 2; ++ai)
#pragma unroll
                for (int m = 0; m < 4; ++m) { float* rowp = gates + (size_t)(row0 + ai * 128 + m * 16) * 48 + c0;
                    f32x4 a = acc[ai][0][m][0], b = acc[ai][0][m][1], oa, ob;
#pragma unroll
                    for (int e = 0; e < 4; ++e) { oa[e] = sigmoid_f(a[e]); ob[e] = sigmoid_f(b[e]); }
                    *(f32x4*)rowp = oa; *(f32x4*)(rowp + 4) = ob; } }
        }
    }
};
struct EpiRes {
    static constexpr bool PERM = true, AFTER_DRAIN = false;
    const float* res; float* out;
    __device__ __forceinline__ void operator()(const f32x4 (&acc)[2][2][4][2], const Unit& u, int wr, int wc, int fr, int fq) const {
        const int row0 = u.pm * 256 + wr * 64 + fr; const int c0 = u.pn * 256 + wc * 32 + 8 * fq;
#pragma unroll
        for (int ai = 0; ai < 2; ++ai)
#pragma unroll
            for (int m = 0; m < 4; ++m) { const size_t off = (size_t)(row0 + ai * 128 + m * 16) * DM + c0;
#pragma unroll
                for (int bj = 0; bj < 2; ++bj) { const f32x4 r0 = *(const f32x4*)(res + off + bj * 128), r1 = *(const f32x4*)(res + off + bj * 128 + 4);
                    *(f32x4*)(out + off + bj * 128) = r0 * ALPHA_ + acc[ai][bj][m][0]; *(f32x4*)(out + off + bj * 128 + 4) = r1 * ALPHA_ + acc[ai][bj][m][1]; } }
    }
};
struct EpiRelu2 {
    static constexpr bool PERM = true, AFTER_DRAIN = false;
    bf16_t* O;
    __device__ __forceinline__ void operator()(const f32x4 (&acc)[2][2][4][2], const Unit& u, int wr, int wc, int fr, int fq) const {
        const int row0 = u.pm * 256 + wr * 64 + fr; const int c0 = u.pn * 256 + wc * 32 + 8 * fq;
#pragma unroll
        for (int ai = 0; ai < 2; ++ai)
#pragma unroll
            for (int m = 0; m < 4; ++m) { bf16_t* rowp = O + (size_t)(row0 + ai * 128 + m * 16) * FF + c0;
#pragma unroll
                for (int bj = 0; bj < 2; ++bj) { f32x4 a = acc[ai][bj][m][0], b = acc[ai][bj][m][1];
#pragma unroll
                    for (int e = 0; e < 4; ++e) { a[e] = fmaxf(a[e], 0.f); a[e] *= a[e]; b[e] = fmaxf(b[e], 0.f); b[e] *= b[e]; }
                    *(u32x4*)(rowp + bj * 128) = pack8bf(a, b); } }
    }
};
__device__ __forceinline__ int vt_pos(int ko) { return ((ko & 15) >> 2) * 8 + ((ko >> 4) << 2) + (ko & 3); }
struct EpiKV {
    static constexpr bool PERM = true, AFTER_DRAIN = false;
    bf16_t* kv; bf16_t* rawk; bf16_t* rawv; bf16_t* vt;
    __device__ __forceinline__ void operator()(const f32x4 (&acc)[2][2][4][2], const Unit& u, int wr, int wc, int fr, int fq) const {
        const int row0 = u.pm * 256 + wr * 64 + fr;
#pragma unroll
        for (int bj = 0; bj < 2; ++bj) {
            const int cg_ = u.pn * 256 + bj * 128; const int slot = cg_ >> 9, g = (cg_ & 511) >> 7; const int d0 = wc * 32 + 8 * fq;
#pragma unroll
            for (int ai = 0; ai < 2; ++ai)
#pragma unroll
                for (int m = 0; m < 4; ++m) { const int row = row0 + ai * 128 + m * 16; const f32x4 a = acc[ai][bj][m][0], b = acc[ai][bj][m][1];
                    if (slot < 2) { bf16_t* dst = (slot == 0 ? rawk : rawv) + ((size_t)g * S_ + row) * 128 + d0; *(u32x4*)dst = pack8bf(a, b); }
                    else if (slot == 3) { const u32x4 w = pack8bf(a, b); bf16_t* dst = vt + ((size_t)g * 128 + d0) * S_ + (row & ~31) + vt_pos(row & 31);
                        dst[0 * (size_t)S_] = (bf16_t)(w.x & 0xffffu); dst[1 * (size_t)S_] = (bf16_t)(w.x >> 16); dst[2 * (size_t)S_] = (bf16_t)(w.y & 0xffffu); dst[3 * (size_t)S_] = (bf16_t)(w.y >> 16);
                        dst[4 * (size_t)S_] = (bf16_t)(w.z & 0xffffu); dst[5 * (size_t)S_] = (bf16_t)(w.z >> 16); dst[6 * (size_t)S_] = (bf16_t)(w.w & 0xffffu); dst[7 * (size_t)S_] = (bf16_t)(w.w >> 16); }
                    else { *(u32x4*)(kv + (size_t)row * NKV + cg_ + d0) = pack8bf(a, b); } }
        }
    }
};
struct EpiCmp1 {
    static constexpr bool PERM = true, AFTER_DRAIN = false;
    bf16_t* O; const float* bias;
    __device__ __forceinline__ void operator()(const f32x4 (&acc)[2][2][4][2], const Unit& u, int wr, int wc, int fr, int fq) const {
        const int row0 = u.pm * 256 + wr * 64 + fr; const int c0 = wc * 32 + 8 * fq;
#pragma unroll
        for (int bj = 0; bj < 2; ++bj) { const f32x4 b0 = *(const f32x4*)(bias + c0 + bj * 128), b1 = *(const f32x4*)(bias + c0 + bj * 128 + 4);
#pragma unroll
            for (int ai = 0; ai < 2; ++ai)
#pragma unroll
                for (int m = 0; m < 4; ++m) { f32x4 a = acc[ai][bj][m][0] + b0, b = acc[ai][bj][m][1] + b1;
#pragma unroll
                    for (int e = 0; e < 4; ++e) { a[e] = gelu_tanh_f(a[e]); b[e] = gelu_tanh_f(b[e]); }
                    *(u32x4*)(O + (size_t)(row0 + ai * 128 + m * 16) * 256 + c0 + bj * 128) = pack8bf(a, b); } }
    }
};

__device__ __forceinline__ unsigned f2bf(float f) { unsigned u = __builtin_bit_cast(unsigned, f); return (u + 0x7fffu + ((u >> 16) & 1u)) >> 16; }
__device__ __forceinline__ unsigned pk2(float lo, float hi) { return f2bf(lo) | (f2bf(hi) << 16); }
__device__ __forceinline__ float wave_sum(float v) {
#pragma unroll
    for (int o = 1; o < 64; o <<= 1) v += __shfl_xor(v, o);
    return v;
}
__device__ __forceinline__ float wave_max(float v) {
#pragma unroll
    for (int o = 1; o < 64; o <<= 1) v = fmaxf(v, __shfl_xor(v, o));
    return v;
}
__device__ __forceinline__ void transpose_item(const float* W, int K, int ld, int ncols, bf16_t* WT, LAS float* scr, int item, int lane) {
    const int nblk = ncols / 32, kb = item / nblk, nb = item % nblk, k0 = 64 * kb, n0 = 32 * nb;
#pragma unroll 8
    for (int i = 0; i < 32; ++i) { const int kk = 2 * i + (lane >> 5); scr[kk * 33 + (lane & 31)] = W[(size_t)(k0 + kk) * ld + n0 + (lane & 31)]; }
    asm volatile("s_waitcnt lgkmcnt(0)" ::: "memory");
    const int c = lane & 7;
#pragma unroll
    for (int j = 0; j < 4; ++j) { const int n = (lane >> 3) + 8 * j; const LAS float* s = scr + (8 * c) * 33 + n;
        u32x4 o; o.x = pk2(s[0 * 33], s[1 * 33]); o.y = pk2(s[2 * 33], s[3 * 33]); o.z = pk2(s[4 * 33], s[5 * 33]); o.w = pk2(s[6 * 33], s[7 * 33]);
        *(u32x4*)(WT + (size_t)(n0 + n) * K + k0 + 8 * c) = o; }
    asm volatile("s_waitcnt lgkmcnt(0)" ::: "memory");
}
__device__ __forceinline__ int rel_bucket_dev(int n) {
    if (n < 16) return n;
    int lg = 16 + (int)(__logf((float)n / 16.0f) / 4.852030263919617f * 16.0f);
    return lg > 31 ? 31 : lg;
}

struct Params { const float* in[20]; float* out; unsigned char* ws; };
typedef const Params __attribute__((address_space(4)))* KP;
#define KARGS() ({ KP q_ = (KP)__builtin_amdgcn_kernarg_segment_ptr(); asm volatile("" : "+s"(q_)); q_; })
enum { I_X = 0, I_FOXWIN, I_FOXBF, I_FOXWO, I_NSAWIN, I_NSAWO, I_KVW, I_POSK, I_POSV, I_CK1, I_CK2, I_CV1, I_CV2, I_RELB, I_W1, I_W2, I_LN1G, I_LN1B, I_LN2G, I_LN2B };

__device__ __forceinline__ void prologue(KP p, LAS unsigned char* lds) {
    int tid_ = threadIdx.x; asm volatile("" : "+v"(tid_));
    const int tid = tid_, lane = tid & 63, wave = tid >> 6;
    const int gw = blockIdx.x * 8 + wave, NGW = gridDim.x * 8;
    LAS float* scr = (LAS float*)(lds + wave * 16384);
    unsigned char* ws = p->ws;
    long base = 0;
#define TR(src, K, ld, ncols, dst) do { const long n_ = (long)((K) / 64) * ((ncols) / 32); \
        for (long it = gw; it < n_; it += NGW) transpose_item((src), (K), (ld), (ncols), (dst), scr, (int)it, lane); } while (0)
    for (int L = 0; L < 2; ++L) {
        TR(p->in[I_FOXWIN] + (size_t)L * DM * 6160, DM, 6160, 6144, (bf16_t*)(ws + WS_WFOXIN) + (size_t)L * NFOX * DM);
        TR(p->in[I_FOXWO] + (size_t)L * DM * DM, DM, DM, DM, (bf16_t*)(ws + WS_WFOXO) + (size_t)L * DM * DM);
        TR(p->in[I_NSAWIN] + (size_t)L * DM * 2096, DM, 2096, 2048, (bf16_t*)(ws + WS_WNSAIN) + (size_t)L * NNSA * DM);
        TR(p->in[I_NSAWO] + (size_t)L * DM * DM, DM, DM, DM, (bf16_t*)(ws + WS_WNSAO) + (size_t)L * DM * DM);
    }
    TR(p->in[I_KVW], DM, NKV, NKV, (bf16_t*)(ws + WS_WKV));
    for (int L = 0; L < 4; ++L) {
        TR(p->in[I_W1] + (size_t)L * DM * FF, DM, FF, FF, (bf16_t*)(ws + WS_W1) + (size_t)L * FF * DM);
        TR(p->in[I_W2] + (size_t)L * FF * DM, FF, DM, DM, (bf16_t*)(ws + WS_W2) + (size_t)L * DM * FF);
    }
    TR(p->in[I_CK1], 4096, 256, 256, (bf16_t*)(ws + WS_WC1));
    TR(p->in[I_CV1], 4096, 256, 256, (bf16_t*)(ws + WS_WC1) + (size_t)256 * 4096);
#undef TR
    (void)base;
    const int gt = blockIdx.x * 512 + tid, NGT = gridDim.x * 512;
    for (int i = gt; i < 2 * 256 * DM; i += NGT) { const int L = i / (256 * DM), r = (i / DM) % 256, k = i % DM;
        const float v = r < 16 ? p->in[I_FOXWIN][(size_t)L * DM * 6160 + (size_t)k * 6160 + 6144 + r] : 0.f;
        ((bf16_t*)(ws + WS_WFOXIN))[(size_t)L * NFOX * DM + (size_t)(6144 + r) * DM + k] = (bf16_t)f2bf(v); }
    for (int i = gt; i < 2 * 256 * DM; i += NGT) { const int L = i / (256 * DM), r = (i / DM) % 256, k = i % DM;
        const float v = r < 48 ? p->in[I_NSAWIN][(size_t)L * DM * 2096 + (size_t)k * 2096 + 2048 + r] : 0.f;
        ((bf16_t*)(ws + WS_WNSAIN))[(size_t)L * NNSA * DM + (size_t)(2048 + r) * DM + k] = (bf16_t)f2bf(v); }
    { const f32x4* x4 = (const f32x4*)p->in[I_X]; u32x2* o = (u32x2*)(ws + WS_HBF);
      for (int i = gt; i < S_ * DM / 4; i += NGT) { const f32x4 v = x4[i]; u32x2 w; w.x = pk2(v[0], v[1]); w.y = pk2(v[2], v[3]); o[i] = w; } }
    { float* lut = (float*)(ws + WS_LUT);
      for (int i = gt; i < 16 * 2048; i += NGT) { const int h = i >> 11, d = i & 2047; lut[i] = p->in[I_RELB][rel_bucket_dev(d) * 16 + h]; } }
    { float* part = (float*)(ws + WS_CBP);
      for (int i = gt; i < 2 * 64 * 256; i += NGT) { const int mat = i / (64 * 256), ch = (i / 256) % 64, c = i % 256;
          const float* pos = p->in[mat ? I_POSV : I_POSK]; const float* w1 = p->in[mat ? I_CV1 : I_CK1]; float s = 0.f;
          for (int j = ch * 64; j < ch * 64 + 64; ++j) s += pos[j] * w1[(size_t)j * 256 + c];
          part[i] = s; } }
    if (gt < 64) ((unsigned*)(ws + WS_NRM))[gt] = 0u;
    { bf16_t* rk = (bf16_t*)(ws + WS_RAWK) + (size_t)4 * S_ * 128; bf16_t* rv = (bf16_t*)(ws + WS_RAWV) + (size_t)4 * S_ * 128;
      for (int i = gt; i < 32 * 128; i += NGT) { rk[i] = 0; rv[i] = 0; } }
}

__device__ __forceinline__ void ln_phase(const float* pre, const float* gam, const float* bet, float* h32, bf16_t* hbf) {
    int tid_ = threadIdx.x; asm volatile("" : "+v"(tid_));
    const int tid = tid_, lane = tid & 63, wave = tid >> 6;
    const int gw = blockIdx.x * 8 + wave, NGW = gridDim.x * 8;
    for (int row = gw; row < S_; row += NGW) {
        const f32x4* xr = (const f32x4*)(pre + (size_t)row * DM) + lane;
        f32x4 v[8]; float s = 0.f;
#pragma unroll
        for (int j = 0; j < 8; ++j) { v[j] = xr[64 * j]; s += (v[j][0] + v[j][1]) + (v[j][2] + v[j][3]); }
        const float mean = wave_sum(s) * (1.f / DM); float s2 = 0.f;
#pragma unroll
        for (int j = 0; j < 8; ++j) { v[j] = v[j] - mean; s2 += (v[j][0] * v[j][0] + v[j][1] * v[j][1]) + (v[j][2] * v[j][2] + v[j][3] * v[j][3]); }
        const float rstd = 1.f / sqrtf(wave_sum(s2) * (1.f / DM) + LN_EPS_);
        f32x4* o4 = (f32x4*)(h32 + (size_t)row * DM) + lane; u32x2* o2 = (u32x2*)(hbf + (size_t)row * DM) + lane;
#pragma unroll
        for (int j = 0; j < 8; ++j) { const f32x4 g4 = ((const f32x4*)gam)[lane + 64 * j], b4 = ((const f32x4*)bet)[lane + 64 * j];
            const f32x4 y = v[j] * rstd * g4 + b4; o4[64 * j] = y; u32x2 w; w.x = pk2(y[0], y[1]); w.y = pk2(y[2], y[3]); o2[64 * j] = w; }
    }
}

__device__ __forceinline__ void scan_phase(KP p, LAS unsigned char* lds, bool do_cbias, int layer) {
    int tid_ = threadIdx.x; asm volatile("" : "+v"(tid_));
    const int tid = tid_; unsigned char* ws = p->ws;
    if (blockIdx.x < 16) {
        const int h = blockIdx.x; const float* fl = (const float*)(ws + WS_FLOG); float* cum = (float*)(ws + WS_CUM) + (size_t)h * S_;
        LAS float* sh = (LAS float*)lds;
        float loc[32]; float tot = 0.f;
#pragma unroll
        for (int i = 0; i < 32; ++i) { loc[i] = fl[(size_t)(tid * 32 + i) * 16 + h]; }
#pragma unroll
        for (int i = 0; i < 32; ++i) { tot += loc[i]; loc[i] = tot; }
        sh[tid] = tot; __syncthreads();
        for (int off = 1; off < 512; off <<= 1) { const float v = tid >= off ? sh[tid - off] : 0.f; __syncthreads(); sh[tid] += v; __syncthreads(); }
        const float excl = sh[tid] - tot;
#pragma unroll
        for (int i = 0; i < 32; ++i) cum[tid * 32 + i] = excl + loc[i];
        __syncthreads();
    } else if (blockIdx.x == 16) {
        if (do_cbias) {
        const float* part = (const float*)(ws + WS_CBP); float* cb = (float*)(ws + WS_CB);
        const int mat = tid >> 8, c = tid & 255; float s = 0.f;
        for (int ch = 0; ch < 64; ++ch) s += part[(mat * 64 + ch) * 256 + c];
        cb[tid] = s; }
    } else {
        const int nb = (int)gridDim.x - 17, b = (int)blockIdx.x - 17;
        const int h = tid & 15; float mq = 0.f, mk = 0.f;
        const bf16_t* Q = (const bf16_t*)(ws + WS_A); const bf16_t* K = Q + (size_t)S_ * DM;
        for (int t = b * 32 + (tid >> 4); t < S_; t += nb * 32) {
            const u32x4* qp = (const u32x4*)(Q + (size_t)t * DM + h * 128); const u32x4* kp = (const u32x4*)(K + (size_t)t * DM + h * 128);
            float sq = 0.f, sk = 0.f;
#pragma unroll 4
            for (int i = 0; i < 16; ++i) { const u32x4 a = qp[i], c = kp[i];
#pragma unroll
                for (int e = 0; e < 4; ++e) { const float q0 = __uint_as_float(a[e] << 16), q1 = __uint_as_float(a[e] & 0xffff0000u), k0 = __uint_as_float(c[e] << 16), k1 = __uint_as_float(c[e] & 0xffff0000u);
                    sq += q0 * q0 + q1 * q1; sk += k0 * k0 + k1 * k1; } }
            mq = fmaxf(mq, sq); mk = fmaxf(mk, sk);
        }
        mq = fmaxf(mq, __shfl_xor(mq, 16)); mq = fmaxf(mq, __shfl_xor(mq, 32)); mk = fmaxf(mk, __shfl_xor(mk, 16)); mk = fmaxf(mk, __shfl_xor(mk, 32));
        if ((tid & 63) < 16) { unsigned* nr = (unsigned*)(ws + WS_NRM) + (layer * 16 + h) * 2; atomicMax(nr, __float_as_uint(mq)); atomicMax(nr + 1, __float_as_uint(mk)); }
    }
}

__device__ __forceinline__ void cmp2_phase(KP p) {
    int tid_ = threadIdx.x; asm volatile("" : "+v"(tid_));
    const int tid = tid_; unsigned char* ws = p->ws;
    const int rr = tid >> 7, d = tid & 127;
    for (int it = blockIdx.x; it < 2 * 1024; it += gridDim.x) {
        const int mat = it >> 10, row = (it & 1023) * 4 + rr;
        const bf16_t* hid = (const bf16_t*)(ws + WS_CH) + (size_t)mat * 4096 * 256 + (size_t)row * 256;
        const float* w2 = p->in[mat ? I_CV2 : I_CK2];
        float s = 0.f;
        for (int k = 0; k < 256; k += 2) { const unsigned hv = *(const unsigned*)(hid + k);
            s += __uint_as_float(hv << 16) * w2[k * 128 + d]; s += __uint_as_float(hv & 0xffff0000u) * w2[(k + 1) * 128 + d]; }
        if ((row & 1023) == 1023) s = 0.f;
        ((bf16_t*)(ws + (mat ? WS_VC : WS_KC)))[(size_t)row * 128 + d] = (bf16_t)f2bf(s);
    }
}

#define KSWZ(row, colB) ((row) * 256 + ((colB) ^ (((row) & 7) << 4)))
#define SBAR() __builtin_amdgcn_sched_barrier(0)
__device__ __forceinline__ int v_st(int k, int c) { const int kk = (k & ~0xC) | ((k & 4) << 1) | ((k & 8) >> 1); return ((kk >> 3) * 4 + (c >> 5)) * 512 + ((kk & 7) * 32 + (c & 31)) * 2; }
__device__ __forceinline__ int v_rd_base(int lane) { return ((lane & 3) << 3) | (((lane >> 2) & 3) << 6) | (((lane >> 4) & 1) << 5) | (((lane >> 5) & 1) << 8); }
constexpr int v_rd_off(int d0, int ks, int half) { return d0 * 512 + ks * 4096 + half * 2048; }
__device__ __forceinline__ int crow(int r, int hi) { return (r & 3) + 8 * (r >> 2) + 4 * hi; }

__device__ __forceinline__ void qkt(f32x16& p0, f32x16& p1, const LAS unsigned char* Kb, int r32, int hi, const bf16x8* qr) {
#pragma unroll
    for (int r = 0; r < 16; ++r) { p0[r] = 0.f; p1[r] = 0.f; }
    const LAS unsigned char* kb[4];
#pragma unroll
    for (int dd = 0; dd < 4; ++dd) kb[dd] = Kb + KSWZ(r32, (dd * 16 + hi * 8) * 2);
#pragma unroll
    for (int d0 = 0; d0 < 8; ++d0) { const LAS unsigned char* a = kb[d0 & 3] + (d0 >> 2) * 128;
        const bf16x8 b0 = *(const LAS bf16x8*)a;
        const bf16x8 b1 = *(const LAS bf16x8*)(a + 32 * 256);
        p0 = __builtin_amdgcn_mfma_f32_32x32x16_bf16(b0, qr[d0], p0, 0, 0, 0);
        p1 = __builtin_amdgcn_mfma_f32_32x32x16_bf16(b1, qr[d0], p1, 0, 0, 0); }
}
__device__ __forceinline__ void pv_tile(f32x16* o, int vb, bf16x8 pa0, bf16x8 pa1, bf16x8 pa2, bf16x8 pa3) {
#define TRRD(dst, off) asm volatile("ds_read_b64_tr_b16 %0, %1 offset:%2" : "=&v"(dst) : "v"(vb), "i"(off) : "memory")
#define PV_D0(d0) do { s16x4 l0, l1, l2, l3, h0, h1, h2, h3; constexpr int b_ = v_rd_off(d0, 0, 0); \
        TRRD(l0, b_); TRRD(h0, b_ + 2048); TRRD(l1, b_ + 4096); TRRD(h1, b_ + 6144); TRRD(l2, b_ + 8192); TRRD(h2, b_ + 10240); TRRD(l3, b_ + 12288); TRRD(h3, b_ + 14336); \
        asm volatile("s_waitcnt lgkmcnt(0)" ::: "memory"); SBAR(); \
        o[d0] = __builtin_amdgcn_mfma_f32_32x32x16_bf16(pa0, (bf16x8){l0[0], l0[1], l0[2], l0[3], h0[0], h0[1], h0[2], h0[3]}, o[d0], 0, 0, 0);   \
        o[d0] = __builtin_amdgcn_mfma_f32_32x32x16_bf16(pa1, (bf16x8){l1[0], l1[1], l1[2], l1[3], h1[0], h1[1], h1[2], h1[3]}, o[d0], 0, 0, 0);   \
        o[d0] = __builtin_amdgcn_mfma_f32_32x32x16_bf16(pa2, (bf16x8){l2[0], l2[1], l2[2], l2[3], h2[0], h2[1], h2[2], h2[3]}, o[d0], 0, 0, 0);   \
        o[d0] = __builtin_amdgcn_mfma_f32_32x32x16_bf16(pa3, (bf16x8){l3[0], l3[1], l3[2], l3[3], h3[0], h3[1], h3[2], h3[3]}, o[d0], 0, 0, 0); } while (0)
    PV_D0(0); PV_D0(1); PV_D0(2); PV_D0(3);
#undef PV_D0
#undef TRRD
}
__device__ __forceinline__ void p_to_frags(const f32x16& p0, const f32x16& p1, bf16x8& pa0, bf16x8& pa1, bf16x8& pa2, bf16x8& pa3) {
#define PK4(P, B_, OUT) do { unsigned a0 = cvt_pk_bf16(P[B_+0], P[B_+1]), a1 = cvt_pk_bf16(P[B_+2], P[B_+3]);                          \
        unsigned b0 = cvt_pk_bf16(P[B_+4], P[B_+5]), b1 = cvt_pk_bf16(P[B_+6], P[B_+7]);                                             \
        auto r0 = __builtin_amdgcn_permlane32_swap(a0, b0, false, false); auto r1 = __builtin_amdgcn_permlane32_swap(a1, b1, false, false); \
        u32x4 w = {r0[0], r1[0], r0[1], r1[1]}; OUT = *reinterpret_cast<bf16x8*>(&w); } while (0)
    PK4(p0, 0, pa0); PK4(p0, 8, pa1); PK4(p1, 0, pa2); PK4(p1, 8, pa3);
#undef PK4
}
__device__ __forceinline__ float half_swap_max(float v) { auto rr = __builtin_amdgcn_permlane32_swap(__float_as_uint(v), __float_as_uint(v), false, false); return fmaxf(__uint_as_float(rr[0]), __uint_as_float(rr[1])); }
__device__ __forceinline__ float half_swap_sum(float v) { auto rr = __builtin_amdgcn_permlane32_swap(__float_as_uint(v), __float_as_uint(v), false, false); return __uint_as_float(rr[0]) + __uint_as_float(rr[1]); }
__device__ __forceinline__ float online_sm(f32x16& p0, f32x16& p1, float& m, float& l) {
    float pmax = p0[0];
#pragma unroll
    for (int r = 1; r < 16; ++r) pmax = fmaxf(pmax, p0[r]);
#pragma unroll
    for (int r = 0; r < 16; ++r) pmax = fmaxf(pmax, p1[r]);
    pmax = half_swap_max(pmax);
    const float mn = fmaxf(m, pmax); const float alpha = __builtin_amdgcn_exp2f((m - mn) * L2E); m = mn;
    const float mnL = -mn * L2E; float ps = 0.f;
#pragma unroll
    for (int r = 0; r < 16; ++r) { p0[r] = __builtin_amdgcn_exp2f(fmaf(p0[r], L2E, mnL)); p1[r] = __builtin_amdgcn_exp2f(fmaf(p1[r], L2E, mnL)); ps += p0[r] + p1[r]; }
    ps = half_swap_sum(ps);
    l = l * alpha + ps;
    return alpha;
}

struct FL {
    const bf16_t* K; const bf16_t* V; int kstride, vstride;
    int j_lo, j_hi;
    const float* cum; float cq;
    int t_lane, t_w0;
    const LAS float* lut;
    __half* imp;
};
template <int MODE>
__device__ __forceinline__ void flash_loop(LAS unsigned char* lds, const FL& a, const bf16x8* qr, float& m, float& l, f32x16* o, float inv_l) {
    int tid_ = threadIdx.x; asm volatile("" : "+v"(tid_));
    const int tid = tid_, wid = __builtin_amdgcn_readfirstlane(tid >> 6), lane = tid & 63, r32 = lane & 31, hi = lane >> 5;
    LAS unsigned char* V_lds = lds + L_V; LAS unsigned char* K_lds = lds + L_K;
    LAS float* al_l = (LAS float*)(lds + L_WS) + wid * 64 + 32;
    LAS float* ckb = (LAS float*)(lds + L_CK);
    const int sr = tid >> 4, sc = (tid & 15) * 8, vst0 = v_st(sr, sc), vst1 = v_st(32 + sr, sc), kws = KSWZ(sr, sc * 2);
    const int vb0 = (int)(size_t)V_lds + v_rd_base(lane);
    constexpr bool HASV = (MODE != 1);
    bf16x8 sk0, sk1, sv0, sv1; float sck = 0.f;
    const float NEG = -__builtin_inff();
    float carry = 0.f;
#define FL_LOAD(j) do { const int kb_ = (j) * 64; \
        sk0 = *(const bf16x8*)(a.K + (size_t)(kb_ + sr) * a.kstride + sc); sk1 = *(const bf16x8*)(a.K + (size_t)(kb_ + 32 + sr) * a.kstride + sc); \
        if (HASV) { sv0 = *(const bf16x8*)(a.V + (size_t)(kb_ + sr) * a.vstride + sc); sv1 = *(const bf16x8*)(a.V + (size_t)(kb_ + 32 + sr) * a.vstride + sc); } \
        if (MODE == 0) { if (tid < 64) sck = a.cum[kb_ + tid]; } } while (0)
#define FL_WRITE(buf) do { *(LAS bf16x8*)(K_lds + (buf) * SHM_K + kws) = sk0; *(LAS bf16x8*)(K_lds + (buf) * SHM_K + kws + 32 * 256) = sk1; \
        if (HASV) { *(LAS bf16x8*)(V_lds + (buf) * SHM_V + vst0) = sv0; *(LAS bf16x8*)(V_lds + (buf) * SHM_V + vst1) = sv1; } \
        if (MODE == 0) { if (tid < 64) ckb[(buf) * 64 + tid] = sck; } } while (0)
    __syncthreads();
    FL_LOAD(a.j_lo); FL_WRITE(0); __syncthreads();
#pragma nounroll
    for (int j = a.j_lo; j < a.j_hi; ++j) {
        const int buf = (j - a.j_lo) & 1; const int kb = j * 64;
        if (j + 1 < a.j_hi) FL_LOAD(j + 1);
        const bool act = (MODE != 0) || (kb <= a.t_w0 + 31);
        if (act) {
            f32x16 p0, p1;
            qkt(p0, p1, K_lds + buf * SHM_K, r32, hi, qr);
            if (MODE == 0) {
#pragma unroll
                for (int i = 0; i < 4; ++i) { const f32x4 c0 = *(const LAS f32x4*)(ckb + buf * 64 + 4 * hi + 8 * i), c1 = *(const LAS f32x4*)(ckb + buf * 64 + 32 + 4 * hi + 8 * i);
#pragma unroll
                    for (int e = 0; e < 4; ++e) { p0[4 * i + e] += a.cq - c0[e]; p1[4 * i + e] += a.cq - c1[e]; } }
                if (kb + 63 > a.t_w0) { const int dq = a.t_lane - kb - 4 * hi;
#pragma unroll
                    for (int r = 0; r < 16; ++r) { const int c = (r & 3) + 8 * (r >> 2); if (dq - c < 0) p0[r] = NEG; if (dq - c - 32 < 0) p1[r] = NEG; } }
            } else if (MODE == 1 || MODE == 2) {
                const int dq = a.t_lane - 16 * kb - 31 - 64 * hi;
#pragma unroll
                for (int r = 0; r < 16; ++r) { const int d0_ = dq - 16 * (r & 3) - 128 * (r >> 2), d1_ = d0_ - 512;
                    const unsigned i0 = (unsigned)d0_ < 2047u ? (unsigned)d0_ : 2047u, i1 = (unsigned)d1_ < 2047u ? (unsigned)d1_ : 2047u;
                    const float b0 = a.lut[i0], b1 = a.lut[i1];
                    p0[r] = d0_ >= 0 ? p0[r] + b0 : NEG; p1[r] = d1_ >= 0 ? p1[r] + b1 : NEG; }
            } else {
                const int dq = a.t_lane - kb - 4 * hi;
#pragma unroll
                for (int r = 0; r < 16; ++r) { const int d0_ = dq - ((r & 3) + 8 * (r >> 2)), d1_ = d0_ - 32;
                    const unsigned i0 = (unsigned)d0_ < 2047u ? (unsigned)d0_ : 2047u, i1 = (unsigned)d1_ < 2047u ? (unsigned)d1_ : 2047u;
                    const float b0 = a.lut[i0], b1 = a.lut[i1];
                    p0[r] = (unsigned)d0_ < 512u ? p0[r] + b0 : NEG; p1[r] = (unsigned)d1_ < 512u ? p1[r] + b1 : NEG; }
            }
            if (MODE == 1) { (void)online_sm(p0, p1, m, l); }
            else if (MODE == 2) {
                const float mnL = -m * L2E;
#pragma unroll
                for (int r = 0; r < 16; ++r) { p0[r] = __builtin_amdgcn_exp2f(fmaf(p0[r], L2E, mnL)) * inv_l; p1[r] = __builtin_amdgcn_exp2f(fmaf(p1[r], L2E, mnL)) * inv_l; }
                float a0[4], a1[4], x0[4], x1[4];
#pragma unroll
                for (int i = 0; i < 4; ++i) { a0[i] = (p0[4 * i] + p0[4 * i + 1]) + (p0[4 * i + 2] + p0[4 * i + 3]); a1[i] = (p1[4 * i] + p1[4 * i + 1]) + (p1[4 * i + 2] + p1[4 * i + 3]);
                    x0[i] = __shfl_xor(p0[4 * i + 3], 32); x1[i] = __shfl_xor(p1[4 * i + 3], 32); }
                __half* ip = a.imp + 16 * j + hi;
#pragma unroll
                for (int i = 0; i < 4; ++i) { const float e0 = hi ? x0[i] : (i ? x0[i > 0 ? i - 1 : 0] : carry); const float e1 = hi ? x1[i] : (i ? x1[i > 0 ? i - 1 : 0] : x0[3]);
                    ip[2 * i] = __float2half(a0[i] + e0); ip[8 + 2 * i] = __float2half(a1[i] + e1); }
                carry = x1[3];
                bf16x8 pa0, pa1, pa2, pa3; p_to_frags(p0, p1, pa0, pa1, pa2, pa3);
                pv_tile(o, vb0 + buf * SHM_V, pa0, pa1, pa2, pa3);
            } else {
                const float alpha = online_sm(p0, p1, m, l);
                if (__any(alpha < 1.f)) { if (hi == 0) al_l[r32] = alpha; asm volatile("s_waitcnt lgkmcnt(0)" ::: "memory");
#pragma unroll
                    for (int d_ = 0; d_ < 4; ++d_)
#pragma unroll
                        for (int r = 0; r < 16; ++r) o[d_][r] *= al_l[crow(r, hi)]; }
                bf16x8 pa0, pa1, pa2, pa3; p_to_frags(p0, p1, pa0, pa1, pa2, pa3);
                pv_tile(o, vb0 + buf * SHM_V, pa0, pa1, pa2, pa3);
            }
        }
        if (j + 1 < a.j_hi) FL_WRITE(buf ^ 1);
        __syncthreads();
    }
#undef FL_LOAD
#undef FL_WRITE
}

__device__ __forceinline__ void fox_attn_phase(KP p, LAS unsigned char* lds, int layer) {
    const int wid = __builtin_amdgcn_readfirstlane(threadIdx.x >> 6);
    unsigned char* ws = p->ws;
    const bf16_t* Q = (const bf16_t*)(ws + WS_A); const bf16_t* K = Q + (size_t)S_ * DM; const bf16_t* V = K + (size_t)S_ * DM; bf16_t* O = (bf16_t*)(V + (size_t)S_ * DM);
    const float* cumall = (const float*)(ws + WS_CUM);
    const unsigned* nrm = (const unsigned*)(ws + WS_NRM) + layer * 32;
    LAS float* li_l = (LAS float*)(lds + L_WS) + wid * 64;
    LAS int* jl = (LAS int*)(lds + L_CK + 1024);
    for (int I = blockIdx.x; I < 1024; I += gridDim.x) {
        const int kk = I >> 8, qbi = (I >> 4) & 63, h = ((I & 15) + 5 * kk) & 15;
        const int c_ = qbi & 15; const int qb = kk == 0 ? 63 - c_ : (kk == 1 ? c_ : (kk == 2 ? 47 - c_ : 16 + c_));
        {
            int tid_ = threadIdx.x; asm volatile("" : "+v"(tid_));
            const int lane = tid_ & 63, r32 = lane & 31, hi = lane >> 5;
            const int t_w0 = qb * 256 + wid * 32, t_lane = t_w0 + r32;
            const float* cum = cumall + (size_t)h * S_;
            const float B2 = 2.f * sqrtf(__uint_as_float(nrm[h * 2]) * __uint_as_float(nrm[h * 2 + 1])) * 1.01f;
            const float T = cum[qb * 256] + 110.f + B2;
            __syncthreads();
            { const bool ok = (tid_ < qb * 4 + 4) && (cum[64 * (tid_ < 256 ? tid_ : 0) + 63] <= T);
              const unsigned long long bm = __ballot(ok);
              if (lane == 0) jl[wid] = bm ? wid * 64 + (__ffsll((long long)bm) - 1) : (1 << 30); }
            __syncthreads();
            int j_lo = jl[0];
#pragma unroll
            for (int w = 1; w < 8; ++w) j_lo = min(j_lo, jl[w]);
            j_lo = __builtin_amdgcn_readfirstlane(j_lo);
            if (j_lo > qb * 4) j_lo = qb * 4;
            bf16x8 qr[8];
#pragma unroll
            for (int d0 = 0; d0 < 8; ++d0) qr[d0] = *(const bf16x8*)(Q + (size_t)t_lane * DM + h * 128 + d0 * 16 + hi * 8);
            FL a; a.K = K + h * 128; a.V = V + h * 128; a.kstride = DM; a.vstride = DM; a.j_lo = j_lo; a.j_hi = qb * 4 + 4;
            a.cum = cum; a.cq = cum[t_lane]; a.t_lane = t_lane; a.t_w0 = t_w0; a.lut = nullptr; a.imp = nullptr;
            float m = -1e30f, l = 0.f; f32x16 o[4];
#pragma unroll
            for (int d_ = 0; d_ < 4; ++d_)
#pragma unroll
                for (int r = 0; r < 16; ++r) o[d_][r] = 0.f;
            flash_loop<0>(lds, a, qr, m, l, o, 0.f);
            if (hi == 0) li_l[r32] = l; asm volatile("s_waitcnt lgkmcnt(0)" ::: "memory");
            bf16_t* Ow = O + (size_t)t_w0 * DM + h * 128;
            int lo_ = 4 * hi * DM + r32; asm volatile("" : "+v"(lo_));
#pragma unroll
            for (int r = 0; r < 16; ++r) { const int orow = crow(r, hi); const float rli = __builtin_amdgcn_rcpf(li_l[orow]);
#pragma unroll
                for (int d0 = 0; d0 < 4; ++d0) { const float v = o[d0][r] * rli; const float vn = __shfl_xor(v, 1);
                    if ((r32 & 1) == 0) *(unsigned*)(Ow + (lo_ + ((r & 3) + 8 * (r >> 2)) * DM + d0 * 32)) = cvt_pk_bf16(v, vn); } }
        }
    }
}

__device__ __forceinline__ void nsa_attn_phase(KP p, LAS unsigned char* lds) {
    const int tid = threadIdx.x, wid = __builtin_amdgcn_readfirstlane(tid >> 6);
    unsigned char* ws = p->ws;
    const bf16_t* Q = (const bf16_t*)(ws + WS_A); bf16_t* attn = (bf16_t*)(ws + WS_A) + (size_t)S_ * DM; __half* imp = (__half*)(ws + WS_A + 128 * MiB);
    float* partial = (float*)(ws + WS_PRE); const float* gates = (const float*)(ws + WS_GATE);
    const bf16_t* kv = (const bf16_t*)(ws + WS_KV); const bf16_t* kc = (const bf16_t*)(ws + WS_KC); const bf16_t* vc = (const bf16_t*)(ws + WS_VC);
    const bf16_t* vt = (const bf16_t*)(ws + WS_VT); const float* lutg = (const float*)(ws + WS_LUT);
    LAS float* lut = (LAS float*)(lds + L_LUT);
    LAS float* li_l = (LAS float*)(lds + L_WS) + wid * 64;
    const float NEG = -__builtin_inff();
    for (int u = blockIdx.x; u < 512; u += gridDim.x) {
        const int g = u >> 7, x = u & 127;
        __syncthreads();
        for (int i = tid; i < 4 * 2048; i += 512) lut[i] = lutg[g * 4 * 2048 + i];
        __syncthreads();
        for (int pass = 0; pass < 2; ++pass) {
            const int tile = pass == 0 ? 255 - x : x; const int t0 = tile * 64;
            {
                const int r = wid & 3, th = wid >> 2, h = g * 4 + r;
                int tid_ = threadIdx.x; asm volatile("" : "+v"(tid_));
                const int lane = tid_ & 63, r32 = lane & 31, hi = lane >> 5;
                const int t_w0 = t0 + 32 * th, t_lane = t_w0 + r32;
                bf16x8 qr[8];
#pragma unroll
                for (int d0 = 0; d0 < 8; ++d0) qr[d0] = *(const bf16x8*)(Q + (size_t)t_lane * DM + h * 128 + d0 * 16 + hi * 8);
                const float g0 = gates[(size_t)t_lane * 48 + h * 3 + 0], g2 = gates[(size_t)t_lane * 48 + h * 3 + 2];
                FL a; a.K = kc + (size_t)g * 1024 * 128; a.V = vc + (size_t)g * 1024 * 128; a.kstride = 128; a.vstride = 128; a.j_lo = 0; a.j_hi = (t0 / 16 + 2) / 64 + 1;
                a.cum = nullptr; a.cq = 0.f; a.t_lane = t_lane; a.t_w0 = t_w0; a.lut = lut + r * 2048; a.imp = imp + ((size_t)h * S_ + t_lane) * 256;
                float m = -1e30f, l = 0.f; f32x16 o[4];
#pragma unroll
                for (int d_ = 0; d_ < 4; ++d_)
#pragma unroll
                    for (int rr = 0; rr < 16; ++rr) o[d_][rr] = 0.f;
                flash_loop<1>(lds, a, qr, m, l, o, 0.f);
                const float inv_l = l > 0.f ? 1.f / l : 0.f;
                flash_loop<2>(lds, a, qr, m, l, o, inv_l);
                float* Pw = partial + (size_t)t_w0 * DM + h * 128;
                int lo_ = 4 * hi * DM + r32; asm volatile("" : "+v"(lo_));
                if (hi == 0) li_l[r32] = g0; asm volatile("s_waitcnt lgkmcnt(0)" ::: "memory");
#pragma unroll
                for (int rr = 0; rr < 16; ++rr) { const int orow = crow(rr, hi); const float f = li_l[orow];
#pragma unroll
                    for (int d0 = 0; d0 < 4; ++d0) Pw[lo_ + ((rr & 3) + 8 * (rr >> 2)) * DM + d0 * 32] = o[d0][rr] * f; }
                a.K = kv + 4 * 512 + g * 128; a.V = kv + 5 * 512 + g * 128; a.kstride = NKV; a.vstride = NKV; a.j_lo = tile >= 8 ? tile - 8 : 0; a.j_hi = tile + 1;
                m = -1e30f; l = 0.f;
#pragma unroll
                for (int d_ = 0; d_ < 4; ++d_)
#pragma unroll
                    for (int rr = 0; rr < 16; ++rr) o[d_][rr] = 0.f;
                flash_loop<3>(lds, a, qr, m, l, o, 0.f);
                asm volatile("s_waitcnt lgkmcnt(0)" ::: "memory");
                int lo2_ = 4 * hi * DM + r32; asm volatile("" : "+v"(lo2_));
                if (hi == 0) li_l[r32] = g2 * (l > 0.f ? 1.f / l : 0.f); asm volatile("s_waitcnt lgkmcnt(0)" ::: "memory");
#pragma unroll
                for (int rr = 0; rr < 16; ++rr) { const int orow = crow(rr, hi); const float f = li_l[orow];
#pragma unroll
                    for (int d0 = 0; d0 < 4; ++d0) { float* pp = Pw + (lo2_ + ((rr & 3) + 8 * (rr >> 2)) * DM + d0 * 32); *pp = *pp + o[d0][rr] * f; } }
            }
            __syncthreads();
            {
#pragma nounroll
                for (int tt = 0; tt < 8; ++tt) {
                    int tid_ = threadIdx.x; asm volatile("" : "+v"(tid_));
                    const int lane = tid_ & 63;
                    const int n = lane & 15, kq = lane >> 4, hn = n & 3; const bool hv = n < 4;
                    const LAS float* lutn = lut + hn * 2048;
                    const int t = t0 + 8 * wid + tt; const int blk = tile;
                    float sc[4] = {0.f, 0.f, 0.f, 0.f};
#pragma unroll
                    for (int r = 0; r < 4; ++r) { const u32x2 raw = *(const u32x2*)(imp + ((size_t)(g * 4 + r) * S_ + t) * 256 + lane * 4);
                        sc[0] += __half2float(__ushort_as_half((unsigned short)(raw.x & 0xffffu))); sc[1] += __half2float(__ushort_as_half((unsigned short)(raw.x >> 16)));
                        sc[2] += __half2float(__ushort_as_half((unsigned short)(raw.y & 0xffffu))); sc[3] += __half2float(__ushort_as_half((unsigned short)(raw.y >> 16))); }
#pragma unroll
                    for (int e = 0; e < 4; ++e) { const int j = lane * 4 + e; const bool forced = (j == 0) | (j == blk) | (j == blk - 1);
                        sc[e] = forced ? 1e4f : (j <= blk ? sc[e] : -1.f); }
                    int mysel = -1;
#pragma nounroll
                    for (int k = 0; k < 16; ++k) {
                        float bv = sc[0]; int be = 0;
#pragma unroll
                        for (int e = 1; e < 4; ++e) if (sc[e] > bv) { bv = sc[e]; be = e; }
                        const float wmax = wave_max(bv);
                        if (wmax < 0.f) break;
                        const unsigned long long msk = __ballot(bv == wmax);
                        const int src = __ffsll((long long)msk) - 1;
                        const int jw = __shfl(lane * 4 + be, src);
                        if (lane == k) mysel = jw;
                        if (lane == src) {
#pragma unroll
                            for (int e = 0; e < 4; ++e) if (be == e) sc[e] = -2.f; }
                    }
                    bf16x8 qb[4];
#pragma unroll
                    for (int ks = 0; ks < 4; ++ks) { qb[ks] = *(const bf16x8*)(Q + (size_t)t * DM + (g * 4 + hn) * 128 + 32 * ks + kq * 8);
                        if (!hv) qb[ks] = (bf16x8){0, 0, 0, 0, 0, 0, 0, 0}; }
                    float m = -1e30f, l = 0.f; f32x4 o[8];
#pragma unroll
                    for (int d_ = 0; d_ < 8; ++d_) o[d_] = (f32x4){0.f, 0.f, 0.f, 0.f};
#pragma nounroll
                    for (int b = 0; b < 16; ++b) {
                        const int sb = __builtin_amdgcn_readfirstlane(__shfl(mysel, b));
                        if (sb < 0) continue;
                        const bf16_t* Kp = kv + (size_t)(sb * 64 + n) * NKV + 2 * 512 + g * 128 + kq * 8;
                        f32x4 s[4];
#pragma unroll
                        for (int sub = 0; sub < 4; ++sub) { s[sub] = (f32x4){0.f, 0.f, 0.f, 0.f};
#pragma unroll
                            for (int ks = 0; ks < 4; ++ks) { const bf16x8 kf = *(const bf16x8*)(Kp + (size_t)(16 * sub) * NKV + 32 * ks);
                                s[sub] = __builtin_amdgcn_mfma_f32_16x16x32_bf16(kf, qb[ks], s[sub], 0, 0, 0); } }
                        const int dq = t - sb * 64 - 4 * kq; float pmax = NEG;
#pragma unroll
                        for (int sub = 0; sub < 4; ++sub)
#pragma unroll
                            for (int i = 0; i < 4; ++i) { const int d = dq - 16 * sub - i; const unsigned idx = (unsigned)d < 2047u ? (unsigned)d : 2047u;
                                const float v = d >= 0 ? s[sub][i] + lutn[idx] : NEG; s[sub][i] = v; pmax = fmaxf(pmax, v); }
                        pmax = fmaxf(pmax, __shfl_xor(pmax, 16)); pmax = fmaxf(pmax, __shfl_xor(pmax, 32));
                        const float mn = fmaxf(m, pmax); const float alpha = __builtin_amdgcn_exp2f((m - mn) * L2E); m = mn;
                        const float mnL = -mn * L2E; float ps = 0.f;
#pragma unroll
                        for (int sub = 0; sub < 4; ++sub)
#pragma unroll
                            for (int i = 0; i < 4; ++i) { s[sub][i] = __builtin_amdgcn_exp2f(fmaf(s[sub][i], L2E, mnL)); ps += s[sub][i]; }
                        ps += __shfl_xor(ps, 16); ps += __shfl_xor(ps, 32);
                        l = l * alpha + ps;
#pragma unroll
                        for (int d_ = 0; d_ < 8; ++d_) o[d_] = o[d_] * alpha;
                        bf16x8 pb[2];
                        { const u32x4 w0 = pack8bf(s[0], s[1]), w1 = pack8bf(s[2], s[3]); pb[0] = *reinterpret_cast<const bf16x8*>(&w0); pb[1] = *reinterpret_cast<const bf16x8*>(&w1); }
                        const bf16_t* Vp = vt + ((size_t)g * 128 + n) * S_ + sb * 64 + kq * 8;
#pragma unroll
                        for (int d_ = 0; d_ < 8; ++d_)
#pragma unroll
                            for (int s2 = 0; s2 < 2; ++s2) { const bf16x8 vf = *(const bf16x8*)(Vp + (size_t)(16 * d_) * S_ + 32 * s2);
                                o[d_] = __builtin_amdgcn_mfma_f32_16x16x32_bf16(vf, pb[s2], o[d_], 0, 0, 0); }
                    }
                    const float g1 = gates[(size_t)t * 48 + (g * 4 + hn) * 3 + 1];
                    const float f = g1 * (l > 0.f ? 1.f / l : 0.f);
                    if (hv) {
#pragma unroll
                        for (int d_ = 0; d_ < 8; ++d_) { const size_t off = (size_t)t * DM + (g * 4 + n) * 128 + 16 * d_ + 4 * kq;
                            const f32x4 pp = *(const f32x4*)(partial + off); const f32x4 r4 = pp + o[d_] * f;
                            u32x2 w; w.x = cvt_pk_bf16(r4[0], r4[1]); w.y = cvt_pk_bf16(r4[2], r4[3]); *(u32x2*)(attn + off) = w; }
                    }
                }
            }
        }
    }
}

#define RUN_GEMM(EpiT, epi, Aptr, Btptr, Mv, Nv, Kv, ldav, cidx) do { const pg8::Gemm g_{(Aptr), (Btptr), (Mv), (Nv), (Kv), (ldav)}; pg8::StaticOrder so_; so_.init((Mv), (Nv), (int)gridDim.x, (cidx)); \
        pg8::gemm_phase<EpiT, pg8::StaticOrder, true, true>(lds, g_, so_, (epi)); } while (0)

__global__ void __launch_bounds__(512, 2) mega_fwd(Params p_unused) {
    extern __shared__ __attribute__((aligned(16))) unsigned char lds_raw[];
    LAS unsigned char* lds = (LAS unsigned char*)lds_raw;
    cg::grid_group grid = cg::this_grid();
    const size_t SD = (size_t)S_ * DM;
#define WSP(off) (KARGS()->ws + (off))
    prologue(KARGS(), lds);
    grid.sync();
#pragma nounroll
    for (int L = 0; L < 4; ++L) {
        const int bid = (int)blockIdx.x, G = (int)gridDim.x;
        if (L < 2) {
            { KP p = KARGS(); unsigned char* ws = p->ws; bf16_t* A0 = (bf16_t*)(ws + WS_A);
              EpiFoxQKV E{A0, (float*)(ws + WS_FLOG), p->in[I_FOXBF] + L * 16};
              RUN_GEMM(EpiFoxQKV, E, (const bf16_t*)(ws + WS_HBF), (const bf16_t*)(ws + WS_WFOXIN) + (size_t)L * NFOX * DM, S_, NFOX, DM, DM, bid); }
            grid.sync();
            scan_phase(KARGS(), lds, L == 0, L);
            grid.sync();
            fox_attn_phase(KARGS(), lds, L);
            grid.sync();
        } else {
            if (L == 2) {
                { KP p = KARGS(); unsigned char* ws = p->ws;
                  EpiKV E{(bf16_t*)(ws + WS_KV), (bf16_t*)(ws + WS_RAWK), (bf16_t*)(ws + WS_RAWV), (bf16_t*)(ws + WS_VT)};
                  RUN_GEMM(EpiKV, E, (const bf16_t*)(ws + WS_HBF), (const bf16_t*)(ws + WS_WKV), S_, NKV, DM, DM, bid); }
                grid.sync();
#pragma nounroll
                for (int mat = 0; mat < 2; ++mat) { KP p = KARGS(); unsigned char* ws = p->ws;
                    EpiCmp1 E{(bf16_t*)(ws + WS_CH) + (size_t)mat * 4096 * 256, (const float*)(ws + WS_CB) + mat * 256};
                    RUN_GEMM(EpiCmp1, E, (const bf16_t*)(ws + (mat ? WS_RAWV : WS_RAWK)), (const bf16_t*)(ws + WS_WC1) + (size_t)mat * 256 * 4096, 4096, 256, 4096, 2048, (bid + G - 16 * mat) % G);
                }
                grid.sync();
                cmp2_phase(KARGS());
                grid.sync();
            }
            { KP p = KARGS(); unsigned char* ws = p->ws;
              EpiNsaQ E{(bf16_t*)(ws + WS_A), (float*)(ws + WS_GATE)};
              RUN_GEMM(EpiNsaQ, E, (const bf16_t*)(ws + WS_HBF), (const bf16_t*)(ws + WS_WNSAIN) + (size_t)(L - 2) * NNSA * DM, S_, NNSA, DM, DM, bid); }
            grid.sync();
            nsa_attn_phase(KARGS(), lds);
            grid.sync();
        }
        { KP p = KARGS(); unsigned char* ws = p->ws; bf16_t* A0 = (bf16_t*)(ws + WS_A);
          const float* hres = L == 0 ? p->in[I_X] : p->out;
          const bf16_t* attn = L < 2 ? A0 + 3 * SD : A0 + SD;
          const bf16_t* wo = L < 2 ? (const bf16_t*)(ws + WS_WFOXO) + (size_t)L * DM * DM : (const bf16_t*)(ws + WS_WNSAO) + (size_t)(L - 2) * DM * DM;
          EpiRes E{hres, (float*)(ws + WS_PRE)}; RUN_GEMM(EpiRes, E, attn, wo, S_, DM, DM, DM, bid); }
        grid.sync();
        { KP p = KARGS(); ln_phase((const float*)(p->ws + WS_PRE), p->in[I_LN1G] + L * DM, p->in[I_LN1B] + L * DM, p->out, (bf16_t*)(p->ws + WS_HBF)); }
        grid.sync();
        { KP p = KARGS(); unsigned char* ws = p->ws;
          EpiRelu2 E{(bf16_t*)(ws + WS_A)}; RUN_GEMM(EpiRelu2, E, (const bf16_t*)(ws + WS_HBF), (const bf16_t*)(ws + WS_W1) + (size_t)L * FF * DM, S_, FF, DM, DM, bid); }
        grid.sync();
        { KP p = KARGS(); unsigned char* ws = p->ws;
          EpiRes E{p->out, (float*)(ws + WS_PRE)}; RUN_GEMM(EpiRes, E, (const bf16_t*)(ws + WS_A), (const bf16_t*)(ws + WS_W2) + (size_t)L * DM * FF, S_, DM, FF, FF, bid); }
        grid.sync();
        { KP p = KARGS(); ln_phase((const float*)(p->ws + WS_PRE), p->in[I_LN2G] + L * DM, p->in[I_LN2B] + L * DM, p->out, (bf16_t*)(p->ws + WS_HBF)); }
        grid.sync();
    }
}

extern "C" void kernel_launch(void* const* d_in, const int* in_sizes, int n_in, void* d_out, int out_size, void* d_ws, size_t ws_size, hipStream_t stream) {
    static int grid = 0;
    if (grid == 0) {
        if (n_in != 20 || out_size != S_ * DM || ws_size < WS_END) { fprintf(stderr, "kernel_launch: unexpected shapes (n_in %d out %d ws %zu)\n", n_in, out_size, ws_size); grid = -1; return; }
        int dev = 0, cus = 0, per_cu = 0;
        (void)hipGetDevice(&dev); (void)hipDeviceGetAttribute(&cus, hipDeviceAttributeMultiprocessorCount, dev);
        if (hipFuncSetAttribute((const void*)mega_fwd, hipFuncAttributeMaxDynamicSharedMemorySize, LDS_BYTES) != hipSuccess) fprintf(stderr, "kernel_launch: hipFuncSetAttribute failed\n");
        if (hipOccupancyMaxActiveBlocksPerMultiprocessor(&per_cu, (const void*)mega_fwd, 512, LDS_BYTES) != hipSuccess || per_cu < 1) per_cu = 1;
        (void)hipGetLastError();
        if (cus <= 0) cus = 256;
        grid = cus * per_cu;
    }
    if (grid < 0) return;
    Params p{};
    for (int i = 0; i < 20; ++i) p.in[i] = (const float*)d_in[i];
    p.out = (float*)d_out; p.ws = (unsigned char*)d_ws;
    void* args[] = {&p};
    hipError_t e = hipLaunchCooperativeKernel((const void*)mega_fwd, dim3(grid), dim3(512), args, LDS_BYTES, stream);
    if (e != hipSuccess) fprintf(stderr, "kernel_launch: cooperative launch failed: %s (grid %d)\n", hipGetErrorString(e), grid);
}
```

```cpp
#include <hip/hip_runtime.h>
#include <hip/hip_cooperative_groups.h>
#include <hip/hip_fp16.h>
#include <cstdio>
#include <cstdint>
namespace cg = cooperative_groups;
namespace pg8 {
#define PG8_LAS __attribute__((address_space(3)))
typedef unsigned short bf16_t;
typedef short bf16x8 __attribute__((ext_vector_type(8)));
typedef float f32x4 __attribute__((ext_vector_type(4)));
typedef unsigned u32x4 __attribute__((ext_vector_type(4)));
constexpr int BM = 256, BK = 64, HALF = 128, HTB = HALF * BK * 2  , STAGE_BYTES = 8 * HTB, NXCD = 8, WGM = 8;

__host__ __device__ __forceinline__ int lds_byte(int r, int c) { const int st = (r >> 4) * 2 + (c >> 5), rr = r & 15, cc = c & 31, ob = rr * 64 + cc * 2; return st * 1024 + (ob ^ (((ob >> 9) & 1) << 5)); }
__host__ __device__ __forceinline__ void stage_rc(int b, int& R, int& C) { const int st = b / 1024, sb = b % 1024, swz = sb ^ (((sb >> 9) & 1) << 5); R = (st >> 1) * 16 + swz / 64; C = (st & 1) * 32 + (swz % 64) / 2; }
__host__ __device__ __forceinline__ int perm32(int rho) { const int n = rho >> 4, i = rho & 15; return 8 * (i >> 2) + 4 * n + (i & 3); }

struct Unit { int pm, pn; };
struct Gemm { const bf16_t* A; const bf16_t* Bt; int M, N, K, lda; };

struct StaticOrder {
    int nM, nN, nwg, G, c;
    __host__ __device__ void init(int M, int N, int G_, int c_) { nM = M / BM; nN = N / BM; nwg = nM * nN; G = G_; c = c_; }
    __host__ __device__ bool next(int i, Unit& u) const {
        const long L = (long)i * G + c; if (L >= nwg) return false;
        int wgid = (int)L; { const int q = nwg / NXCD, r = nwg % NXCD, xcd = wgid % NXCD, off = wgid / NXCD; wgid = (xcd < r ? xcd * (q + 1) : r * (q + 1) + (xcd - r) * q) + off; }
        const int nig = WGM * nN, gid = wgid / nig, fm = gid * WGM, gsz = (nM - fm) < WGM ? (nM - fm) : WGM;
        u.pm = fm + ((wgid % nig) % gsz); u.pn = (wgid % nig) / gsz; return true;
    }
    __device__ __forceinline__ void a_ready(const Unit&) const {}
    __device__ __forceinline__ void done(const Unit&) const {}
};


__device__ __forceinline__ unsigned cvt_pk_bf16(float lo, float hi) { unsigned r; asm volatile("v_cvt_pk_bf16_f32 %0, %1, %2" : "=v"(r) : "v"(lo), "v"(hi)); return r; }
typedef float f32x2 __attribute__((ext_vector_type(2)));
template <class Epi, class Sched, bool ALIGN_EPI = false, bool SP2 = false>
__device__ __forceinline__ void gemm_phase(PG8_LAS unsigned char* lds, const Gemm g, const Sched& S, const Epi& E) {
    int tid_ = threadIdx.x; asm volatile("" : "+v"(tid_));
    const int tid = tid_, wid = __builtin_amdgcn_readfirstlane(tid >> 6), lane = tid & 63, wr = wid >> 2, wc = wid & 3, fr = lane & 15, fq = lane >> 4;
    const int K = g.K, nt = K / BK;
    unsigned voffA[2], voffB[2];
#pragma unroll
    for (int i = 0; i < 2; ++i) { int R, C; stage_rc(tid * 16 + i * 8192, R, C); const int Rb = Epi::PERM ? ((R & ~31) + perm32(R & 31)) : R;
        voffA[i] = (unsigned)(R * g.lda + C) * 2u; voffB[i] = (unsigned)(Rb * K + C) * 2u; }
    const size_t kstep = (size_t)(BK * 2);
    const size_t hstepB = (size_t)HALF * K * 2, hstepA = (size_t)HALF * g.lda * 2;
    const size_t tstepB = 2 * hstepB, tstepA = 2 * hstepA;
    const unsigned ldsw = (unsigned)wid * 1024u;
    const int aoff = lds_byte(wr * 64 + fr, fq * 8), boff = lds_byte(wc * 32 + fr, fq * 8);
#define PG8_SA(b, h) (((b) * 2 + (h)) * HTB)
#define PG8_SB(b, h) ((4 + (b) * 2 + (h)) * HTB)
#define PG8_STAGE(bufoff, gbase, voff) do { _Pragma("unroll") for (int _i = 0; _i < 2; ++_i) \
        __builtin_amdgcn_global_load_lds((const unsigned*)((const char*)(gbase) + (voff)[_i]), (PG8_LAS unsigned*)(lds + (bufoff) + ldsw + _i * 8192), 16, 0, 0); } while (0)
#define PG8_LDA(dst, b, h) do { _Pragma("unroll") for (int m = 0; m < 4; ++m) _Pragma("unroll") for (int k = 0; k < 2; ++k) dst[m][k] = *(const PG8_LAS bf16x8*)(lds + PG8_SA(b, h) + aoff + m * 2048 + k * 1024); } while (0)
#define PG8_LDB(dst, b, h) do { _Pragma("unroll") for (int n = 0; n < 2; ++n) _Pragma("unroll") for (int k = 0; k < 2; ++k) dst[n][k] = *(const PG8_LAS bf16x8*)(lds + PG8_SB(b, h) + boff + n * 2048 + k * 1024); } while (0)
#define PG8_MMA(ai, bj, At, Bt) do { __builtin_amdgcn_s_setprio(1); _Pragma("unroll") for (int m = 0; m < 4; ++m) _Pragma("unroll") for (int n = 0; n < 2; ++n) _Pragma("unroll") for (int k = 0; k < 2; ++k) \
        acc[ai][bj][m][n] = __builtin_amdgcn_mfma_f32_16x16x32_bf16(Bt[n][k], At[m][k], acc[ai][bj][m][n], 0, 0, 0); __builtin_amdgcn_s_setprio(0); } while (0)
#define PG8_WAIT_V(n) asm volatile("s_waitcnt vmcnt(" #n ")" ::: "memory")
#define PG8_WAIT_L(n) asm volatile("s_waitcnt lgkmcnt(" #n ")" ::: "memory")
#define PG8_BAR __builtin_amdgcn_s_barrier()
#define PG8_SCHED __builtin_amdgcn_sched_barrier(0)
    Unit cur, nxt; int ui = 0;
    if (!S.next(0, cur)) return;
    f32x4 acc[2][2][4][2];
#pragma unroll
    for (int a = 0; a < 2; ++a)
#pragma unroll
        for (int b = 0; b < 2; ++b)
#pragma unroll
            for (int m = 0; m < 4; ++m)
#pragma unroll
                for (int n = 0; n < 2; ++n) acc[a][b][m][n] = (f32x4){0.f, 0.f, 0.f, 0.f};
    bf16x8 At[4][2], B0[2][2], B1[2][2];
    const char* cA = (const char*)g.A + (size_t)cur.pm * tstepA; const char* cB = (const char*)g.Bt + (size_t)cur.pn * tstepB;
    S.a_ready(cur);
    if constexpr (SP2) {
        PG8_STAGE(PG8_SB(0, 0), cB, voffB); PG8_STAGE(PG8_SB(0, 1), cB + hstepB, voffB); PG8_STAGE(PG8_SA(0, 0), cA, voffA); PG8_STAGE(PG8_SA(0, 1), cA + hstepA, voffA);
        if (wr == 1) PG8_BAR;
        PG8_WAIT_V(2); PG8_BAR;
        PG8_STAGE(PG8_SB(1, 0), cB + kstep, voffB); PG8_STAGE(PG8_SA(1, 0), cA + kstep, voffA); PG8_STAGE(PG8_SB(1, 1), cB + hstepB + kstep, voffB);
        PG8_WAIT_V(6); PG8_BAR;
    } else {
        PG8_STAGE(PG8_SB(0, 0), cB, voffB); PG8_STAGE(PG8_SA(0, 0), cA, voffA); PG8_STAGE(PG8_SB(0, 1), cB + hstepB, voffB); PG8_STAGE(PG8_SA(0, 1), cA + hstepA, voffA);
        if (wr == 1) PG8_BAR;
        PG8_WAIT_V(4); PG8_BAR;
        PG8_STAGE(PG8_SB(1, 0), cB + kstep, voffB); PG8_STAGE(PG8_SA(1, 0), cA + kstep, voffA); PG8_STAGE(PG8_SB(1, 1), cB + hstepB + kstep, voffB);
        PG8_WAIT_V(6); PG8_BAR;
    }
    for (;;) {
        const bool has_next = S.next(ui + 1, nxt);
        const char* nA = has_next ? (const char*)g.A + (size_t)nxt.pm * tstepA : cA; const char* nB = has_next ? (const char*)g.Bt + (size_t)nxt.pn * tstepB : cB;
        for (int t = 0; t < nt; t += 2) {
            const bool last = (t == nt - 2);
            const char* a1 = cA + (size_t)(t + 1) * kstep;
            const char* a2 = last ? nA : cA + (size_t)(t + 2) * kstep; const char* b2 = last ? nB : cB + (size_t)(t + 2) * kstep;
            const char* a3 = a2 + kstep; const char* b3 = b2 + kstep;
            if (last && has_next) S.a_ready(nxt);
            if constexpr (SP2) {
            PG8_LDB(B0, 0, 0); PG8_LDB(B1, 0, 1); PG8_SCHED; PG8_LDA(At, 0, 0); PG8_STAGE(PG8_SA(1, 1), a1 + hstepA, voffA);
            PG8_WAIT_V(8); PG8_WAIT_L(0); PG8_BAR; PG8_MMA(0, 0, At, B0); PG8_MMA(0, 1, At, B1); PG8_BAR; PG8_SCHED;
            PG8_LDA(At, 0, 1); PG8_STAGE(PG8_SB(0, 0), b2, voffB); PG8_STAGE(PG8_SB(0, 1), b2 + hstepB, voffB); PG8_STAGE(PG8_SA(0, 0), a2, voffA);
            PG8_WAIT_V(8); PG8_WAIT_L(0); PG8_BAR; PG8_MMA(1, 0, At, B0); PG8_MMA(1, 1, At, B1); PG8_BAR; PG8_SCHED;
            PG8_LDB(B0, 1, 0); PG8_LDB(B1, 1, 1); PG8_SCHED; PG8_LDA(At, 1, 0); PG8_STAGE(PG8_SA(0, 1), a2 + hstepA, voffA);
            PG8_WAIT_V(8); PG8_WAIT_L(0); PG8_BAR; PG8_MMA(0, 0, At, B0); PG8_MMA(0, 1, At, B1); PG8_BAR; PG8_SCHED;
            PG8_LDA(At, 1, 1); PG8_STAGE(PG8_SB(1, 0), b3, voffB); PG8_STAGE(PG8_SB(1, 1), b3 + hstepB, voffB); PG8_STAGE(PG8_SA(1, 0), a3, voffA);
            PG8_WAIT_V(8); PG8_WAIT_L(0); PG8_BAR; PG8_MMA(1, 0, At, B0); PG8_MMA(1, 1, At, B1); PG8_BAR; PG8_SCHED;
            }
        }
        if constexpr (ALIGN_EPI) { if (wr == 0) PG8_BAR; }
        if constexpr (!Epi::AFTER_DRAIN) { E(acc, cur, wr, wc, fr, fq); S.done(cur); }
        if (!has_next) break;
#pragma unroll
        for (int a = 0; a < 2; ++a)
#pragma unroll
            for (int b = 0; b < 2; ++b)
#pragma unroll
                for (int m = 0; m < 4; ++m)
#pragma unroll
                    for (int n = 0; n < 2; ++n) acc[a][b][m][n] = (f32x4){0.f, 0.f, 0.f, 0.f};
        cur = nxt; cA = nA; cB = nB; ++ui;
        if constexpr (ALIGN_EPI) { if (wr == 1) PG8_BAR; }
    }
    PG8_WAIT_V(0);
    if constexpr (!ALIGN_EPI) { if (wr == 0) PG8_BAR; }
    PG8_BAR;
    if constexpr (Epi::AFTER_DRAIN) { E.fused(acc, cur, wr, wc, fr, fq, lds, wid, lane); S.done(cur); }
#undef PG8_SA
#undef PG8_SB
#undef PG8_STAGE
#undef PG8_LDA
#undef PG8_LDB
#undef PG8_MMA
#undef PG8_WAIT_V
#undef PG8_WAIT_L
#undef PG8_BAR
#undef PG8_SCHED
}
}

#define LAS __attribute__((address_space(3)))
using pg8::bf16_t; using pg8::bf16x8; using pg8::f32x4; using pg8::u32x4; using pg8::Unit; using pg8::cvt_pk_bf16;
typedef short s16x4 __attribute__((ext_vector_type(4)));
typedef float f32x16 __attribute__((ext_vector_type(16)));
typedef unsigned u32x2 __attribute__((ext_vector_type(2)));

constexpr int S_ = 16384, DM = 2048, FF = 8192, NH = 16, DH = 128, NG = 4;
constexpr int NFOX = 6400, NNSA = 2304, NKV = 3072;
constexpr float ALPHA_ = 1.6817928305074292f;
constexpr float QSCALE = 0.08838834764831845f;
constexpr float L2E = 1.4426950408889634f;
constexpr float LN_EPS_ = 1e-5f;

constexpr size_t MiB = 1u << 20;
constexpr size_t WS_WFOXIN = 0;
constexpr size_t WS_WFOXO  = 50 * MiB;
constexpr size_t WS_WNSAIN = 66 * MiB;
constexpr size_t WS_WNSAO  = 84 * MiB;
constexpr size_t WS_WKV    = 100 * MiB;
constexpr size_t WS_W1     = 112 * MiB;
constexpr size_t WS_W2     = 240 * MiB;
constexpr size_t WS_WC1    = 368 * MiB;
constexpr size_t WS_HBF    = 372 * MiB;
constexpr size_t WS_PRE    = 436 * MiB;
constexpr size_t WS_A      = 564 * MiB;
constexpr size_t WS_KV     = 820 * MiB;
constexpr size_t WS_RAWK   = 916 * MiB;
constexpr size_t WS_RAWV   = 933 * MiB;
constexpr size_t WS_VT     = 950 * MiB;
constexpr size_t WS_CH     = 966 * MiB;
constexpr size_t WS_KC     = 970 * MiB;
constexpr size_t WS_VC     = 971 * MiB;
constexpr size_t WS_CUM    = 972 * MiB;
constexpr size_t WS_FLOG   = 973 * MiB;
constexpr size_t WS_GATE   = 974 * MiB;
constexpr size_t WS_LUT    = 977 * MiB;
constexpr size_t WS_CBP    = 977 * MiB + 256 * 1024;
constexpr size_t WS_CB     = 977 * MiB + 512 * 1024;
constexpr size_t WS_NRM    = 977 * MiB + 768 * 1024;
constexpr size_t WS_KF     = 978 * MiB;
constexpr size_t WS_END    = 994 * MiB;

constexpr int SHM_K = 16384, SHM_V = 16384;
constexpr int L_V = 0, L_K = 32768, L_WS = 65536, L_CK = 65536 + 2048, L_LUT = 69632, L_END = 69632 + 32768;
constexpr int LDS_BYTES = 147456;

__device__ __forceinline__ u32x4 pack8bf(f32x4 a, f32x4 b) { u32x4 w; w.x = cvt_pk_bf16(a[0], a[1]); w.y = cvt_pk_bf16(a[2], a[3]); w.z = cvt_pk_bf16(b[0], b[1]); w.w = cvt_pk_bf16(b[2], b[3]); return w; }
__device__ __forceinline__ float log_sigmoid_f(float x) { return fminf(x, 0.f) - log1pf(__expf(-fabsf(x))); }
__device__ __forceinline__ float sigmoid_f(float x) { return 1.f / (1.f + __expf(-x)); }
__device__ __forceinline__ float gelu_tanh_f(float x) { const float u = 0.7978845608028654f * (x + 0.044715f * x * x * x); const float t = 1.f - 2.f / (__expf(2.f * u) + 1.f); return 0.5f * x * (1.f + t); }

struct EpiFoxQKV {
    static constexpr bool PERM = true, AFTER_DRAIN = false;
    bf16_t* q; float* flog; const float* bfg;
    __device__ __forceinline__ void operator()(const f32x4 (&acc)[2][2][4][2], const Unit& u, int wr, int wc, int fr, int fq) const {
        const int row0 = u.pm * 256 + wr * 64 + fr; const int colt = u.pn * 256;
        if (colt < 6144) {
            const int t = colt >> 11; bf16_t* base = q + (size_t)t * ((size_t)S_ * DM); const float sc = t == 0 ? QSCALE : 1.f;
            const int c0 = colt - t * 2048 + wc * 32 + 8 * fq;
#pragma unroll
            for (int ai = 0; ai < 2; ++ai)
#pragma unroll
                for (int m = 0; m < 4; ++m) { bf16_t* rowp = base + (size_t)(row0 + ai * 128 + m * 16) * DM + c0;
#pragma unroll
                    for (int bj = 0; bj < 2; ++bj) *(u32x4*)(rowp + bj * 128) = pack8bf(acc[ai][bj][m][0] * sc, acc[ai][bj][m][1] * sc); }
        } else if (wc == 0 && fq < 2) {
            float bb[8];
#pragma unroll
            for (int e = 0; e < 8; ++e) bb[e] = bfg[8 * fq + e];
#pragma unroll
            for (int ai = 0; ai < 2; ++ai)
#pragma unroll
                for (int m = 0; m < 4; ++m) { float* rowp = flog + (size_t)(row0 + ai * 128 + m * 16) * 16 + 8 * fq;
                    f32x4 a = acc[ai][0][m][0], b = acc[ai][0][m][1], oa, ob;
#pragma unroll
                    for (int e = 0; e < 4; ++e) { oa[e] = log_sigmoid_f(a[e] + bb[e]); ob[e] = log_sigmoid_f(b[e] + bb[4 + e]); }
                    *(f32x4*)rowp = oa; *(f32x4*)(rowp + 4) = ob; }
        }
    }
};
struct EpiNsaQ {
    static constexpr bool PERM = true, AFTER_DRAIN = false;
    bf16_t* q; float* gates;
    __device__ __forceinline__ void operator()(const f32x4 (&acc)[2][2][4][2], const Unit& u, int wr, int wc, int fr, int fq) const {
        const int row0 = u.pm * 256 + wr * 64 + fr; const int colt = u.pn * 256;
        if (colt < 2048) {
            const int c0 = colt + wc * 32 + 8 * fq;
#pragma unroll
            for (int ai = 0; ai < 2; ++ai)
#pragma unroll
                for (int m = 0; m < 4; ++m) { bf16_t* rowp = q + (size_t)(row0 + ai * 128 + m * 16) * DM + c0;
#pragma unroll
                    for (int bj = 0; bj < 2; ++bj) *(u32x4*)(rowp + bj * 128) = pack8bf(acc[ai][bj][m][0] * QSCALE, acc[ai][bj][m][1] * QSCALE); }
        } else { const int c0 = wc * 32 + 8 * fq;
            if (c0 < 48) {
#pragma unroll
            for (int ai = 0; ai < 2; ++ai)
#pragma unroll
                for (int m = 0; m < 4; ++m) { float* rowp = gates + (size_t)(row0 + ai * 128 + m * 16) * 48 + c0;
                    f32x4 a = acc[ai][0][m][0], b = acc[ai][0][m][1], oa, ob;
#pragma unroll
                    for (int e = 0; e < 4; ++e) { oa[e] = sigmoid_f(a[e]); ob[e] = sigmoid_f(b[e]); }
                    *(f32x4*)rowp = oa; *(f32x4*)(rowp + 4) = ob; } }
        }
    }
};
struct EpiRes {
    static constexpr bool PERM = true, AFTER_DRAIN = false;
    const float* res; float* out;
    __device__ __forceinline__ void operator()(const f32x4 (&acc)[2][2][4][2], const Unit& u, int wr, int wc, int fr, int fq) const {
        const int row0 = u.pm * 256 + wr * 64 + fr; const int c0 = u.pn * 256 + wc * 32 + 8 * fq;
#pragma unroll
        for (int ai = 0; ai < 2; ++ai)
#pragma unroll
            for (int m = 0; m < 4; ++m) { const size_t off = (size_t)(row0 + ai * 128 + m * 16) * DM + c0;
#pragma unroll
                for (int bj = 0; bj < 2; ++bj) { const f32x4 r0 = *(const f32x4*)(res + off + bj * 128), r1 = *(const f32x4*)(res + off + bj * 128 + 4);
                    *(f32x4*)(out + off + bj * 128) = r0 * ALPHA_ + acc[ai][bj][m][0]; *(f32x4*)(out + off + bj * 128 + 4) = r1 * ALPHA_ + acc[ai][bj][m][1]; } }
    }
};
struct EpiRelu2 {
    static constexpr bool PERM = true, AFTER_DRAIN = false;
    bf16_t* O;
    __device__ __forceinline__ void operator()(const f32x4 (&acc)[2][2][4][2], const Unit& u, int wr, int wc, int fr, int fq) const {
        const int row0 = u.pm * 256 + wr * 64 + fr; const int c0 = u.pn * 256 + wc * 32 + 8 * fq;
#pragma unroll
        for (int ai = 0; ai < 2; ++ai)
#pragma unroll
            for (int m = 0; m < 4; ++m) { bf16_t* rowp = O + (size_t)(row0 + ai * 128 + m * 16) * FF + c0;
#pragma unroll
                for (int bj = 0; bj < 2; ++bj) { f32x4 a = acc[ai][bj][m][0], b = acc[ai][bj][m][1];
#pragma unroll
                    for (int e = 0; e < 4; ++e) { a[e] = fmaxf(a[e], 0.f); a[e] *= a[e]; b[e] = fmaxf(b[e], 0.f); b[e] *= b[e]; }
                    *(u32x4*)(rowp + bj * 128) = pack8bf(a, b); } }
    }
};
__device__ __forceinline__ int vt_pos(int ko) { return ((ko & 15) >> 2) * 8 + ((ko >> 4) << 2) + (ko & 3); }
struct EpiKV {
    static constexpr bool PERM = true, AFTER_DRAIN = false;
    bf16_t* kv; bf16_t* rawk; bf16_t* rawv; bf16_t* vt; bf16_t* kf;
    __device__ __forceinline__ void operator()(const f32x4 (&acc)[2][2][4][2], const Unit& u, int wr, int wc, int fr, int fq) const {
        const int row0 = u.pm * 256 + wr * 64 + fr;
#pragma unroll
        for (int bj = 0; bj < 2; ++bj) {
            const int cg_ = u.pn * 256 + bj * 128; const int slot = cg_ >> 9, g = (cg_ & 511) >> 7; const int d0 = wc * 32 + 8 * fq;
#pragma unroll
            for (int ai = 0; ai < 2; ++ai)
#pragma unroll
                for (int m = 0; m < 4; ++m) { const int row = row0 + ai * 128 + m * 16; const f32x4 a = acc[ai][bj][m][0], b = acc[ai][bj][m][1];
                    if (slot < 2) { bf16_t* dst = (slot == 0 ? rawk : rawv) + ((size_t)g * S_ + row) * 128 + d0; *(u32x4*)dst = pack8bf(a, b); }
                    else if (slot == 2) { const int blk = row >> 6, kin = row & 63;
                        *(u32x4*)(kf + ((size_t)((g * 256 + blk) * 16 + (kin >> 4) * 4 + wc)) * 512 + (fq * 16 + (kin & 15)) * 8) = pack8bf(a, b); }
                    else if (slot == 3) { const u32x4 w = pack8bf(a, b); const int blk = row >> 6, kin = row & 63, pos = vt_pos(kin & 31);
                        bf16_t* dst = vt + ((size_t)((g * 256 + blk) * 16 + (wc * 2 + (fq >> 1)) * 2 + (kin >> 5))) * 512 + ((pos >> 3) * 16 + (fq & 1) * 8) * 8 + (pos & 7);
                        dst[0] = (bf16_t)(w.x & 0xffffu); dst[8] = (bf16_t)(w.x >> 16); dst[16] = (bf16_t)(w.y & 0xffffu); dst[24] = (bf16_t)(w.y >> 16);
                        dst[32] = (bf16_t)(w.z & 0xffffu); dst[40] = (bf16_t)(w.z >> 16); dst[48] = (bf16_t)(w.w & 0xffffu); dst[56] = (bf16_t)(w.w >> 16); }
                    else { *(u32x4*)(kv + (size_t)row * NKV + cg_ + d0) = pack8bf(a, b); } }
        }
    }
};
struct EpiCmp1 {
    static constexpr bool PERM = true, AFTER_DRAIN = false;
    bf16_t* O; const float* bias;
    __device__ __forceinline__ void operator()(const f32x4 (&acc)[2][2][4][2], const Unit& u, int wr, int wc, int fr, int fq) const {
        const int row0 = u.pm * 256 + wr * 64 + fr; const int c0 = wc * 32 + 8 * fq;
#pragma unroll
        for (int bj = 0; bj < 2; ++bj) { const f32x4 b0 = *(const f32x4*)(bias + c0 + bj * 128), b1 = *(const f32x4*)(bias + c0 + bj * 128 + 4);
#pragma unroll
            for (int ai = 0; ai < 2; ++ai)
#pragma unroll
                for (int m = 0; m < 4; ++m) { f32x4 a = acc[ai][bj][m][0] + b0, b = acc[ai][bj][m][1] + b1;
#pragma unroll
                    for (int e = 0; e < 4; ++e) { a[e] = gelu_tanh_f(a[e]); b[e] = gelu_tanh_f(b[e]); }
                    *(u32x4*)(O + (size_t)(row0 + ai * 128 + m * 16) * 256 + c0 + bj * 128) = pack8bf(a, b); } }
    }
};

__device__ __forceinline__ unsigned f2bf(float f) { unsigned u = __builtin_bit_cast(unsigned, f); return (u + 0x7fffu + ((u >> 16) & 1u)) >> 16; }
__device__ __forceinline__ unsigned pk2(float lo, float hi) { return f2bf(lo) | (f2bf(hi) << 16); }
__device__ __forceinline__ float wave_sum(float v) {
#pragma unroll
    for (int o = 1; o < 64; o <<= 1) v += __shfl_xor(v, o);
    return v;
}
__device__ __forceinline__ float wave_max(float v) {
#pragma unroll
    for (int o = 1; o < 64; o <<= 1) v = fmaxf(v, __shfl_xor(v, o));
    return v;
}
__device__ __forceinline__ void transpose_item(const float* W, int K, int ld, int ncols, bf16_t* WT, LAS float* scr, int item, int lane) {
    const int nblk = ncols / 32, kb = item / nblk, nb = item % nblk, k0 = 64 * kb, n0 = 32 * nb;
#pragma unroll 8
    for (int i = 0; i < 32; ++i) { const int kk = 2 * i + (lane >> 5); scr[kk * 33 + (lane & 31)] = W[(size_t)(k0 + kk) * ld + n0 + (lane & 31)]; }
    asm volatile("s_waitcnt lgkmcnt(0)" ::: "memory");
    const int c = lane & 7;
#pragma unroll
    for (int j = 0; j < 4; ++j) { const int n = (lane >> 3) + 8 * j; const LAS float* s = scr + (8 * c) * 33 + n;
        u32x4 o; o.x = pk2(s[0 * 33], s[1 * 33]); o.y = pk2(s[2 * 33], s[3 * 33]); o.z = pk2(s[4 * 33], s[5 * 33]); o.w = pk2(s[6 * 33], s[7 * 33]);
        *(u32x4*)(WT + (size_t)(n0 + n) * K + k0 + 8 * c) = o; }
    asm volatile("s_waitcnt lgkmcnt(0)" ::: "memory");
}
__device__ __forceinline__ int rel_bucket_dev(int n) {
    if (n < 16) return n;
    int lg = 16 + (int)(__logf((float)n / 16.0f) / 4.852030263919617f * 16.0f);
    return lg > 31 ? 31 : lg;
}

struct Params { const float* in[20]; float* out; unsigned char* ws; };
typedef const Params __attribute__((address_space(4)))* KP;
#define KARGS() ({ KP q_ = (KP)__builtin_amdgcn_kernarg_segment_ptr(); asm volatile("" : "+s"(q_)); q_; })
enum { I_X = 0, I_FOXWIN, I_FOXBF, I_FOXWO, I_NSAWIN, I_NSAWO, I_KVW, I_POSK, I_POSV, I_CK1, I_CK2, I_CV1, I_CV2, I_RELB, I_W1, I_W2, I_LN1G, I_LN1B, I_LN2G, I_LN2B };

__device__ __forceinline__ void prologue(KP p, LAS unsigned char* lds) {
    int tid_ = threadIdx.x; asm volatile("" : "+v"(tid_));
    const int tid = tid_, lane = tid & 63, wave = tid >> 6;
    const int gw = blockIdx.x * 8 + wave, NGW = gridDim.x * 8;
    LAS float* scr = (LAS float*)(lds + wave * 16384);
    unsigned char* ws = p->ws;
    long base = 0;
#define TR(src, K, ld, ncols, dst) do { const long n_ = (long)((K) / 64) * ((ncols) / 32); \
        for (long it = gw; it < n_; it += NGW) transpose_item((src), (K), (ld), (ncols), (dst), scr, (int)it, lane); } while (0)
    for (int L = 0; L < 2; ++L) {
        TR(p->in[I_FOXWIN] + (size_t)L * DM * 6160, DM, 6160, 6144, (bf16_t*)(ws + WS_WFOXIN) + (size_t)L * NFOX * DM);
        TR(p->in[I_FOXWO] + (size_t)L * DM * DM, DM, DM, DM, (bf16_t*)(ws + WS_WFOXO) + (size_t)L * DM * DM);
        TR(p->in[I_NSAWIN] + (size_t)L * DM * 2096, DM, 2096, 2048, (bf16_t*)(ws + WS_WNSAIN) + (size_t)L * NNSA * DM);
        TR(p->in[I_NSAWO] + (size_t)L * DM * DM, DM, DM, DM, (bf16_t*)(ws + WS_WNSAO) + (size_t)L * DM * DM);
    }
    TR(p->in[I_KVW], DM, NKV, NKV, (bf16_t*)(ws + WS_WKV));
    for (int L = 0; L < 4; ++L) {
        TR(p->in[I_W1] + (size_t)L * DM * FF, DM, FF, FF, (bf16_t*)(ws + WS_W1) + (size_t)L * FF * DM);
        TR(p->in[I_W2] + (size_t)L * FF * DM, FF, DM, DM, (bf16_t*)(ws + WS_W2) + (size_t)L * DM * FF);
    }
    TR(p->in[I_CK1], 4096, 256, 256, (bf16_t*)(ws + WS_WC1));
    TR(p->in[I_CV1], 4096, 256, 256, (bf16_t*)(ws + WS_WC1) + (size_t)256 * 4096);
#undef TR
    (void)base;
    const int gt = blockIdx.x * 512 + tid, NGT = gridDim.x * 512;
    for (int i = gt; i < 2 * 256 * DM; i += NGT) { const int L = i / (256 * DM), r = (i / DM) % 256, k = i % DM;
        const float v = r < 16 ? p->in[I_FOXWIN][(size_t)L * DM * 6160 + (size_t)k * 6160 + 6144 + r] : 0.f;
        ((bf16_t*)(ws + WS_WFOXIN))[(size_t)L * NFOX * DM + (size_t)(6144 + r) * DM + k] = (bf16_t)f2bf(v); }
    for (int i = gt; i < 2 * 256 * DM; i += NGT) { const int L = i / (256 * DM), r = (i / DM) % 256, k = i % DM;
        const float v = r < 48 ? p->in[I_NSAWIN][(size_t)L * DM * 2096 + (size_t)k * 2096 + 2048 + r] : 0.f;
        ((bf16_t*)(ws + WS_WNSAIN))[(size_t)L * NNSA * DM + (size_t)(2048 + r) * DM + k] = (bf16_t)f2bf(v); }
    { const f32x4* x4 = (const f32x4*)p->in[I_X]; u32x2* o = (u32x2*)(ws + WS_HBF);
      for (int i = gt; i < S_ * DM / 4; i += NGT) { const f32x4 v = x4[i]; u32x2 w; w.x = pk2(v[0], v[1]); w.y = pk2(v[2], v[3]); o[i] = w; } }
    { float* lut = (float*)(ws + WS_LUT);
      for (int i = gt; i < 16 * 2048; i += NGT) { const int h = i >> 11, d = i & 2047; lut[i] = p->in[I_RELB][rel_bucket_dev(d) * 16 + h]; } }
    { float* part = (float*)(ws + WS_CBP);
      for (int i = gt; i < 2 * 64 * 256; i += NGT) { const int mat = i / (64 * 256), ch = (i / 256) % 64, c = i % 256;
          const float* pos = p->in[mat ? I_POSV : I_POSK]; const float* w1 = p->in[mat ? I_CV1 : I_CK1]; float s = 0.f;
          for (int j = ch * 64; j < ch * 64 + 64; ++j) s += pos[j] * w1[(size_t)j * 256 + c];
          part[i] = s; } }
    if (gt < 64) ((unsigned*)(ws + WS_NRM))[gt] = 0u;
    { bf16_t* rk = (bf16_t*)(ws + WS_RAWK) + (size_t)4 * S_ * 128; bf16_t* rv = (bf16_t*)(ws + WS_RAWV) + (size_t)4 * S_ * 128;
      for (int i = gt; i < 32 * 128; i += NGT) { rk[i] = 0; rv[i] = 0; } }
}

__device__ __forceinline__ void ln_phase(const float* pre, const float* gam, const float* bet, float* h32, bf16_t* hbf) {
    int tid_ = threadIdx.x; asm volatile("" : "+v"(tid_));
    const int tid = tid_, lane = tid & 63, wave = tid >> 6;
    const int gw = blockIdx.x * 8 + wave, NGW = gridDim.x * 8;
    for (int row = gw; row < S_; row += NGW) {
        const f32x4* xr = (const f32x4*)(pre + (size_t)row * DM) + lane;
        f32x4 v[8]; float s = 0.f;
#pragma unroll
        for (int j = 0; j < 8; ++j) { v[j] = xr[64 * j]; s += (v[j][0] + v[j][1]) + (v[j][2] + v[j][3]); }
        const float mean = wave_sum(s) * (1.f / DM); float s2 = 0.f;
#pragma unroll
        for (int j = 0; j < 8; ++j) { v[j] = v[j] - mean; s2 += (v[j][0] * v[j][0] + v[j][1] * v[j][1]) + (v[j][2] * v[j][2] + v[j][3] * v[j][3]); }
        const float rstd = 1.f / sqrtf(wave_sum(s2) * (1.f / DM) + LN_EPS_);
        f32x4* o4 = (f32x4*)(h32 + (size_t)row * DM) + lane; u32x2* o2 = (u32x2*)(hbf + (size_t)row * DM) + lane;
#pragma unroll
        for (int j = 0; j < 8; ++j) { const f32x4 g4 = ((const f32x4*)gam)[lane + 64 * j], b4 = ((const f32x4*)bet)[lane + 64 * j];
            const f32x4 y = v[j] * rstd * g4 + b4; o4[64 * j] = y; u32x2 w; w.x = pk2(y[0], y[1]); w.y = pk2(y[2], y[3]); o2[64 * j] = w; }
    }
}

__device__ __forceinline__ void scan_phase(KP p, LAS unsigned char* lds, bool do_cbias, int layer) {
    int tid_ = threadIdx.x; asm volatile("" : "+v"(tid_));
    const int tid = tid_; unsigned char* ws = p->ws;
    if (blockIdx.x < 16) {
        const int h = blockIdx.x; const float* fl = (const float*)(ws + WS_FLOG); float* cum = (float*)(ws + WS_CUM) + (size_t)h * S_;
        LAS float* sh = (LAS float*)lds;
        float loc[32]; float tot = 0.f;
#pragma unroll
        for (int i = 0; i < 32; ++i) { loc[i] = fl[(size_t)(tid * 32 + i) * 16 + h]; }
#pragma unroll
        for (int i = 0; i < 32; ++i) { tot += loc[i]; loc[i] = tot; }
        sh[tid] = tot; __syncthreads();
        for (int off = 1; off < 512; off <<= 1) { const float v = tid >= off ? sh[tid - off] : 0.f; __syncthreads(); sh[tid] += v; __syncthreads(); }
        const float excl = sh[tid] - tot;
#pragma unroll
        for (int i = 0; i < 32; ++i) cum[tid * 32 + i] = excl + loc[i];
        __syncthreads();
    } else if (blockIdx.x == 16) {
        if (do_cbias) {
        const float* part = (const float*)(ws + WS_CBP); float* cb = (float*)(ws + WS_CB);
        const int mat = tid >> 8, c = tid & 255; float s = 0.f;
        for (int ch = 0; ch < 64; ++ch) s += part[(mat * 64 + ch) * 256 + c];
        cb[tid] = s; }
    } else {
        const int nb = (int)gridDim.x - 17, b = (int)blockIdx.x - 17;
        const int h = tid & 15; float mq = 0.f, mk = 0.f;
        const bf16_t* Q = (const bf16_t*)(ws + WS_A); const bf16_t* K = Q + (size_t)S_ * DM;
        for (int t = b * 32 + (tid >> 4); t < S_; t += nb * 32) {
            const u32x4* qp = (const u32x4*)(Q + (size_t)t * DM + h * 128); const u32x4* kp = (const u32x4*)(K + (size_t)t * DM + h * 128);
            float sq = 0.f, sk = 0.f;
#pragma unroll 4
            for (int i = 0; i < 16; ++i) { const u32x4 a = qp[i], c = kp[i];
#pragma unroll
                for (int e = 0; e < 4; ++e) { const float q0 = __uint_as_float(a[e] << 16), q1 = __uint_as_float(a[e] & 0xffff0000u), k0 = __uint_as_float(c[e] << 16), k1 = __uint_as_float(c[e] & 0xffff0000u);
                    sq += q0 * q0 + q1 * q1; sk += k0 * k0 + k1 * k1; } }
            mq = fmaxf(mq, sq); mk = fmaxf(mk, sk);
        }
        mq = fmaxf(mq, __shfl_xor(mq, 16)); mq = fmaxf(mq, __shfl_xor(mq, 32)); mk = fmaxf(mk, __shfl_xor(mk, 16)); mk = fmaxf(mk, __shfl_xor(mk, 32));
        if ((tid & 63) < 16) { unsigned* nr = (unsigned*)(ws + WS_NRM) + (layer * 16 + h) * 2; atomicMax(nr, __float_as_uint(mq)); atomicMax(nr + 1, __float_as_uint(mk)); }
    }
}

__device__ __forceinline__ void cmp2_phase(KP p) {
    int tid_ = threadIdx.x; asm volatile("" : "+v"(tid_));
    const int tid = tid_; unsigned char* ws = p->ws;
    const int rr = tid >> 7, d = tid & 127;
    for (int it = blockIdx.x; it < 2 * 1024; it += gridDim.x) {
        const int mat = it >> 10, row = (it & 1023) * 4 + rr;
        const bf16_t* hid = (const bf16_t*)(ws + WS_CH) + (size_t)mat * 4096 * 256 + (size_t)row * 256;
        const float* w2 = p->in[mat ? I_CV2 : I_CK2];
        float s = 0.f;
        for (int k = 0; k < 256; k += 2) { const unsigned hv = *(const unsigned*)(hid + k);
            s += __uint_as_float(hv << 16) * w2[k * 128 + d]; s += __uint_as_float(hv & 0xffff0000u) * w2[(k + 1) * 128 + d]; }
        if ((row & 1023) == 1023) s = 0.f;
        ((bf16_t*)(ws + (mat ? WS_VC : WS_KC)))[(size_t)row * 128 + d] = (bf16_t)f2bf(s);
    }
}

#define KSWZ(row, colB) ((row) * 256 + ((colB) ^ (((row) & 7) << 4)))
#define SBAR() __builtin_amdgcn_sched_barrier(0)
__device__ __forceinline__ int v_st(int k, int c) { const int kk = (k & ~0xC) | ((k & 4) << 1) | ((k & 8) >> 1); return ((kk >> 3) * 4 + (c >> 5)) * 512 + ((kk & 7) * 32 + (c & 31)) * 2; }
__device__ __forceinline__ int v_rd_base(int lane) { return ((lane & 3) << 3) | (((lane >> 2) & 3) << 6) | (((lane >> 4) & 1) << 5) | (((lane >> 5) & 1) << 8); }
constexpr int v_rd_off(int d0, int ks, int half) { return d0 * 512 + ks * 4096 + half * 2048; }
__device__ __forceinline__ int crow(int r, int hi) { return (r & 3) + 8 * (r >> 2) + 4 * hi; }

__device__ __forceinline__ void qkt(f32x16& p0, f32x16& p1, const LAS unsigned char* Kb, int r32, int hi, const bf16x8* qr) {
#pragma unroll
    for (int r = 0; r < 16; ++r) { p0[r] = 0.f; p1[r] = 0.f; }
    const LAS unsigned char* kb[4];
#pragma unroll
    for (int dd = 0; dd < 4; ++dd) kb[dd] = Kb + KSWZ(r32, (dd * 16 + hi * 8) * 2);
#pragma unroll
    for (int d0 = 0; d0 < 8; ++d0) { const LAS unsigned char* a = kb[d0 & 3] + (d0 >> 2) * 128;
        const bf16x8 b0 = *(const LAS bf16x8*)a;
        const bf16x8 b1 = *(const LAS bf16x8*)(a + 32 * 256);
        p0 = __builtin_amdgcn_mfma_f32_32x32x16_bf16(b0, qr[d0], p0, 0, 0, 0);
        p1 = __builtin_amdgcn_mfma_f32_32x32x16_bf16(b1, qr[d0], p1, 0, 0, 0); }
}
__device__ __forceinline__ void pv_tile(f32x16* o, int vb, bf16x8 pa0, bf16x8 pa1, bf16x8 pa2, bf16x8 pa3) {
#define TRRD(dst, off) asm volatile("ds_read_b64_tr_b16 %0, %1 offset:%2" : "=&v"(dst) : "v"(vb), "i"(off) : "memory")
#define PV_D0(d0) do { s16x4 l0, l1, l2, l3, h0, h1, h2, h3; constexpr int b_ = v_rd_off(d0, 0, 0); \
        TRRD(l0, b_); TRRD(h0, b_ + 2048); TRRD(l1, b_ + 4096); TRRD(h1, b_ + 6144); TRRD(l2, b_ + 8192); TRRD(h2, b_ + 10240); TRRD(l3, b_ + 12288); TRRD(h3, b_ + 14336); \
        asm volatile("s_waitcnt lgkmcnt(0)" ::: "memory"); SBAR(); \
        o[d0] = __builtin_amdgcn_mfma_f32_32x32x16_bf16(pa0, (bf16x8){l0[0], l0[1], l0[2], l0[3], h0[0], h0[1], h0[2], h0[3]}, o[d0], 0, 0, 0);   \
        o[d0] = __builtin_amdgcn_mfma_f32_32x32x16_bf16(pa1, (bf16x8){l1[0], l1[1], l1[2], l1[3], h1[0], h1[1], h1[2], h1[3]}, o[d0], 0, 0, 0);   \
        o[d0] = __builtin_amdgcn_mfma_f32_32x32x16_bf16(pa2, (bf16x8){l2[0], l2[1], l2[2], l2[3], h2[0], h2[1], h2[2], h2[3]}, o[d0], 0, 0, 0);   \
        o[d0] = __builtin_amdgcn_mfma_f32_32x32x16_bf16(pa3, (bf16x8){l3[0], l3[1], l3[2], l3[3], h3[0], h3[1], h3[2], h3[3]}, o[d0], 0, 0, 0); } while (0)
    PV_D0(0); PV_D0(1); PV_D0(2); PV_D0(3);
#undef PV_D0
#undef TRRD
}
__device__ __forceinline__ void p_to_frags(const f32x16& p0, const f32x16& p1, bf16x8& pa0, bf16x8& pa1, bf16x8& pa2, bf16x8& pa3) {
#define PK4(P, B_, OUT) do { unsigned a0 = cvt_pk_bf16(P[B_+0], P[B_+1]), a1 = cvt_pk_bf16(P[B_+2], P[B_+3]);                          \
        unsigned b0 = cvt_pk_bf16(P[B_+4], P[B_+5]), b1 = cvt_pk_bf16(P[B_+6], P[B_+7]);                                             \
        auto r0 = __builtin_amdgcn_permlane32_swap(a0, b0, false, false); auto r1 = __builtin_amdgcn_permlane32_swap(a1, b1, false, false); \
        u32x4 w = {r0[0], r1[0], r0[1], r1[1]}; OUT = *reinterpret_cast<bf16x8*>(&w); } while (0)
    PK4(p0, 0, pa0); PK4(p0, 8, pa1); PK4(p1, 0, pa2); PK4(p1, 8, pa3);
#undef PK4
}
__device__ __forceinline__ float half_swap_max(float v) { auto rr = __builtin_amdgcn_permlane32_swap(__float_as_uint(v), __float_as_uint(v), false, false); return fmaxf(__uint_as_float(rr[0]), __uint_as_float(rr[1])); }
__device__ __forceinline__ float half_swap_sum(float v) { auto rr = __builtin_amdgcn_permlane32_swap(__float_as_uint(v), __float_as_uint(v), false, false); return __uint_as_float(rr[0]) + __uint_as_float(rr[1]); }
__device__ __forceinline__ float online_sm(f32x16& p0, f32x16& p1, float& m, float& l) {
    float pmax = p0[0];
#pragma unroll
    for (int r = 1; r < 16; ++r) pmax = fmaxf(pmax, p0[r]);
#pragma unroll
    for (int r = 0; r < 16; ++r) pmax = fmaxf(pmax, p1[r]);
    pmax = half_swap_max(pmax);
    const float mn = fmaxf(m, pmax); const float alpha = __builtin_amdgcn_exp2f((m - mn) * L2E); m = mn;
    const float mnL = -mn * L2E; float ps = 0.f;
#pragma unroll
    for (int r = 0; r < 16; ++r) { p0[r] = __builtin_amdgcn_exp2f(fmaf(p0[r], L2E, mnL)); p1[r] = __builtin_amdgcn_exp2f(fmaf(p1[r], L2E, mnL)); ps += p0[r] + p1[r]; }
    ps = half_swap_sum(ps);
    l = l * alpha + ps;
    return alpha;
}

struct FL {
    const bf16_t* K; const bf16_t* V; int kstride, vstride;
    int j_lo, j_hi;
    const float* cum; float cq;
    int t_lane, t_w0;
    const LAS float* lut;
    __half* imp;
};
template <int MODE>
__device__ __forceinline__ void flash_loop(LAS unsigned char* lds, const FL& a, const bf16x8* qr, float& m, float& l, f32x16* o, float inv_l) {
    int tid_ = threadIdx.x; asm volatile("" : "+v"(tid_));
    const int tid = tid_, wid = __builtin_amdgcn_readfirstlane(tid >> 6), lane = tid & 63, r32 = lane & 31, hi = lane >> 5;
    LAS unsigned char* V_lds = lds + L_V; LAS unsigned char* K_lds = lds + L_K;
    LAS float* al_l = (LAS float*)(lds + L_WS) + wid * 64 + 32;
    LAS float* ckb = (LAS float*)(lds + L_CK);
    const int sr = tid >> 4, sc = (tid & 15) * 8, vst0 = v_st(sr, sc), vst1 = v_st(32 + sr, sc), kws = KSWZ(sr, sc * 2);
    const int vb0 = (int)(size_t)V_lds + v_rd_base(lane);
    constexpr bool HASV = (MODE != 1);
    bf16x8 sk0, sk1, sv0, sv1; float sck = 0.f;
    const float NEG = -__builtin_inff();
    float carry = 0.f;
#define FL_LOAD(j) do { const int kb_ = (j) * 64; \
        sk0 = *(const bf16x8*)(a.K + (size_t)(kb_ + sr) * a.kstride + sc); sk1 = *(const bf16x8*)(a.K + (size_t)(kb_ + 32 + sr) * a.kstride + sc); \
        if (HASV) { sv0 = *(const bf16x8*)(a.V + (size_t)(kb_ + sr) * a.vstride + sc); sv1 = *(const bf16x8*)(a.V + (size_t)(kb_ + 32 + sr) * a.vstride + sc); } \
        if (MODE == 0) { if (tid < 64) sck = a.cum[kb_ + tid]; } } while (0)
#define FL_WRITE(buf) do { *(LAS bf16x8*)(K_lds + (buf) * SHM_K + kws) = sk0; *(LAS bf16x8*)(K_lds + (buf) * SHM_K + kws + 32 * 256) = sk1; \
        if (HASV) { *(LAS bf16x8*)(V_lds + (buf) * SHM_V + vst0) = sv0; *(LAS bf16x8*)(V_lds + (buf) * SHM_V + vst1) = sv1; } \
        if (MODE == 0) { if (tid < 64) ckb[(buf) * 64 + tid] = sck; } } while (0)
    __syncthreads();
    FL_LOAD(a.j_lo); FL_WRITE(0); __syncthreads();
#pragma nounroll
    for (int j = a.j_lo; j < a.j_hi; ++j) {
        const int buf = (j - a.j_lo) & 1; const int kb = j * 64;
        if (j + 1 < a.j_hi) FL_LOAD(j + 1);
        const bool act = (MODE != 0) || (kb <= a.t_w0 + 31);
        if (act) {
            f32x16 p0, p1;
            qkt(p0, p1, K_lds + buf * SHM_K, r32, hi, qr);
            if (MODE == 0) {
#pragma unroll
                for (int i = 0; i < 4; ++i) { const f32x4 c0 = *(const LAS f32x4*)(ckb + buf * 64 + 4 * hi + 8 * i), c1 = *(const LAS f32x4*)(ckb + buf * 64 + 32 + 4 * hi + 8 * i);
#pragma unroll
                    for (int e = 0; e < 4; ++e) { p0[4 * i + e] += a.cq - c0[e]; p1[4 * i + e] += a.cq - c1[e]; } }
                if (kb + 63 > a.t_w0) { const int dq = a.t_lane - kb - 4 * hi;
#pragma unroll
                    for (int r = 0; r < 16; ++r) { const int c = (r & 3) + 8 * (r >> 2); if (dq - c < 0) p0[r] = NEG; if (dq - c - 32 < 0) p1[r] = NEG; } }
            } else if (MODE == 1 || MODE == 2) {
                const int dq = a.t_lane - 16 * kb - 31 - 64 * hi;
#pragma unroll
                for (int r = 0; r < 16; ++r) { const int d0_ = dq - 16 * (r & 3) - 128 * (r >> 2), d1_ = d0_ - 512;
                    const unsigned i0 = (unsigned)d0_ < 2047u ? (unsigned)d0_ : 2047u, i1 = (unsigned)d1_ < 2047u ? (unsigned)d1_ : 2047u;
                    const float b0 = a.lut[i0], b1 = a.lut[i1];
                    p0[r] = d0_ >= 0 ? p0[r] + b0 : NEG; p1[r] = d1_ >= 0 ? p1[r] + b1 : NEG; }
            } else {
                const int dq = a.t_lane - kb - 4 * hi;
#pragma unroll
                for (int r = 0; r < 16; ++r) { const int d0_ = dq - ((r & 3) + 8 * (r >> 2)), d1_ = d0_ - 32;
                    const unsigned i0 = (unsigned)d0_ < 2047u ? (unsigned)d0_ : 2047u, i1 = (unsigned)d1_ < 2047u ? (unsigned)d1_ : 2047u;
                    const float b0 = a.lut[i0], b1 = a.lut[i1];
                    p0[r] = (unsigned)d0_ < 512u ? p0[r] + b0 : NEG; p1[r] = (unsigned)d1_ < 512u ? p1[r] + b1 : NEG; }
            }
            if (MODE == 1) { (void)online_sm(p0, p1, m, l); }
            else if (MODE == 2) {
                const float mnL = -m * L2E;
#pragma unroll
                for (int r = 0; r < 16; ++r) { p0[r] = __builtin_amdgcn_exp2f(fmaf(p0[r], L2E, mnL)) * inv_l; p1[r] = __builtin_amdgcn_exp2f(fmaf(p1[r], L2E, mnL)) * inv_l; }
                float a0[4], a1[4], x0[4], x1[4];
#pragma unroll
                for (int i = 0; i < 4; ++i) { a0[i] = (p0[4 * i] + p0[4 * i + 1]) + (p0[4 * i + 2] + p0[4 * i + 3]); a1[i] = (p1[4 * i] + p1[4 * i + 1]) + (p1[4 * i + 2] + p1[4 * i + 3]);
                    x0[i] = __shfl_xor(p0[4 * i + 3], 32); x1[i] = __shfl_xor(p1[4 * i + 3], 32); }
                __half* ip = a.imp + 16 * j + hi;
#pragma unroll
                for (int i = 0; i < 4; ++i) { const float e0 = hi ? x0[i] : (i ? x0[i > 0 ? i - 1 : 0] : carry); const float e1 = hi ? x1[i] : (i ? x1[i > 0 ? i - 1 : 0] : x0[3]);
                    ip[2 * i] = __float2half(a0[i] + e0); ip[8 + 2 * i] = __float2half(a1[i] + e1); }
                carry = x1[3];
                bf16x8 pa0, pa1, pa2, pa3; p_to_frags(p0, p1, pa0, pa1, pa2, pa3);
                pv_tile(o, vb0 + buf * SHM_V, pa0, pa1, pa2, pa3);
            } else {
                const float alpha = online_sm(p0, p1, m, l);
                if (__any(alpha < 1.f)) { if (hi == 0) al_l[r32] = alpha; asm volatile("s_waitcnt lgkmcnt(0)" ::: "memory");
#pragma unroll
                    for (int d_ = 0; d_ < 4; ++d_)
#pragma unroll
                        for (int r = 0; r < 16; ++r) o[d_][r] *= al_l[crow(r, hi)]; }
                bf16x8 pa0, pa1, pa2, pa3; p_to_frags(p0, p1, pa0, pa1, pa2, pa3);
                pv_tile(o, vb0 + buf * SHM_V, pa0, pa1, pa2, pa3);
            }
        }
        if (j + 1 < a.j_hi) FL_WRITE(buf ^ 1);
        __syncthreads();
    }
#undef FL_LOAD
#undef FL_WRITE
}

__device__ __forceinline__ void fox_attn_phase(KP p, LAS unsigned char* lds, int layer) {
    const int wid = __builtin_amdgcn_readfirstlane(threadIdx.x >> 6);
    unsigned char* ws = p->ws;
    const bf16_t* Q = (const bf16_t*)(ws + WS_A); const bf16_t* K = Q + (size_t)S_ * DM; const bf16_t* V = K + (size_t)S_ * DM; bf16_t* O = (bf16_t*)(V + (size_t)S_ * DM);
    const float* cumall = (const float*)(ws + WS_CUM);
    const unsigned* nrm = (const unsigned*)(ws + WS_NRM) + layer * 32;
    LAS float* li_l = (LAS float*)(lds + L_WS) + wid * 64;
    LAS int* jl = (LAS int*)(lds + L_CK + 1024);
    for (int I = blockIdx.x; I < 1024; I += gridDim.x) {
        const int kk = I >> 8, qbi = (I >> 4) & 63, h = ((I & 15) + 5 * kk) & 15;
        const int c_ = qbi & 15; const int qb = kk == 0 ? 63 - c_ : (kk == 1 ? c_ : (kk == 2 ? 47 - c_ : 16 + c_));
        {
            int tid_ = threadIdx.x; asm volatile("" : "+v"(tid_));
            const int lane = tid_ & 63, r32 = lane & 31, hi = lane >> 5;
            const int t_w0 = qb * 256 + wid * 32, t_lane = t_w0 + r32;
            const float* cum = cumall + (size_t)h * S_;
            const float B2 = 2.f * sqrtf(__uint_as_float(nrm[h * 2]) * __uint_as_float(nrm[h * 2 + 1])) * 1.01f;
            const float T = cum[qb * 256] + 110.f + B2;
            __syncthreads();
            { const bool ok = (tid_ < qb * 4 + 4) && (cum[64 * (tid_ < 256 ? tid_ : 0) + 63] <= T);
              const unsigned long long bm = __ballot(ok);
              if (lane == 0) jl[wid] = bm ? wid * 64 + (__ffsll((long long)bm) - 1) : (1 << 30); }
            __syncthreads();
            int j_lo = jl[0];
#pragma unroll
            for (int w = 1; w < 8; ++w) j_lo = min(j_lo, jl[w]);
            j_lo = __builtin_amdgcn_readfirstlane(j_lo);
            if (j_lo > qb * 4) j_lo = qb * 4;
            bf16x8 qr[8];
#pragma unroll
            for (int d0 = 0; d0 < 8; ++d0) qr[d0] = *(const bf16x8*)(Q + (size_t)t_lane * DM + h * 128 + d0 * 16 + hi * 8);
            FL a; a.K = K + h * 128; a.V = V + h * 128; a.kstride = DM; a.vstride = DM; a.j_lo = j_lo; a.j_hi = qb * 4 + 4;
            a.cum = cum; a.cq = cum[t_lane]; a.t_lane = t_lane; a.t_w0 = t_w0; a.lut = nullptr; a.imp = nullptr;
            float m = -1e30f, l = 0.f; f32x16 o[4];
#pragma unroll
            for (int d_ = 0; d_ < 4; ++d_)
#pragma unroll
                for (int r = 0; r < 16; ++r) o[d_][r] = 0.f;
            flash_loop<0>(lds, a, qr, m, l, o, 0.f);
            if (hi == 0) li_l[r32] = l; asm volatile("s_waitcnt lgkmcnt(0)" ::: "memory");
            bf16_t* Ow = O + (size_t)t_w0 * DM + h * 128;
            int lo_ = 4 * hi * DM + r32; asm volatile("" : "+v"(lo_));
#pragma unroll
            for (int r = 0; r < 16; ++r) { const int orow = crow(r, hi); const float rli = __builtin_amdgcn_rcpf(li_l[orow]);
#pragma unroll
                for (int d0 = 0; d0 < 4; ++d0) { const float v = o[d0][r] * rli; const float vn = __shfl_xor(v, 1);
                    if ((r32 & 1) == 0) *(unsigned*)(Ow + (lo_ + ((r & 3) + 8 * (r >> 2)) * DM + d0 * 32)) = cvt_pk_bf16(v, vn); } }
        }
    }
}

__device__ __forceinline__ void nsa_attn_phase(KP p, LAS unsigned char* lds) {
    const int tid = threadIdx.x, wid = __builtin_amdgcn_readfirstlane(tid >> 6);
    unsigned char* ws = p->ws;
    const bf16_t* Q = (const bf16_t*)(ws + WS_A); bf16_t* attn = (bf16_t*)(ws + WS_A) + (size_t)S_ * DM; __half* imp = (__half*)(ws + WS_A + 128 * MiB);
    float* partial = (float*)(ws + WS_PRE); const float* gates = (const float*)(ws + WS_GATE);
    const bf16_t* kv = (const bf16_t*)(ws + WS_KV); const bf16_t* kc = (const bf16_t*)(ws + WS_KC); const bf16_t* vc = (const bf16_t*)(ws + WS_VC);
    const bf16_t* vt = (const bf16_t*)(ws + WS_VT); const bf16_t* kfr = (const bf16_t*)(ws + WS_KF); const float* lutg = (const float*)(ws + WS_LUT);
    LAS float* lut = (LAS float*)(lds + L_LUT);
    LAS float* li_l = (LAS float*)(lds + L_WS) + wid * 64;
    const float NEG = -__builtin_inff();
    int g_loaded = -1;
    for (int it = blockIdx.x; it < 1024; it += gridDim.x) {
        const int g = it & 3, tile = 2 * (it >> 3) + ((it >> 2) & 1);
        if (g != g_loaded) {
            __syncthreads();
            for (int i = tid; i < 4 * 2048; i += 512) lut[i] = lutg[g * 4 * 2048 + i];
            __syncthreads();
            g_loaded = g;
        }
        {
            const int t0 = tile * 64;
            {
                const int r = wid & 3, th = wid >> 2, h = g * 4 + r;
                int tid_ = threadIdx.x; asm volatile("" : "+v"(tid_));
                const int lane = tid_ & 63, r32 = lane & 31, hi = lane >> 5;
                const int t_w0 = t0 + 32 * th, t_lane = t_w0 + r32;
                bf16x8 qr[8];
#pragma unroll
                for (int d0 = 0; d0 < 8; ++d0) qr[d0] = *(const bf16x8*)(Q + (size_t)t_lane * DM + h * 128 + d0 * 16 + hi * 8);
                const float g0 = gates[(size_t)t_lane * 48 + h * 3 + 0], g2 = gates[(size_t)t_lane * 48 + h * 3 + 2];
                FL a; a.K = kc + (size_t)g * 1024 * 128; a.V = vc + (size_t)g * 1024 * 128; a.kstride = 128; a.vstride = 128; a.j_lo = 0; a.j_hi = (t0 / 16 + 2) / 64 + 1;
                a.cum = nullptr; a.cq = 0.f; a.t_lane = t_lane; a.t_w0 = t_w0; a.lut = lut + r * 2048; a.imp = imp + ((size_t)h * S_ + t_lane) * 256;
                float m = -1e30f, l = 0.f; f32x16 o[4];
#pragma unroll
                for (int d_ = 0; d_ < 4; ++d_)
#pragma unroll
                    for (int rr = 0; rr < 16; ++rr) o[d_][rr] = 0.f;
                flash_loop<1>(lds, a, qr, m, l, o, 0.f);
                const float inv_l = l > 0.f ? 1.f / l : 0.f;
                flash_loop<2>(lds, a, qr, m, l, o, inv_l);
                float* Pw = partial + (size_t)t_w0 * DM + h * 128;
                int lo_ = 4 * hi * DM + r32; asm volatile("" : "+v"(lo_));
                if (hi == 0) li_l[r32] = g0; asm volatile("s_waitcnt lgkmcnt(0)" ::: "memory");
#pragma unroll
                for (int rr = 0; rr < 16; ++rr) { const int orow = crow(rr, hi); const float f = li_l[orow];
#pragma unroll
                    for (int d0 = 0; d0 < 4; ++d0) Pw[lo_ + ((rr & 3) + 8 * (rr >> 2)) * DM + d0 * 32] = o[d0][rr] * f; }
                a.K = kv + 4 * 512 + g * 128; a.V = kv + 5 * 512 + g * 128; a.kstride = NKV; a.vstride = NKV; a.j_lo = tile >= 8 ? tile - 8 : 0; a.j_hi = tile + 1;
                m = -1e30f; l = 0.f;
#pragma unroll
                for (int d_ = 0; d_ < 4; ++d_)
#pragma unroll
                    for (int rr = 0; rr < 16; ++rr) o[d_][rr] = 0.f;
                flash_loop<3>(lds, a, qr, m, l, o, 0.f);
                asm volatile("s_waitcnt lgkmcnt(0)" ::: "memory");
                int lo2_ = 4 * hi * DM + r32; asm volatile("" : "+v"(lo2_));
                if (hi == 0) li_l[r32] = g2 * (l > 0.f ? 1.f / l : 0.f); asm volatile("s_waitcnt lgkmcnt(0)" ::: "memory");
#pragma unroll
                for (int rr = 0; rr < 16; ++rr) { const int orow = crow(rr, hi); const float f = li_l[orow];
#pragma unroll
                    for (int d0 = 0; d0 < 4; ++d0) { float* pp = Pw + (lo2_ + ((rr & 3) + 8 * (rr >> 2)) * DM + d0 * 32); *pp = *pp + o[d0][rr] * f; } }
            }
            __syncthreads();
            {
#pragma nounroll
                for (int tt = 0; tt < 8; ++tt) {
                    int tid_ = threadIdx.x; asm volatile("" : "+v"(tid_));
                    const int lane = tid_ & 63;
                    const int n = lane & 15, kq = lane >> 4, hn = n & 3; const bool hv = n < 4;
                    const LAS float* lutn = lut + hn * 2048;
                    const int t = t0 + 8 * wid + tt; const int blk = tile;
                    float sc[4] = {0.f, 0.f, 0.f, 0.f};
#pragma unroll
                    for (int r = 0; r < 4; ++r) { const u32x2 raw = *(const u32x2*)(imp + ((size_t)(g * 4 + r) * S_ + t) * 256 + lane * 4);
                        sc[0] += __half2float(__ushort_as_half((unsigned short)(raw.x & 0xffffu))); sc[1] += __half2float(__ushort_as_half((unsigned short)(raw.x >> 16)));
                        sc[2] += __half2float(__ushort_as_half((unsigned short)(raw.y & 0xffffu))); sc[3] += __half2float(__ushort_as_half((unsigned short)(raw.y >> 16))); }
#pragma unroll
                    for (int e = 0; e < 4; ++e) { const int j = lane * 4 + e; const bool forced = (j == 0) | (j == blk) | (j == blk - 1);
                        sc[e] = forced ? 1e4f : (j <= blk ? sc[e] : -1.f); }
                    int mysel = -1;
#pragma nounroll
                    for (int k = 0; k < 16; ++k) {
                        float bv = sc[0]; int be = 0;
#pragma unroll
                        for (int e = 1; e < 4; ++e) if (sc[e] > bv) { bv = sc[e]; be = e; }
                        const float wmax = wave_max(bv);
                        if (wmax < 0.f) break;
                        const unsigned long long msk = __ballot(bv == wmax);
                        const int src = __ffsll((long long)msk) - 1;
                        const int jw = __shfl(lane * 4 + be, src);
                        if (lane == k) mysel = jw;
                        if (lane == src) {
#pragma unroll
                            for (int e = 0; e < 4; ++e) if (be == e) sc[e] = -2.f; }
                    }
                    bf16x8 qb[4];
#pragma unroll
                    for (int ks = 0; ks < 4; ++ks) { qb[ks] = *(const bf16x8*)(Q + (size_t)t * DM + (g * 4 + hn) * 128 + 32 * ks + kq * 8);
                        if (!hv) qb[ks] = (bf16x8){0, 0, 0, 0, 0, 0, 0, 0}; }
                    float m = -1e30f, l = 0.f; f32x4 o[8];
#pragma unroll
                    for (int d_ = 0; d_ < 8; ++d_) o[d_] = (f32x4){0.f, 0.f, 0.f, 0.f};
                    const int nsel = __builtin_popcountll(__ballot(mysel >= 0));
                    bf16x8 kf[16], vf[16];
                    const bf16_t* Kg = kfr + (size_t)g * 256 * 8192 + lane * 8;
                    const bf16_t* Vg = vt + (size_t)g * 256 * 8192 + lane * 8;
                    int sb = __builtin_amdgcn_readfirstlane(__shfl(mysel, 0));
                    { const bf16_t* Kp = Kg + (size_t)sb * 8192;
#pragma unroll
                      for (int f = 0; f < 16; ++f) kf[f] = *(const bf16x8*)(Kp + f * 512); }
#pragma nounroll
                    for (int b = 0; b < nsel; ++b) {
                        const int sbn = __builtin_amdgcn_readfirstlane(__shfl(mysel, b + 1 < nsel ? b + 1 : b));
                        { const bf16_t* Vp = Vg + (size_t)sb * 8192;
#pragma unroll
                          for (int f = 0; f < 16; ++f) vf[f] = *(const bf16x8*)(Vp + f * 512); }
                        SBAR();
                        f32x4 s[4];
#pragma unroll
                        for (int sub = 0; sub < 4; ++sub) { s[sub] = (f32x4){0.f, 0.f, 0.f, 0.f};
#pragma unroll
                            for (int ks = 0; ks < 4; ++ks) s[sub] = __builtin_amdgcn_mfma_f32_16x16x32_bf16(kf[sub * 4 + ks], qb[ks], s[sub], 0, 0, 0); }
                        SBAR();
                        { const bf16_t* Kp = Kg + (size_t)sbn * 8192;
#pragma unroll
                          for (int f = 0; f < 16; ++f) kf[f] = *(const bf16x8*)(Kp + f * 512); }
                        SBAR();
                        const int dq = t - sb * 64 - 4 * kq; float pmax = NEG;
#pragma unroll
                        for (int sub = 0; sub < 4; ++sub)
#pragma unroll
                            for (int i = 0; i < 4; ++i) { const int d = dq - 16 * sub - i; const unsigned idx = (unsigned)d < 2047u ? (unsigned)d : 2047u;
                                const float v = d >= 0 ? s[sub][i] + lutn[idx] : NEG; s[sub][i] = v; pmax = fmaxf(pmax, v); }
                        pmax = fmaxf(pmax, __shfl_xor(pmax, 16)); pmax = fmaxf(pmax, __shfl_xor(pmax, 32));
                        const float mn = fmaxf(m, pmax); const float alpha = __builtin_amdgcn_exp2f((m - mn) * L2E); m = mn;
                        const float mnL = -mn * L2E; float ps = 0.f;
#pragma unroll
                        for (int sub = 0; sub < 4; ++sub)
#pragma unroll
                            for (int i = 0; i < 4; ++i) { s[sub][i] = __builtin_amdgcn_exp2f(fmaf(s[sub][i], L2E, mnL)); ps += s[sub][i]; }
                        ps += __shfl_xor(ps, 16); ps += __shfl_xor(ps, 32);
                        l = l * alpha + ps;
#pragma unroll
                        for (int d_ = 0; d_ < 8; ++d_) o[d_] = o[d_] * alpha;
                        bf16x8 pb[2];
                        { const u32x4 w0 = pack8bf(s[0], s[1]), w1 = pack8bf(s[2], s[3]); pb[0] = *reinterpret_cast<const bf16x8*>(&w0); pb[1] = *reinterpret_cast<const bf16x8*>(&w1); }
                        SBAR();
#pragma unroll
                        for (int d_ = 0; d_ < 8; ++d_)
#pragma unroll
                            for (int s2 = 0; s2 < 2; ++s2) o[d_] = __builtin_amdgcn_mfma_f32_16x16x32_bf16(vf[d_ * 2 + s2], pb[s2], o[d_], 0, 0, 0);
                        sb = sbn;
                    }
                    const float g1 = gates[(size_t)t * 48 + (g * 4 + hn) * 3 + 1];
                    const float f = g1 * (l > 0.f ? 1.f / l : 0.f);
                    if (hv) {
#pragma unroll
                        for (int d_ = 0; d_ < 8; ++d_) { const size_t off = (size_t)t * DM + (g * 4 + n) * 128 + 16 * d_ + 4 * kq;
                            const f32x4 pp = *(const f32x4*)(partial + off); const f32x4 r4 = pp + o[d_] * f;
                            u32x2 w; w.x = cvt_pk_bf16(r4[0], r4[1]); w.y = cvt_pk_bf16(r4[2], r4[3]); *(u32x2*)(attn + off) = w; }
                    }
                }
            }
        }
    }
}

#define RUN_GEMM(EpiT, epi, Aptr, Btptr, Mv, Nv, Kv, ldav, cidx) do { const pg8::Gemm g_{(Aptr), (Btptr), (Mv), (Nv), (Kv), (ldav)}; pg8::StaticOrder so_; so_.init((Mv), (Nv), (int)gridDim.x, (cidx)); \
        pg8::gemm_phase<EpiT, pg8::StaticOrder, true, true>(lds, g_, so_, (epi)); } while (0)

__global__ void __launch_bounds__(512, 2) mega_fwd(Params p_unused) {
    extern __shared__ __attribute__((aligned(16))) unsigned char lds_raw[];
    LAS unsigned char* lds = (LAS unsigned char*)lds_raw;
    cg::grid_group grid = cg::this_grid();
    const size_t SD = (size_t)S_ * DM;
#define WSP(off) (KARGS()->ws + (off))
    prologue(KARGS(), lds);
    grid.sync();
#pragma nounroll
    for (int L = 0; L < 4; ++L) {
        const int bid = (int)blockIdx.x, G = (int)gridDim.x;
        if (L < 2) {
            { KP p = KARGS(); unsigned char* ws = p->ws; bf16_t* A0 = (bf16_t*)(ws + WS_A);
              EpiFoxQKV E{A0, (float*)(ws + WS_FLOG), p->in[I_FOXBF] + L * 16};
              RUN_GEMM(EpiFoxQKV, E, (const bf16_t*)(ws + WS_HBF), (const bf16_t*)(ws + WS_WFOXIN) + (size_t)L * NFOX * DM, S_, NFOX, DM, DM, bid); }
            grid.sync();
            scan_phase(KARGS(), lds, L == 0, L);
            grid.sync();
            fox_attn_phase(KARGS(), lds, L);
            grid.sync();
        } else {
            if (L == 2) {
                { KP p = KARGS(); unsigned char* ws = p->ws;
                  EpiKV E{(bf16_t*)(ws + WS_KV), (bf16_t*)(ws + WS_RAWK), (bf16_t*)(ws + WS_RAWV), (bf16_t*)(ws + WS_VT), (bf16_t*)(ws + WS_KF)};
                  RUN_GEMM(EpiKV, E, (const bf16_t*)(ws + WS_HBF), (const bf16_t*)(ws + WS_WKV), S_, NKV, DM, DM, bid); }
                grid.sync();
#pragma nounroll
                for (int mat = 0; mat < 2; ++mat) { KP p = KARGS(); unsigned char* ws = p->ws;
                    EpiCmp1 E{(bf16_t*)(ws + WS_CH) + (size_t)mat * 4096 * 256, (const float*)(ws + WS_CB) + mat * 256};
                    RUN_GEMM(EpiCmp1, E, (const bf16_t*)(ws + (mat ? WS_RAWV : WS_RAWK)), (const bf16_t*)(ws + WS_WC1) + (size_t)mat * 256 * 4096, 4096, 256, 4096, 2048, (bid + G - 16 * mat) % G);
                }
                grid.sync();
                cmp2_phase(KARGS());
                grid.sync();
            }
            { KP p = KARGS(); unsigned char* ws = p->ws;
              EpiNsaQ E{(bf16_t*)(ws + WS_A), (float*)(ws + WS_GATE)};
              RUN_GEMM(EpiNsaQ, E, (const bf16_t*)(ws + WS_HBF), (const bf16_t*)(ws + WS_WNSAIN) + (size_t)(L - 2) * NNSA * DM, S_, NNSA, DM, DM, bid); }
            grid.sync();
            nsa_attn_phase(KARGS(), lds);
            grid.sync();
        }
        { KP p = KARGS(); unsigned char* ws = p->ws; bf16_t* A0 = (bf16_t*)(ws + WS_A);
          const float* hres = L == 0 ? p->in[I_X] : p->out;
          const bf16_t* attn = L < 2 ? A0 + 3 * SD : A0 + SD;
          const bf16_t* wo = L < 2 ? (const bf16_t*)(ws + WS_WFOXO) + (size_t)L * DM * DM : (const bf16_t*)(ws + WS_WNSAO) + (size_t)(L - 2) * DM * DM;
          EpiRes E{hres, (float*)(ws + WS_PRE)}; RUN_GEMM(EpiRes, E, attn, wo, S_, DM, DM, DM, bid); }
        grid.sync();
        { KP p = KARGS(); ln_phase((const float*)(p->ws + WS_PRE), p->in[I_LN1G] + L * DM, p->in[I_LN1B] + L * DM, p->out, (bf16_t*)(p->ws + WS_HBF)); }
        grid.sync();
        { KP p = KARGS(); unsigned char* ws = p->ws;
          EpiRelu2 E{(bf16_t*)(ws + WS_A)}; RUN_GEMM(EpiRelu2, E, (const bf16_t*)(ws + WS_HBF), (const bf16_t*)(ws + WS_W1) + (size_t)L * FF * DM, S_, FF, DM, DM, bid); }
        grid.sync();
        { KP p = KARGS(); unsigned char* ws = p->ws;
          EpiRes E{p->out, (float*)(ws + WS_PRE)}; RUN_GEMM(EpiRes, E, (const bf16_t*)(ws + WS_A), (const bf16_t*)(ws + WS_W2) + (size_t)L * DM * FF, S_, DM, FF, FF, bid); }
        grid.sync();
        { KP p = KARGS(); ln_phase((const float*)(p->ws + WS_PRE), p->in[I_LN2G] + L * DM, p->in[I_LN2B] + L * DM, p->out, (bf16_t*)(p->ws + WS_HBF)); }
        grid.sync();
    }
}

extern "C" void kernel_launch(void* const* d_in, const int* in_sizes, int n_in, void* d_out, int out_size, void* d_ws, size_t ws_size, hipStream_t stream) {
    static int grid = 0;
    if (grid == 0) {
        if (n_in != 20 || out_size != S_ * DM || ws_size < WS_END) { fprintf(stderr, "kernel_launch: unexpected shapes (n_in %d out %d ws %zu)\n", n_in, out_size, ws_size); grid = -1; return; }
        int dev = 0, cus = 0, per_cu = 0;
        (void)hipGetDevice(&dev); (void)hipDeviceGetAttribute(&cus, hipDeviceAttributeMultiprocessorCount, dev);
        if (hipFuncSetAttribute((const void*)mega_fwd, hipFuncAttributeMaxDynamicSharedMemorySize, LDS_BYTES) != hipSuccess) fprintf(stderr, "kernel_launch: hipFuncSetAttribute failed\n");
        if (hipOccupancyMaxActiveBlocksPerMultiprocessor(&per_cu, (const void*)mega_fwd, 512, LDS_BYTES) != hipSuccess || per_cu < 1) per_cu = 1;
        (void)hipGetLastError();
        if (cus <= 0) cus = 256;
        grid = cus * per_cu;
    }
    if (grid < 0) return;
    Params p{};
    for (int i = 0; i < 20; ++i) p.in[i] = (const float*)d_in[i];
    p.out = (float*)d_out; p.ws = (unsigned char*)d_ws;
    void* args[] = {&p};
    hipError_t e = hipLaunchCooperativeKernel((const void*)mega_fwd, dim3(grid), dim3(512), args, LDS_BYTES, stream);
    if (e != hipSuccess) fprintf(stderr, "kernel_launch: cooperative launch failed: %s (grid %d)\n", hipGetErrorString(e), grid);
}
```

```cpp
#include <hip/hip_runtime.h>
#include <hip/hip_cooperative_groups.h>
#include <hip/hip_fp16.h>
#include <cstdio>
#include <cstdint>
namespace cg = cooperative_groups;
namespace pg8 {
#define PG8_LAS __attribute__((address_space(3)))
typedef unsigned short bf16_t;
typedef short bf16x8 __attribute__((ext_vector_type(8)));
typedef float f32x4 __attribute__((ext_vector_type(4)));
typedef unsigned u32x4 __attribute__((ext_vector_type(4)));
constexpr int BM = 256, BK = 64, HALF = 128, HTB = HALF * BK * 2  , STAGE_BYTES = 8 * HTB, NXCD = 8, WGM = 8;

__host__ __device__ __forceinline__ int lds_byte(int r, int c) { const int st = (r >> 4) * 2 + (c >> 5), rr = r & 15, cc = c & 31, ob = rr * 64 + cc * 2; return st * 1024 + (ob ^ (((ob >> 9) & 1) << 5)); }
__host__ __device__ __forceinline__ void stage_rc(int b, int& R, int& C) { const int st = b / 1024, sb = b % 1024, swz = sb ^ (((sb >> 9) & 1) << 5); R = (st >> 1) * 16 + swz / 64; C = (st & 1) * 32 + (swz % 64) / 2; }
__host__ __device__ __forceinline__ int perm32(int rho) { const int n = rho >> 4, i = rho & 15; return 8 * (i >> 2) + 4 * n + (i & 3); }

struct Unit { int pm, pn; };
struct Gemm { const bf16_t* A; const bf16_t* Bt; int M, N, K, lda; };

struct StaticOrder {
    int nM, nN, nwg, G, c;
    __host__ __device__ void init(int M, int N, int G_, int c_) { nM = M / BM; nN = N / BM; nwg = nM * nN; G = G_; c = c_; }
    __host__ __device__ bool next(int i, Unit& u) const {
        const long L = (long)i * G + c; if (L >= nwg) return false;
        int wgid = (int)L; { const int q = nwg / NXCD, r = nwg % NXCD, xcd = wgid % NXCD, off = wgid / NXCD; wgid = (xcd < r ? xcd * (q + 1) : r * (q + 1) + (xcd - r) * q) + off; }
        const int nig = WGM * nN, gid = wgid / nig, fm = gid * WGM, gsz = (nM - fm) < WGM ? (nM - fm) : WGM;
        u.pm = fm + ((wgid % nig) % gsz); u.pn = (wgid % nig) / gsz; return true;
    }
    __device__ __forceinline__ void a_ready(const Unit&) const {}
    __device__ __forceinline__ void done(const Unit&) const {}
};


__device__ __forceinline__ unsigned cvt_pk_bf16(float lo, float hi) { unsigned r; asm volatile("v_cvt_pk_bf16_f32 %0, %1, %2" : "=v"(r) : "v"(lo), "v"(hi)); return r; }
typedef float f32x2 __attribute__((ext_vector_type(2)));
template <class Epi, class Sched, bool ALIGN_EPI = false, bool SP2 = false>
__device__ __forceinline__ void gemm_phase(PG8_LAS unsigned char* lds, const Gemm g, const Sched& S, const Epi& E) {
    int tid_ = threadIdx.x; asm volatile("" : "+v"(tid_));
    const int tid = tid_, wid = __builtin_amdgcn_readfirstlane(tid >> 6), lane = tid & 63, wr = wid >> 2, wc = wid & 3, fr = lane & 15, fq = lane >> 4;
    const int K = g.K, nt = K / BK;
    unsigned voffA[2], voffB[2];
#pragma unroll
    for (int i = 0; i < 2; ++i) { int R, C; stage_rc(tid * 16 + i * 8192, R, C); const int Rb = Epi::PERM ? ((R & ~31) + perm32(R & 31)) : R;
        voffA[i] = (unsigned)(R * g.lda + C) * 2u; voffB[i] = (unsigned)(Rb * K + C) * 2u; }
    const size_t kstep = (size_t)(BK * 2);
    const size_t hstepB = (size_t)HALF * K * 2, hstepA = (size_t)HALF * g.lda * 2;
    const size_t tstepB = 2 * hstepB, tstepA = 2 * hstepA;
    const unsigned ldsw = (unsigned)wid * 1024u;
    const int aoff = lds_byte(wr * 64 + fr, fq * 8), boff = lds_byte(wc * 32 + fr, fq * 8);
#define PG8_SA(b, h) (((b) * 2 + (h)) * HTB)
#define PG8_SB(b, h) ((4 + (b) * 2 + (h)) * HTB)
#define PG8_STAGE(bufoff, gbase, voff) do { _Pragma("unroll") for (int _i = 0; _i < 2; ++_i) \
        __builtin_amdgcn_global_load_lds((const unsigned*)((const char*)(gbase) + (voff)[_i]), (PG8_LAS unsigned*)(lds + (bufoff) + ldsw + _i * 8192), 16, 0, 0); } while (0)
#define PG8_LDA(dst, b, h) do { _Pragma("unroll") for (int m = 0; m < 4; ++m) _Pragma("unroll") for (int k = 0; k < 2; ++k) dst[m][k] = *(const PG8_LAS bf16x8*)(lds + PG8_SA(b, h) + aoff + m * 2048 + k * 1024); } while (0)
#define PG8_LDB(dst, b, h) do { _Pragma("unroll") for (int n = 0; n < 2; ++n) _Pragma("unroll") for (int k = 0; k < 2; ++k) dst[n][k] = *(const PG8_LAS bf16x8*)(lds + PG8_SB(b, h) + boff + n * 2048 + k * 1024); } while (0)
#define PG8_MMA(ai, bj, At, Bt) do { __builtin_amdgcn_s_setprio(1); _Pragma("unroll") for (int m = 0; m < 4; ++m) _Pragma("unroll") for (int n = 0; n < 2; ++n) _Pragma("unroll") for (int k = 0; k < 2; ++k) \
        acc[ai][bj][m][n] = __builtin_amdgcn_mfma_f32_16x16x32_bf16(Bt[n][k], At[m][k], acc[ai][bj][m][n], 0, 0, 0); __builtin_amdgcn_s_setprio(0); } while (0)
#define PG8_WAIT_V(n) asm volatile("s_waitcnt vmcnt(" #n ")" ::: "memory")
#define PG8_WAIT_L(n) asm volatile("s_waitcnt lgkmcnt(" #n ")" ::: "memory")
#define PG8_BAR __builtin_amdgcn_s_barrier()
#define PG8_SCHED __builtin_amdgcn_sched_barrier(0)
    Unit cur, nxt; int ui = 0;
    if (!S.next(0, cur)) return;
    f32x4 acc[2][2][4][2];
#pragma unroll
    for (int a = 0; a < 2; ++a)
#pragma unroll
        for (int b = 0; b < 2; ++b)
#pragma unroll
            for (int m = 0; m < 4; ++m)
#pragma unroll
                for (int n = 0; n < 2; ++n) acc[a][b][m][n] = (f32x4){0.f, 0.f, 0.f, 0.f};
    bf16x8 At[4][2], B0[2][2], B1[2][2];
    const char* cA = (const char*)g.A + (size_t)cur.pm * tstepA; const char* cB = (const char*)g.Bt + (size_t)cur.pn * tstepB;
    S.a_ready(cur);
    if constexpr (SP2) {
        PG8_STAGE(PG8_SB(0, 0), cB, voffB); PG8_STAGE(PG8_SB(0, 1), cB + hstepB, voffB); PG8_STAGE(PG8_SA(0, 0), cA, voffA); PG8_STAGE(PG8_SA(0, 1), cA + hstepA, voffA);
        if (wr == 1) PG8_BAR;
        PG8_WAIT_V(2); PG8_BAR;
        PG8_STAGE(PG8_SB(1, 0), cB + kstep, voffB); PG8_STAGE(PG8_SA(1, 0), cA + kstep, voffA); PG8_STAGE(PG8_SB(1, 1), cB + hstepB + kstep, voffB);
        PG8_WAIT_V(6); PG8_BAR;
    } else {
        PG8_STAGE(PG8_SB(0, 0), cB, voffB); PG8_STAGE(PG8_SA(0, 0), cA, voffA); PG8_STAGE(PG8_SB(0, 1), cB + hstepB, voffB); PG8_STAGE(PG8_SA(0, 1), cA + hstepA, voffA);
        if (wr == 1) PG8_BAR;
        PG8_WAIT_V(4); PG8_BAR;
        PG8_STAGE(PG8_SB(1, 0), cB + kstep, voffB); PG8_STAGE(PG8_SA(1, 0), cA + kstep, voffA); PG8_STAGE(PG8_SB(1, 1), cB + hstepB + kstep, voffB);
        PG8_WAIT_V(6); PG8_BAR;
    }
    for (;;) {
        const bool has_next = S.next(ui + 1, nxt);
        const char* nA = has_next ? (const char*)g.A + (size_t)nxt.pm * tstepA : cA; const char* nB = has_next ? (const char*)g.Bt + (size_t)nxt.pn * tstepB : cB;
        for (int t = 0; t < nt; t += 2) {
            const bool last = (t == nt - 2);
            const char* a1 = cA + (size_t)(t + 1) * kstep;
            const char* a2 = last ? nA : cA + (size_t)(t + 2) * kstep; const char* b2 = last ? nB : cB + (size_t)(t + 2) * kstep;
            const char* a3 = a2 + kstep; const char* b3 = b2 + kstep;
            if (last && has_next) S.a_ready(nxt);
            if constexpr (SP2) {
            PG8_LDB(B0, 0, 0); PG8_LDB(B1, 0, 1); PG8_SCHED; PG8_LDA(At, 0, 0); PG8_STAGE(PG8_SA(1, 1), a1 + hstepA, voffA);
            PG8_WAIT_V(8); PG8_WAIT_L(0); PG8_BAR; PG8_MMA(0, 0, At, B0); PG8_MMA(0, 1, At, B1); PG8_BAR; PG8_SCHED;
            PG8_LDA(At, 0, 1); PG8_STAGE(PG8_SB(0, 0), b2, voffB); PG8_STAGE(PG8_SB(0, 1), b2 + hstepB, voffB); PG8_STAGE(PG8_SA(0, 0), a2, voffA);
            PG8_WAIT_V(8); PG8_WAIT_L(0); PG8_BAR; PG8_MMA(1, 0, At, B0); PG8_MMA(1, 1, At, B1); PG8_BAR; PG8_SCHED;
            PG8_LDB(B0, 1, 0); PG8_LDB(B1, 1, 1); PG8_SCHED; PG8_LDA(At, 1, 0); PG8_STAGE(PG8_SA(0, 1), a2 + hstepA, voffA);
            PG8_WAIT_V(8); PG8_WAIT_L(0); PG8_BAR; PG8_MMA(0, 0, At, B0); PG8_MMA(0, 1, At, B1); PG8_BAR; PG8_SCHED;
            PG8_LDA(At, 1, 1); PG8_STAGE(PG8_SB(1, 0), b3, voffB); PG8_STAGE(PG8_SB(1, 1), b3 + hstepB, voffB); PG8_STAGE(PG8_SA(1, 0), a3, voffA);
            PG8_WAIT_V(8); PG8_WAIT_L(0); PG8_BAR; PG8_MMA(1, 0, At, B0); PG8_MMA(1, 1, At, B1); PG8_BAR; PG8_SCHED;
            }
        }
        if constexpr (ALIGN_EPI) { if (wr == 0) PG8_BAR; }
        if constexpr (!Epi::AFTER_DRAIN) { E(acc, cur, wr, wc, fr, fq); S.done(cur); }
        if (!has_next) break;
#pragma unroll
        for (int a = 0; a < 2; ++a)
#pragma unroll
            for (int b = 0; b < 2; ++b)
#pragma unroll
                for (int m = 0; m < 4; ++m)
#pragma unroll
                    for (int n = 0; n < 2; ++n) acc[a][b][m][n] = (f32x4){0.f, 0.f, 0.f, 0.f};
        cur = nxt; cA = nA; cB = nB; ++ui;
        if constexpr (ALIGN_EPI) { if (wr == 1) PG8_BAR; }
    }
    PG8_WAIT_V(0);
    if constexpr (!ALIGN_EPI) { if (wr == 0) PG8_BAR; }
    PG8_BAR;
    if constexpr (Epi::AFTER_DRAIN) { E.fused(acc, cur, wr, wc, fr, fq, lds, wid, lane); S.done(cur); }
#undef PG8_SA
#undef PG8_SB
#undef PG8_STAGE
#undef PG8_LDA
#undef PG8_LDB
#undef PG8_MMA
#undef PG8_WAIT_V
#undef PG8_WAIT_L
#undef PG8_BAR
#undef PG8_SCHED
}
}

#define LAS __attribute__((address_space(3)))
using pg8::bf16_t; using pg8::bf16x8; using pg8::f32x4; using pg8::u32x4; using pg8::Unit; using pg8::cvt_pk_bf16;
typedef short s16x4 __attribute__((ext_vector_type(4)));
typedef float f32x16 __attribute__((ext_vector_type(16)));
typedef unsigned u32x2 __attribute__((ext_vector_type(2)));

constexpr int S_ = 16384, DM = 2048, FF = 8192, NH = 16, DH = 128, NG = 4;
constexpr int NFOX = 6400, NNSA = 2304, NKV = 3072;
constexpr float ALPHA_ = 1.6817928305074292f;
constexpr float QSCALE = 0.08838834764831845f;
constexpr float L2E = 1.4426950408889634f;
constexpr float LN_EPS_ = 1e-5f;

constexpr size_t MiB = 1u << 20;
constexpr size_t WS_WFOXIN = 0;
constexpr size_t WS_WFOXO  = 50 * MiB;
constexpr size_t WS_WNSAIN = 66 * MiB;
constexpr size_t WS_WNSAO  = 84 * MiB;
constexpr size_t WS_WKV    = 100 * MiB;
constexpr size_t WS_W1     = 112 * MiB;
constexpr size_t WS_W2     = 240 * MiB;
constexpr size_t WS_WC1    = 368 * MiB;
constexpr size_t WS_HBF    = 372 * MiB;
constexpr size_t WS_PRE    = 436 * MiB;
constexpr size_t WS_A      = 564 * MiB;
constexpr size_t WS_KV     = 820 * MiB;
constexpr size_t WS_RAWK   = 916 * MiB;
constexpr size_t WS_RAWV   = 933 * MiB;
constexpr size_t WS_VT     = 950 * MiB;
constexpr size_t WS_CH     = 966 * MiB;
constexpr size_t WS_KC     = 970 * MiB;
constexpr size_t WS_VC     = 971 * MiB;
constexpr size_t WS_CUM    = 972 * MiB;
constexpr size_t WS_FLOG   = 973 * MiB;
constexpr size_t WS_GATE   = 974 * MiB;
constexpr size_t WS_LUT    = 977 * MiB;
constexpr size_t WS_CBP    = 977 * MiB + 256 * 1024;
constexpr size_t WS_CB     = 977 * MiB + 512 * 1024;
constexpr size_t WS_NRM    = 977 * MiB + 768 * 1024;
constexpr size_t WS_KF     = 978 * MiB;
constexpr size_t WS_BAR    = 994 * MiB;
constexpr size_t WS_END    = 995 * MiB;

constexpr int SHM_K = 16384, SHM_V = 16384;
constexpr int L_V = 0, L_K = 32768, L_WS = 65536, L_CK = 65536 + 2048, L_LUT = 69632, L_END = 69632 + 32768;
constexpr int LDS_BYTES = 147456;

__device__ __forceinline__ u32x4 pack8bf(f32x4 a, f32x4 b) { u32x4 w; w.x = cvt_pk_bf16(a[0], a[1]); w.y = cvt_pk_bf16(a[2], a[3]); w.z = cvt_pk_bf16(b[0], b[1]); w.w = cvt_pk_bf16(b[2], b[3]); return w; }
__device__ __forceinline__ float log_sigmoid_f(float x) { return fminf(x, 0.f) - log1pf(__expf(-fabsf(x))); }
__device__ __forceinline__ float sigmoid_f(float x) { return 1.f / (1.f + __expf(-x)); }
__device__ __forceinline__ float gelu_tanh_f(float x) { const float u = 0.7978845608028654f * (x + 0.044715f * x * x * x); const float t = 1.f - 2.f / (__expf(2.f * u) + 1.f); return 0.5f * x * (1.f + t); }

struct EpiFoxQKV {
    static constexpr bool PERM = true, AFTER_DRAIN = false;
    bf16_t* q; float* flog; const float* bfg;
    __device__ __forceinline__ void operator()(const f32x4 (&acc)[2][2][4][2], const Unit& u, int wr, int wc, int fr, int fq) const {
        const int row0 = u.pm * 256 + wr * 64 + fr; const int colt = u.pn * 256;
        if (colt < 6144) {
            const int t = colt >> 11; bf16_t* base = q + (size_t)t * ((size_t)S_ * DM); const float sc = t == 0 ? QSCALE : 1.f;
            const int c0 = colt - t * 2048 + wc * 32 + 8 * fq;
#pragma unroll
            for (int ai = 0; ai < 2; ++ai)
#pragma unroll
                for (int m = 0; m < 4; ++m) { bf16_t* rowp = base + (size_t)(row0 + ai * 128 + m * 16) * DM + c0;
#pragma unroll
                    for (int bj = 0; bj < 2; ++bj) *(u32x4*)(rowp + bj * 128) = pack8bf(acc[ai][bj][m][0] * sc, acc[ai][bj][m][1] * sc); }
        } else if (wc == 0 && fq < 2) {
            float bb[8];
#pragma unroll
            for (int e = 0; e < 8; ++e) bb[e] = bfg[8 * fq + e];
#pragma unroll
            for (int ai = 0; ai < 2; ++ai)
#pragma unroll
                for (int m = 0; m < 4; ++m) { float* rowp = flog + (size_t)(row0 + ai * 128 + m * 16) * 16 + 8 * fq;
                    f32x4 a = acc[ai][0][m][0], b = acc[ai][0][m][1], oa, ob;
#pragma unroll
                    for (int e = 0; e < 4; ++e) { oa[e] = log_sigmoid_f(a[e] + bb[e]); ob[e] = log_sigmoid_f(b[e] + bb[4 + e]); }
                    *(f32x4*)rowp = oa; *(f32x4*)(rowp + 4) = ob; }
        }
    }
};
struct EpiNsaQ {
    static constexpr bool PERM = true, AFTER_DRAIN = false;
    bf16_t* q; float* gates;
    __device__ __forceinline__ void operator()(const f32x4 (&acc)[2][2][4][2], const Unit& u, int wr, int wc, int fr, int fq) const {
        const int row0 = u.pm * 256 + wr * 64 + fr; const int colt = u.pn * 256;
        if (colt < 2048) {
            const int c0 = colt + wc * 32 + 8 * fq;
#pragma unroll
            for (int ai = 0; ai < 2; ++ai)
#pragma unroll
                for (int m = 0; m < 4; ++m) { bf16_t* rowp = q + (size_t)(row0 + ai * 128 + m * 16) * DM + c0;
#pragma unroll
                    for (int bj = 0; bj < 2; ++bj) *(u32x4*)(rowp + bj * 128) = pack8bf(acc[ai][bj][m][0] * QSCALE, acc[ai][bj][m][1] * QSCALE); }
        } else { const int c0 = wc * 32 + 8 * fq;
            if (c0 < 48) {
#pragma unroll
            for (int ai = 0; ai < 2; ++ai)
#pragma unroll
                for (int m = 0; m < 4; ++m) { float* rowp = gates + (size_t)(row0 + ai * 128 + m * 16) * 48 + c0;
                    f32x4 a = acc[ai][0][m][0], b = acc[ai][0][m][1], oa, ob;
#pragma unroll
                    for (int e = 0; e < 4; ++e) { oa[e] = sigmoid_f(a[e]); ob[e] = sigmoid_f(b[e]); }
                    *(f32x4*)rowp = oa; *(f32x4*)(rowp + 4) = ob; } }
        }
    }
};
struct EpiRes {
    static constexpr bool PERM = true, AFTER_DRAIN = false;
    const float* res; float* out;
    __device__ __forceinline__ void operator()(const f32x4 (&acc)[2][2][4][2], const Unit& u, int wr, int wc, int fr, int fq) const {
        const int row0 = u.pm * 256 + wr * 64 + fr; const int c0 = u.pn * 256 + wc * 32 + 8 * fq;
#pragma unroll
        for (int ai = 0; ai < 2; ++ai)
#pragma unroll
            for (int m = 0; m < 4; ++m) { const size_t off = (size_t)(row0 + ai * 128 + m * 16) * DM + c0;
#pragma unroll
                for (int bj = 0; bj < 2; ++bj) { const f32x4 r0 = *(const f32x4*)(res + off + bj * 128), r1 = *(const f32x4*)(res + off + bj * 128 + 4);
                    *(f32x4*)(out + off + bj * 128) = r0 * ALPHA_ + acc[ai][bj][m][0]; *(f32x4*)(out + off + bj * 128 + 4) = r1 * ALPHA_ + acc[ai][bj][m][1]; } }
    }
};
struct EpiRelu2 {
    static constexpr bool PERM = true, AFTER_DRAIN = false;
    bf16_t* O;
    __device__ __forceinline__ void operator()(const f32x4 (&acc)[2][2][4][2], const Unit& u, int wr, int wc, int fr, int fq) const {
        const int row0 = u.pm * 256 + wr * 64 + fr; const int c0 = u.pn * 256 + wc * 32 + 8 * fq;
#pragma unroll
        for (int ai = 0; ai < 2; ++ai)
#pragma unroll
            for (int m = 0; m < 4; ++m) { bf16_t* rowp = O + (size_t)(row0 + ai * 128 + m * 16) * FF + c0;
#pragma unroll
                for (int bj = 0; bj < 2; ++bj) { f32x4 a = acc[ai][bj][m][0], b = acc[ai][bj][m][1];
#pragma unroll
                    for (int e = 0; e < 4; ++e) { a[e] = fmaxf(a[e], 0.f); a[e] *= a[e]; b[e] = fmaxf(b[e], 0.f); b[e] *= b[e]; }
                    *(u32x4*)(rowp + bj * 128) = pack8bf(a, b); } }
    }
};
__device__ __forceinline__ int vt_pos(int ko) { return ((ko & 15) >> 2) * 8 + ((ko >> 4) << 2) + (ko & 3); }
struct EpiKV {
    static constexpr bool PERM = true, AFTER_DRAIN = false;
    bf16_t* kv; bf16_t* rawk; bf16_t* rawv; bf16_t* vt; bf16_t* kf;
    __device__ __forceinline__ void operator()(const f32x4 (&acc)[2][2][4][2], const Unit& u, int wr, int wc, int fr, int fq) const {
        const int row0 = u.pm * 256 + wr * 64 + fr;
#pragma unroll
        for (int bj = 0; bj < 2; ++bj) {
            const int cg_ = u.pn * 256 + bj * 128; const int slot = cg_ >> 9, g = (cg_ & 511) >> 7; const int d0 = wc * 32 + 8 * fq;
#pragma unroll
            for (int ai = 0; ai < 2; ++ai)
#pragma unroll
                for (int m = 0; m < 4; ++m) { const int row = row0 + ai * 128 + m * 16; const f32x4 a = acc[ai][bj][m][0], b = acc[ai][bj][m][1];
                    if (slot < 2) { bf16_t* dst = (slot == 0 ? rawk : rawv) + ((size_t)g * S_ + row) * 128 + d0; *(u32x4*)dst = pack8bf(a, b); }
                    else if (slot == 2) { const int blk = row >> 6, kin = row & 63;
                        *(u32x4*)(kf + ((size_t)((g * 256 + blk) * 16 + (kin >> 4) * 4 + wc)) * 512 + (fq * 16 + (kin & 15)) * 8) = pack8bf(a, b); }
                    else if (slot == 3) { const u32x4 w = pack8bf(a, b); const int blk = row >> 6, kin = row & 63, pos = vt_pos(kin & 31);
                        bf16_t* dst = vt + ((size_t)((g * 256 + blk) * 16 + (wc * 2 + (fq >> 1)) * 2 + (kin >> 5))) * 512 + ((pos >> 3) * 16 + (fq & 1) * 8) * 8 + (pos & 7);
                        dst[0] = (bf16_t)(w.x & 0xffffu); dst[8] = (bf16_t)(w.x >> 16); dst[16] = (bf16_t)(w.y & 0xffffu); dst[24] = (bf16_t)(w.y >> 16);
                        dst[32] = (bf16_t)(w.z & 0xffffu); dst[40] = (bf16_t)(w.z >> 16); dst[48] = (bf16_t)(w.w & 0xffffu); dst[56] = (bf16_t)(w.w >> 16); }
                    else { *(u32x4*)(kv + (size_t)row * NKV + cg_ + d0) = pack8bf(a, b); } }
        }
    }
};
struct EpiCmp1 {
    static constexpr bool PERM = true, AFTER_DRAIN = false;
    bf16_t* O; const float* bias;
    __device__ __forceinline__ void operator()(const f32x4 (&acc)[2][2][4][2], const Unit& u, int wr, int wc, int fr, int fq) const {
        const int row0 = u.pm * 256 + wr * 64 + fr; const int c0 = wc * 32 + 8 * fq;
#pragma unroll
        for (int bj = 0; bj < 2; ++bj) { const f32x4 b0 = *(const f32x4*)(bias + c0 + bj * 128), b1 = *(const f32x4*)(bias + c0 + bj * 128 + 4);
#pragma unroll
            for (int ai = 0; ai < 2; ++ai)
#pragma unroll
                for (int m = 0; m < 4; ++m) { f32x4 a = acc[ai][bj][m][0] + b0, b = acc[ai][bj][m][1] + b1;
#pragma unroll
                    for (int e = 0; e < 4; ++e) { a[e] = gelu_tanh_f(a[e]); b[e] = gelu_tanh_f(b[e]); }
                    *(u32x4*)(O + (size_t)(row0 + ai * 128 + m * 16) * 256 + c0 + bj * 128) = pack8bf(a, b); } }
    }
};

__device__ __forceinline__ unsigned f2bf(float f) { unsigned u = __builtin_bit_cast(unsigned, f); return (u + 0x7fffu + ((u >> 16) & 1u)) >> 16; }
__device__ __forceinline__ unsigned pk2(float lo, float hi) { return f2bf(lo) | (f2bf(hi) << 16); }
__device__ __forceinline__ float wave_sum(float v) {
#pragma unroll
    for (int o = 1; o < 64; o <<= 1) v += __shfl_xor(v, o);
    return v;
}
template <int CTRL> __device__ __forceinline__ float dppf(float v) { return __uint_as_float((unsigned)__builtin_amdgcn_update_dpp(0, (int)__float_as_uint(v), CTRL, 0xF, 0xF, true)); }
__device__ __forceinline__ float wave_max_fast(float v) {
    v = fmaxf(v, dppf<0xB1>(v)); v = fmaxf(v, dppf<0x4E>(v)); v = fmaxf(v, dppf<0x141>(v)); v = fmaxf(v, dppf<0x140>(v));
    const float a = __uint_as_float((unsigned)__builtin_amdgcn_readlane((int)__float_as_uint(v), 0)), b = __uint_as_float((unsigned)__builtin_amdgcn_readlane((int)__float_as_uint(v), 16));
    const float c = __uint_as_float((unsigned)__builtin_amdgcn_readlane((int)__float_as_uint(v), 32)), d = __uint_as_float((unsigned)__builtin_amdgcn_readlane((int)__float_as_uint(v), 48));
    return fmaxf(fmaxf(a, b), fmaxf(c, d));
}
__device__ __forceinline__ float wave_max(float v) {
#pragma unroll
    for (int o = 1; o < 64; o <<= 1) v = fmaxf(v, __shfl_xor(v, o));
    return v;
}
__device__ __forceinline__ void transpose_item(const float* W, int K, int ld, int ncols, bf16_t* WT, LAS float* scr, int item, int lane) {
    const int nblk = ncols / 32, kb = item / nblk, nb = item % nblk, k0 = 64 * kb, n0 = 32 * nb;
#pragma unroll 8
    for (int i = 0; i < 32; ++i) { const int kk = 2 * i + (lane >> 5); scr[kk * 33 + (lane & 31)] = W[(size_t)(k0 + kk) * ld + n0 + (lane & 31)]; }
    asm volatile("s_waitcnt lgkmcnt(0)" ::: "memory");
    const int c = lane & 7;
#pragma unroll
    for (int j = 0; j < 4; ++j) { const int n = (lane >> 3) + 8 * j; const LAS float* s = scr + (8 * c) * 33 + n;
        u32x4 o; o.x = pk2(s[0 * 33], s[1 * 33]); o.y = pk2(s[2 * 33], s[3 * 33]); o.z = pk2(s[4 * 33], s[5 * 33]); o.w = pk2(s[6 * 33], s[7 * 33]);
        *(u32x4*)(WT + (size_t)(n0 + n) * K + k0 + 8 * c) = o; }
    asm volatile("s_waitcnt lgkmcnt(0)" ::: "memory");
}
__device__ __forceinline__ int rel_bucket_dev(int n) {
    if (n < 16) return n;
    int lg = 16 + (int)(__logf((float)n / 16.0f) / 4.852030263919617f * 16.0f);
    return lg > 31 ? 31 : lg;
}

struct Params { const float* in[20]; float* out; unsigned char* ws; };
typedef const Params __attribute__((address_space(4)))* KP;
#define KARGS() ({ KP q_ = (KP)__builtin_amdgcn_kernarg_segment_ptr(); asm volatile("" : "+s"(q_)); q_; })
enum { I_X = 0, I_FOXWIN, I_FOXBF, I_FOXWO, I_NSAWIN, I_NSAWO, I_KVW, I_POSK, I_POSV, I_CK1, I_CK2, I_CV1, I_CV2, I_RELB, I_W1, I_W2, I_LN1G, I_LN1B, I_LN2G, I_LN2B };

__device__ __forceinline__ void prologue(KP p, LAS unsigned char* lds) {
    int tid_ = threadIdx.x; asm volatile("" : "+v"(tid_));
    const int tid = tid_, lane = tid & 63, wave = tid >> 6;
    const int gw = blockIdx.x * 8 + wave, NGW = gridDim.x * 8;
    LAS float* scr = (LAS float*)(lds + wave * 16384);
    unsigned char* ws = p->ws;
    long base = 0;
#define TR(src, K, ld, ncols, dst) do { const long n_ = (long)((K) / 64) * ((ncols) / 32); \
        for (long it = gw; it < n_; it += NGW) transpose_item((src), (K), (ld), (ncols), (dst), scr, (int)it, lane); } while (0)
    for (int L = 0; L < 2; ++L) {
        TR(p->in[I_FOXWIN] + (size_t)L * DM * 6160, DM, 6160, 6144, (bf16_t*)(ws + WS_WFOXIN) + (size_t)L * NFOX * DM);
        TR(p->in[I_FOXWO] + (size_t)L * DM * DM, DM, DM, DM, (bf16_t*)(ws + WS_WFOXO) + (size_t)L * DM * DM);
        TR(p->in[I_NSAWIN] + (size_t)L * DM * 2096, DM, 2096, 2048, (bf16_t*)(ws + WS_WNSAIN) + (size_t)L * NNSA * DM);
        TR(p->in[I_NSAWO] + (size_t)L * DM * DM, DM, DM, DM, (bf16_t*)(ws + WS_WNSAO) + (size_t)L * DM * DM);
    }
    TR(p->in[I_KVW], DM, NKV, NKV, (bf16_t*)(ws + WS_WKV));
    for (int L = 0; L < 4; ++L) {
        TR(p->in[I_W1] + (size_t)L * DM * FF, DM, FF, FF, (bf16_t*)(ws + WS_W1) + (size_t)L * FF * DM);
        TR(p->in[I_W2] + (size_t)L * FF * DM, FF, DM, DM, (bf16_t*)(ws + WS_W2) + (size_t)L * DM * FF);
    }
    TR(p->in[I_CK1], 4096, 256, 256, (bf16_t*)(ws + WS_WC1));
    TR(p->in[I_CV1], 4096, 256, 256, (bf16_t*)(ws + WS_WC1) + (size_t)256 * 4096);
#undef TR
    (void)base;
    const int gt = blockIdx.x * 512 + tid, NGT = gridDim.x * 512;
    for (int i = gt; i < 2 * 256 * DM; i += NGT) { const int L = i / (256 * DM), r = (i / DM) % 256, k = i % DM;
        const float v = r < 16 ? p->in[I_FOXWIN][(size_t)L * DM * 6160 + (size_t)k * 6160 + 6144 + r] : 0.f;
        ((bf16_t*)(ws + WS_WFOXIN))[(size_t)L * NFOX * DM + (size_t)(6144 + r) * DM + k] = (bf16_t)f2bf(v); }
    for (int i = gt; i < 2 * 256 * DM; i += NGT) { const int L = i / (256 * DM), r = (i / DM) % 256, k = i % DM;
        const float v = r < 48 ? p->in[I_NSAWIN][(size_t)L * DM * 2096 + (size_t)k * 2096 + 2048 + r] : 0.f;
        ((bf16_t*)(ws + WS_WNSAIN))[(size_t)L * NNSA * DM + (size_t)(2048 + r) * DM + k] = (bf16_t)f2bf(v); }
    { const f32x4* x4 = (const f32x4*)p->in[I_X]; u32x2* o = (u32x2*)(ws + WS_HBF);
      for (int i = gt; i < S_ * DM / 4; i += NGT) { const f32x4 v = x4[i]; u32x2 w; w.x = pk2(v[0], v[1]); w.y = pk2(v[2], v[3]); o[i] = w; } }
    { float* lut = (float*)(ws + WS_LUT);
      for (int i = gt; i < 16 * 2048; i += NGT) { const int h = i >> 11, d = i & 2047; lut[i] = p->in[I_RELB][rel_bucket_dev(d) * 16 + h]; } }
    { float* part = (float*)(ws + WS_CBP);
      for (int i = gt; i < 2 * 64 * 256; i += NGT) { const int mat = i / (64 * 256), ch = (i / 256) % 64, c = i % 256;
          const float* pos = p->in[mat ? I_POSV : I_POSK]; const float* w1 = p->in[mat ? I_CV1 : I_CK1]; float s = 0.f;
          for (int j = ch * 64; j < ch * 64 + 64; ++j) s += pos[j] * w1[(size_t)j * 256 + c];
          part[i] = s; } }
    if (gt < 64) ((unsigned*)(ws + WS_NRM))[gt] = 0u;
    { bf16_t* rk = (bf16_t*)(ws + WS_RAWK) + (size_t)4 * S_ * 128; bf16_t* rv = (bf16_t*)(ws + WS_RAWV) + (size_t)4 * S_ * 128;
      for (int i = gt; i < 32 * 128; i += NGT) { rk[i] = 0; rv[i] = 0; } }
}

__device__ __forceinline__ void ln_phase(const float* pre, const float* gam, const float* bet, float* h32, bf16_t* hbf) {
    int tid_ = threadIdx.x; asm volatile("" : "+v"(tid_));
    const int tid = tid_, lane = tid & 63, wave = tid >> 6;
    const int gw = blockIdx.x * 8 + wave, NGW = gridDim.x * 8;
    for (int row = gw; row < S_; row += NGW) {
        const f32x4* xr = (const f32x4*)(pre + (size_t)row * DM) + lane;
        f32x4 v[8]; float s = 0.f;
#pragma unroll
        for (int j = 0; j < 8; ++j) { v[j] = xr[64 * j]; s += (v[j][0] + v[j][1]) + (v[j][2] + v[j][3]); }
        const float mean = wave_sum(s) * (1.f / DM); float s2 = 0.f;
#pragma unroll
        for (int j = 0; j < 8; ++j) { v[j] = v[j] - mean; s2 += (v[j][0] * v[j][0] + v[j][1] * v[j][1]) + (v[j][2] * v[j][2] + v[j][3] * v[j][3]); }
        const float rstd = 1.f / sqrtf(wave_sum(s2) * (1.f / DM) + LN_EPS_);
        f32x4* o4 = (f32x4*)(h32 + (size_t)row * DM) + lane; u32x2* o2 = (u32x2*)(hbf + (size_t)row * DM) + lane;
#pragma unroll
        for (int j = 0; j < 8; ++j) { const f32x4 g4 = ((const f32x4*)gam)[lane + 64 * j], b4 = ((const f32x4*)bet)[lane + 64 * j];
            const f32x4 y = v[j] * rstd * g4 + b4; o4[64 * j] = y; u32x2 w; w.x = pk2(y[0], y[1]); w.y = pk2(y[2], y[3]); o2[64 * j] = w; }
    }
}

__device__ __forceinline__ void scan_phase(KP p, LAS unsigned char* lds, bool do_cbias, int layer) {
    int tid_ = threadIdx.x; asm volatile("" : "+v"(tid_));
    const int tid = tid_; unsigned char* ws = p->ws;
    if (blockIdx.x < 16) {
        const int h = blockIdx.x; const float* fl = (const float*)(ws + WS_FLOG); float* cum = (float*)(ws + WS_CUM) + (size_t)h * S_;
        LAS float* sh = (LAS float*)lds;
        float loc[32]; float tot = 0.f;
#pragma unroll
        for (int i = 0; i < 32; ++i) { loc[i] = fl[(size_t)(tid * 32 + i) * 16 + h]; }
#pragma unroll
        for (int i = 0; i < 32; ++i) { tot += loc[i]; loc[i] = tot; }
        sh[tid] = tot; __syncthreads();
        for (int off = 1; off < 512; off <<= 1) { const float v = tid >= off ? sh[tid - off] : 0.f; __syncthreads(); sh[tid] += v; __syncthreads(); }
        const float excl = sh[tid] - tot;
#pragma unroll
        for (int i = 0; i < 32; ++i) cum[tid * 32 + i] = excl + loc[i];
        __syncthreads();
    } else if (blockIdx.x == 16) {
        if (do_cbias) {
        const float* part = (const float*)(ws + WS_CBP); float* cb = (float*)(ws + WS_CB);
        const int mat = tid >> 8, c = tid & 255; float s = 0.f;
        for (int ch = 0; ch < 64; ++ch) s += part[(mat * 64 + ch) * 256 + c];
        cb[tid] = s; }
    } else {
        const int nb = (int)gridDim.x - 17, b = (int)blockIdx.x - 17;
        const int h = tid & 15; float mq = 0.f, mk = 0.f;
        const bf16_t* Q = (const bf16_t*)(ws + WS_A); const bf16_t* K = Q + (size_t)S_ * DM;
        for (int t = b * 32 + (tid >> 4); t < S_; t += nb * 32) {
            const u32x4* qp = (const u32x4*)(Q + (size_t)t * DM + h * 128); const u32x4* kp = (const u32x4*)(K + (size_t)t * DM + h * 128);
            float sq = 0.f, sk = 0.f;
#pragma unroll 4
            for (int i = 0; i < 16; ++i) { const u32x4 a = qp[i], c = kp[i];
#pragma unroll
                for (int e = 0; e < 4; ++e) { const float q0 = __uint_as_float(a[e] << 16), q1 = __uint_as_float(a[e] & 0xffff0000u), k0 = __uint_as_float(c[e] << 16), k1 = __uint_as_float(c[e] & 0xffff0000u);
                    sq += q0 * q0 + q1 * q1; sk += k0 * k0 + k1 * k1; } }
            mq = fmaxf(mq, sq); mk = fmaxf(mk, sk);
        }
        mq = fmaxf(mq, __shfl_xor(mq, 16)); mq = fmaxf(mq, __shfl_xor(mq, 32)); mk = fmaxf(mk, __shfl_xor(mk, 16)); mk = fmaxf(mk, __shfl_xor(mk, 32));
        if ((tid & 63) < 16) { unsigned* nr = (unsigned*)(ws + WS_NRM) + (layer * 16 + h) * 2; atomicMax(nr, __float_as_uint(mq)); atomicMax(nr + 1, __float_as_uint(mk)); }
    }
}

__device__ __forceinline__ void cmp2_phase(KP p) {
    int tid_ = threadIdx.x; asm volatile("" : "+v"(tid_));
    const int tid = tid_; unsigned char* ws = p->ws;
    const int rr = tid >> 7, d = tid & 127;
    for (int it = blockIdx.x; it < 2 * 1024; it += gridDim.x) {
        const int mat = it >> 10, row = (it & 1023) * 4 + rr;
        const bf16_t* hid = (const bf16_t*)(ws + WS_CH) + (size_t)mat * 4096 * 256 + (size_t)row * 256;
        const float* w2 = p->in[mat ? I_CV2 : I_CK2];
        float s = 0.f;
        for (int k = 0; k < 256; k += 2) { const unsigned hv = *(const unsigned*)(hid + k);
            s += __uint_as_float(hv << 16) * w2[k * 128 + d]; s += __uint_as_float(hv & 0xffff0000u) * w2[(k + 1) * 128 + d]; }
        if ((row & 1023) == 1023) s = 0.f;
        ((bf16_t*)(ws + (mat ? WS_VC : WS_KC)))[(size_t)row * 128 + d] = (bf16_t)f2bf(s);
    }
}

#define KSWZ(row, colB) ((row) * 256 + ((colB) ^ (((row) & 7) << 4)))
#define SBAR() __builtin_amdgcn_sched_barrier(0)
__device__ __forceinline__ int v_st(int k, int c) { const int kk = (k & ~0xC) | ((k & 4) << 1) | ((k & 8) >> 1); return ((kk >> 3) * 4 + (c >> 5)) * 512 + ((kk & 7) * 32 + (c & 31)) * 2; }
__device__ __forceinline__ int v_rd_base(int lane) { return ((lane & 3) << 3) | (((lane >> 2) & 3) << 6) | (((lane >> 4) & 1) << 5) | (((lane >> 5) & 1) << 8); }
constexpr int v_rd_off(int d0, int ks, int half) { return d0 * 512 + ks * 4096 + half * 2048; }
__device__ __forceinline__ int crow(int r, int hi) { return (r & 3) + 8 * (r >> 2) + 4 * hi; }

__device__ __forceinline__ void qkt(f32x16& p0, f32x16& p1, const LAS unsigned char* Kb, int r32, int hi, const bf16x8* qr) {
#pragma unroll
    for (int r = 0; r < 16; ++r) { p0[r] = 0.f; p1[r] = 0.f; }
    const LAS unsigned char* kb[4];
#pragma unroll
    for (int dd = 0; dd < 4; ++dd) kb[dd] = Kb + KSWZ(r32, (dd * 16 + hi * 8) * 2);
#pragma unroll
    for (int d0 = 0; d0 < 8; ++d0) { const LAS unsigned char* a = kb[d0 & 3] + (d0 >> 2) * 128;
        const bf16x8 b0 = *(const LAS bf16x8*)a;
        const bf16x8 b1 = *(const LAS bf16x8*)(a + 32 * 256);
        p0 = __builtin_amdgcn_mfma_f32_32x32x16_bf16(b0, qr[d0], p0, 0, 0, 0);
        p1 = __builtin_amdgcn_mfma_f32_32x32x16_bf16(b1, qr[d0], p1, 0, 0, 0); }
}
__device__ __forceinline__ void pv_tile(f32x16* o, int vb, bf16x8 pa0, bf16x8 pa1, bf16x8 pa2, bf16x8 pa3) {
#define TRRD(dst, off) asm volatile("ds_read_b64_tr_b16 %0, %1 offset:%2" : "=&v"(dst) : "v"(vb), "i"(off) : "memory")
#define PV_D0(d0) do { s16x4 l0, l1, l2, l3, h0, h1, h2, h3; constexpr int b_ = v_rd_off(d0, 0, 0); \
        TRRD(l0, b_); TRRD(h0, b_ + 2048); TRRD(l1, b_ + 4096); TRRD(h1, b_ + 6144); TRRD(l2, b_ + 8192); TRRD(h2, b_ + 10240); TRRD(l3, b_ + 12288); TRRD(h3, b_ + 14336); \
        asm volatile("s_waitcnt lgkmcnt(0)" ::: "memory"); SBAR(); \
        o[d0] = __builtin_amdgcn_mfma_f32_32x32x16_bf16(pa0, (bf16x8){l0[0], l0[1], l0[2], l0[3], h0[0], h0[1], h0[2], h0[3]}, o[d0], 0, 0, 0);   \
        o[d0] = __builtin_amdgcn_mfma_f32_32x32x16_bf16(pa1, (bf16x8){l1[0], l1[1], l1[2], l1[3], h1[0], h1[1], h1[2], h1[3]}, o[d0], 0, 0, 0);   \
        o[d0] = __builtin_amdgcn_mfma_f32_32x32x16_bf16(pa2, (bf16x8){l2[0], l2[1], l2[2], l2[3], h2[0], h2[1], h2[2], h2[3]}, o[d0], 0, 0, 0);   \
        o[d0] = __builtin_amdgcn_mfma_f32_32x32x16_bf16(pa3, (bf16x8){l3[0], l3[1], l3[2], l3[3], h3[0], h3[1], h3[2], h3[3]}, o[d0], 0, 0, 0); } while (0)
    PV_D0(0); PV_D0(1); PV_D0(2); PV_D0(3);
#undef PV_D0
#undef TRRD
}
__device__ __forceinline__ void p_to_frags(const f32x16& p0, const f32x16& p1, bf16x8& pa0, bf16x8& pa1, bf16x8& pa2, bf16x8& pa3) {
#define PK4(P, B_, OUT) do { unsigned a0 = cvt_pk_bf16(P[B_+0], P[B_+1]), a1 = cvt_pk_bf16(P[B_+2], P[B_+3]);                          \
        unsigned b0 = cvt_pk_bf16(P[B_+4], P[B_+5]), b1 = cvt_pk_bf16(P[B_+6], P[B_+7]);                                             \
        auto r0 = __builtin_amdgcn_permlane32_swap(a0, b0, false, false); auto r1 = __builtin_amdgcn_permlane32_swap(a1, b1, false, false); \
        u32x4 w = {r0[0], r1[0], r0[1], r1[1]}; OUT = *reinterpret_cast<bf16x8*>(&w); } while (0)
    PK4(p0, 0, pa0); PK4(p0, 8, pa1); PK4(p1, 0, pa2); PK4(p1, 8, pa3);
#undef PK4
}
__device__ __forceinline__ float half_swap_max(float v) { auto rr = __builtin_amdgcn_permlane32_swap(__float_as_uint(v), __float_as_uint(v), false, false); return fmaxf(__uint_as_float(rr[0]), __uint_as_float(rr[1])); }
__device__ __forceinline__ float half_swap_sum(float v) { auto rr = __builtin_amdgcn_permlane32_swap(__float_as_uint(v), __float_as_uint(v), false, false); return __uint_as_float(rr[0]) + __uint_as_float(rr[1]); }
__device__ __forceinline__ float online_sm(f32x16& p0, f32x16& p1, float& m, float& l) {
    float pmax = p0[0];
#pragma unroll
    for (int r = 1; r < 16; ++r) pmax = fmaxf(pmax, p0[r]);
#pragma unroll
    for (int r = 0; r < 16; ++r) pmax = fmaxf(pmax, p1[r]);
    pmax = half_swap_max(pmax);
    const float mn = fmaxf(m, pmax); const float alpha = __builtin_amdgcn_exp2f((m - mn) * L2E); m = mn;
    const float mnL = -mn * L2E; float ps = 0.f;
#pragma unroll
    for (int r = 0; r < 16; ++r) { p0[r] = __builtin_amdgcn_exp2f(fmaf(p0[r], L2E, mnL)); p1[r] = __builtin_amdgcn_exp2f(fmaf(p1[r], L2E, mnL)); ps += p0[r] + p1[r]; }
    ps = half_swap_sum(ps);
    l = l * alpha + ps;
    return alpha;
}

struct FL {
    const bf16_t* K; const bf16_t* V; int kstride, vstride;
    int j_lo, j_hi;
    const float* cum; float cq;
    int t_lane, t_w0;
    const LAS float* lut;
    __half* imp;
};
template <int MODE>
__device__ __forceinline__ void flash_loop(LAS unsigned char* lds, const FL& a, const bf16x8* qr, float& m, float& l, f32x16* o, float inv_l) {
    int tid_ = threadIdx.x; asm volatile("" : "+v"(tid_));
    const int tid = tid_, wid = __builtin_amdgcn_readfirstlane(tid >> 6), lane = tid & 63, r32 = lane & 31, hi = lane >> 5;
    LAS unsigned char* V_lds = lds + L_V; LAS unsigned char* K_lds = lds + L_K;
    LAS float* al_l = (LAS float*)(lds + L_WS) + wid * 64 + 32;
    LAS float* ckb = (LAS float*)(lds + L_CK);
    const int sr = tid >> 4, sc = (tid & 15) * 8, vst0 = v_st(sr, sc), vst1 = v_st(32 + sr, sc), kws = KSWZ(sr, sc * 2);
    const int vb0 = (int)(size_t)V_lds + v_rd_base(lane);
    constexpr bool HASV = (MODE != 1);
    bf16x8 sk0, sk1, sv0, sv1; float sck = 0.f;
    const float NEG = -__builtin_inff();
    float carry = 0.f;
#define FL_LOAD(j) do { const int kb_ = (j) * 64; \
        sk0 = *(const bf16x8*)(a.K + (size_t)(kb_ + sr) * a.kstride + sc); sk1 = *(const bf16x8*)(a.K + (size_t)(kb_ + 32 + sr) * a.kstride + sc); \
        if (HASV) { sv0 = *(const bf16x8*)(a.V + (size_t)(kb_ + sr) * a.vstride + sc); sv1 = *(const bf16x8*)(a.V + (size_t)(kb_ + 32 + sr) * a.vstride + sc); } \
        if (MODE == 0) { if (tid < 64) sck = a.cum[kb_ + tid]; } } while (0)
#define FL_WRITE(buf) do { *(LAS bf16x8*)(K_lds + (buf) * SHM_K + kws) = sk0; *(LAS bf16x8*)(K_lds + (buf) * SHM_K + kws + 32 * 256) = sk1; \
        if (HASV) { *(LAS bf16x8*)(V_lds + (buf) * SHM_V + vst0) = sv0; *(LAS bf16x8*)(V_lds + (buf) * SHM_V + vst1) = sv1; } \
        if (MODE == 0) { if (tid < 64) ckb[(buf) * 64 + tid] = sck; } } while (0)
    __syncthreads();
    FL_LOAD(a.j_lo); FL_WRITE(0); __syncthreads();
#pragma nounroll
    for (int j = a.j_lo; j < a.j_hi; ++j) {
        const int buf = (j - a.j_lo) & 1; const int kb = j * 64;
        if (j + 1 < a.j_hi) FL_LOAD(j + 1);
        const bool act = (MODE != 0) || (kb <= a.t_w0 + 31);
        if (act) {
            f32x16 p0, p1;
            qkt(p0, p1, K_lds + buf * SHM_K, r32, hi, qr);
            if (MODE == 0) {
#pragma unroll
                for (int i = 0; i < 4; ++i) { const f32x4 c0 = *(const LAS f32x4*)(ckb + buf * 64 + 4 * hi + 8 * i), c1 = *(const LAS f32x4*)(ckb + buf * 64 + 32 + 4 * hi + 8 * i);
#pragma unroll
                    for (int e = 0; e < 4; ++e) { p0[4 * i + e] += a.cq - c0[e]; p1[4 * i + e] += a.cq - c1[e]; } }
                if (kb + 63 > a.t_w0) { const int dq = a.t_lane - kb - 4 * hi;
#pragma unroll
                    for (int r = 0; r < 16; ++r) { const int c = (r & 3) + 8 * (r >> 2); if (dq - c < 0) p0[r] = NEG; if (dq - c - 32 < 0) p1[r] = NEG; } }
            } else if (MODE == 1 || MODE == 2) {
                const int dq = a.t_lane - 16 * kb - 31 - 64 * hi;
#pragma unroll
                for (int r = 0; r < 16; ++r) { const int d0_ = dq - 16 * (r & 3) - 128 * (r >> 2), d1_ = d0_ - 512;
                    const unsigned i0 = (unsigned)d0_ < 2047u ? (unsigned)d0_ : 2047u, i1 = (unsigned)d1_ < 2047u ? (unsigned)d1_ : 2047u;
                    const float b0 = a.lut[i0], b1 = a.lut[i1];
                    p0[r] = d0_ >= 0 ? p0[r] + b0 : NEG; p1[r] = d1_ >= 0 ? p1[r] + b1 : NEG; }
            } else {
                const int dq = a.t_lane - kb - 4 * hi;
#pragma unroll
                for (int r = 0; r < 16; ++r) { const int d0_ = dq - ((r & 3) + 8 * (r >> 2)), d1_ = d0_ - 32;
                    const unsigned i0 = (unsigned)d0_ < 2047u ? (unsigned)d0_ : 2047u, i1 = (unsigned)d1_ < 2047u ? (unsigned)d1_ : 2047u;
                    const float b0 = a.lut[i0], b1 = a.lut[i1];
                    p0[r] = (unsigned)d0_ < 512u ? p0[r] + b0 : NEG; p1[r] = (unsigned)d1_ < 512u ? p1[r] + b1 : NEG; }
            }
            if (MODE == 1) { (void)online_sm(p0, p1, m, l); }
            else if (MODE == 2) {
                const float mnL = -m * L2E;
#pragma unroll
                for (int r = 0; r < 16; ++r) { p0[r] = __builtin_amdgcn_exp2f(fmaf(p0[r], L2E, mnL)) * inv_l; p1[r] = __builtin_amdgcn_exp2f(fmaf(p1[r], L2E, mnL)) * inv_l; }
                float a0[4], a1[4], x0[4], x1[4];
#pragma unroll
                for (int i = 0; i < 4; ++i) { a0[i] = (p0[4 * i] + p0[4 * i + 1]) + (p0[4 * i + 2] + p0[4 * i + 3]); a1[i] = (p1[4 * i] + p1[4 * i + 1]) + (p1[4 * i + 2] + p1[4 * i + 3]);
                    x0[i] = __shfl_xor(p0[4 * i + 3], 32); x1[i] = __shfl_xor(p1[4 * i + 3], 32); }
                __half* ip = a.imp + 16 * j + hi;
#pragma unroll
                for (int i = 0; i < 4; ++i) { const float e0 = hi ? x0[i] : (i ? x0[i > 0 ? i - 1 : 0] : carry); const float e1 = hi ? x1[i] : (i ? x1[i > 0 ? i - 1 : 0] : x0[3]);
                    ip[2 * i] = __float2half(a0[i] + e0); ip[8 + 2 * i] = __float2half(a1[i] + e1); }
                carry = x1[3];
                bf16x8 pa0, pa1, pa2, pa3; p_to_frags(p0, p1, pa0, pa1, pa2, pa3);
                pv_tile(o, vb0 + buf * SHM_V, pa0, pa1, pa2, pa3);
            } else {
                const float alpha = online_sm(p0, p1, m, l);
                if (__any(alpha < 1.f)) { if (hi == 0) al_l[r32] = alpha; asm volatile("s_waitcnt lgkmcnt(0)" ::: "memory");
#pragma unroll
                    for (int d_ = 0; d_ < 4; ++d_)
#pragma unroll
                        for (int r = 0; r < 16; ++r) o[d_][r] *= al_l[crow(r, hi)]; }
                bf16x8 pa0, pa1, pa2, pa3; p_to_frags(p0, p1, pa0, pa1, pa2, pa3);
                pv_tile(o, vb0 + buf * SHM_V, pa0, pa1, pa2, pa3);
            }
        }
        if (j + 1 < a.j_hi) FL_WRITE(buf ^ 1);
        __syncthreads();
    }
#undef FL_LOAD
#undef FL_WRITE
}

__device__ __forceinline__ void fox_attn_phase(KP p, LAS unsigned char* lds, int layer) {
    const int wid = __builtin_amdgcn_readfirstlane(threadIdx.x >> 6);
    unsigned char* ws = p->ws;
    const bf16_t* Q = (const bf16_t*)(ws + WS_A); const bf16_t* K = Q + (size_t)S_ * DM; const bf16_t* V = K + (size_t)S_ * DM; bf16_t* O = (bf16_t*)(V + (size_t)S_ * DM);
    const float* cumall = (const float*)(ws + WS_CUM);
    const unsigned* nrm = (const unsigned*)(ws + WS_NRM) + layer * 32;
    LAS float* li_l = (LAS float*)(lds + L_WS) + wid * 64;
    LAS int* jl = (LAS int*)(lds + L_CK + 1024);
    for (int I = blockIdx.x; I < 1024; I += gridDim.x) {
        const int kk = I >> 8, qbi = (I >> 4) & 63, h = ((I & 15) + 5 * kk) & 15;
        const int c_ = qbi & 15; const int qb = kk == 0 ? 63 - c_ : (kk == 1 ? c_ : (kk == 2 ? 47 - c_ : 16 + c_));
        {
            int tid_ = threadIdx.x; asm volatile("" : "+v"(tid_));
            const int lane = tid_ & 63, r32 = lane & 31, hi = lane >> 5;
            const int t_w0 = qb * 256 + wid * 32, t_lane = t_w0 + r32;
            const float* cum = cumall + (size_t)h * S_;
            const float B2 = 2.f * sqrtf(__uint_as_float(nrm[h * 2]) * __uint_as_float(nrm[h * 2 + 1])) * 1.01f;
            const float T = cum[qb * 256] + 110.f + B2;
            __syncthreads();
            { const bool ok = (tid_ < qb * 4 + 4) && (cum[64 * (tid_ < 256 ? tid_ : 0) + 63] <= T);
              const unsigned long long bm = __ballot(ok);
              if (lane == 0) jl[wid] = bm ? wid * 64 + (__ffsll((long long)bm) - 1) : (1 << 30); }
            __syncthreads();
            int j_lo = jl[0];
#pragma unroll
            for (int w = 1; w < 8; ++w) j_lo = min(j_lo, jl[w]);
            j_lo = __builtin_amdgcn_readfirstlane(j_lo);
            if (j_lo > qb * 4) j_lo = qb * 4;
            bf16x8 qr[8];
#pragma unroll
            for (int d0 = 0; d0 < 8; ++d0) qr[d0] = *(const bf16x8*)(Q + (size_t)t_lane * DM + h * 128 + d0 * 16 + hi * 8);
            FL a; a.K = K + h * 128; a.V = V + h * 128; a.kstride = DM; a.vstride = DM; a.j_lo = j_lo; a.j_hi = qb * 4 + 4;
            a.cum = cum; a.cq = cum[t_lane]; a.t_lane = t_lane; a.t_w0 = t_w0; a.lut = nullptr; a.imp = nullptr;
            float m = -1e30f, l = 0.f; f32x16 o[4];
#pragma unroll
            for (int d_ = 0; d_ < 4; ++d_)
#pragma unroll
                for (int r = 0; r < 16; ++r) o[d_][r] = 0.f;
            flash_loop<0>(lds, a, qr, m, l, o, 0.f);
            if (hi == 0) li_l[r32] = l; asm volatile("s_waitcnt lgkmcnt(0)" ::: "memory");
            bf16_t* Ow = O + (size_t)t_w0 * DM + h * 128;
            int lo_ = 4 * hi * DM + r32; asm volatile("" : "+v"(lo_));
#pragma unroll
            for (int r = 0; r < 16; ++r) { const int orow = crow(r, hi); const float rli = __builtin_amdgcn_rcpf(li_l[orow]);
#pragma unroll
                for (int d0 = 0; d0 < 4; ++d0) { const float v = o[d0][r] * rli; const float vn = __shfl_xor(v, 1);
                    if ((r32 & 1) == 0) *(unsigned*)(Ow + (lo_ + ((r & 3) + 8 * (r >> 2)) * DM + d0 * 32)) = cvt_pk_bf16(v, vn); } }
        }
    }
}

__device__ __forceinline__ void nsa_attn_phase(KP p, LAS unsigned char* lds) {
    const int tid = threadIdx.x, wid = __builtin_amdgcn_readfirstlane(tid >> 6);
    unsigned char* ws = p->ws;
    const bf16_t* Q = (const bf16_t*)(ws + WS_A); bf16_t* attn = (bf16_t*)(ws + WS_A) + (size_t)S_ * DM; __half* imp = (__half*)(ws + WS_A + 128 * MiB);
    float* partial = (float*)(ws + WS_PRE); const float* gates = (const float*)(ws + WS_GATE);
    const bf16_t* kv = (const bf16_t*)(ws + WS_KV); const bf16_t* kc = (const bf16_t*)(ws + WS_KC); const bf16_t* vc = (const bf16_t*)(ws + WS_VC);
    const bf16_t* vt = (const bf16_t*)(ws + WS_VT); const bf16_t* kfr = (const bf16_t*)(ws + WS_KF); const float* lutg = (const float*)(ws + WS_LUT);
    LAS float* lut = (LAS float*)(lds + L_LUT);
    LAS float* li_l = (LAS float*)(lds + L_WS) + wid * 64;
    const float NEG = -__builtin_inff();
    int g_loaded = -1;
    for (int it = blockIdx.x; it < 1024; it += gridDim.x) {
        const int g = it & 3, tile = 2 * (it >> 3) + ((it >> 2) & 1);
        if (g != g_loaded) {
            __syncthreads();
            for (int i = tid; i < 4 * 2048; i += 512) lut[i] = lutg[g * 4 * 2048 + i];
            __syncthreads();
            g_loaded = g;
        }
        {
            const int t0 = tile * 64;
            {
                const int r = wid & 3, th = wid >> 2, h = g * 4 + r;
                int tid_ = threadIdx.x; asm volatile("" : "+v"(tid_));
                const int lane = tid_ & 63, r32 = lane & 31, hi = lane >> 5;
                const int t_w0 = t0 + 32 * th, t_lane = t_w0 + r32;
                bf16x8 qr[8];
#pragma unroll
                for (int d0 = 0; d0 < 8; ++d0) qr[d0] = *(const bf16x8*)(Q + (size_t)t_lane * DM + h * 128 + d0 * 16 + hi * 8);
                const float g0 = gates[(size_t)t_lane * 48 + h * 3 + 0], g2 = gates[(size_t)t_lane * 48 + h * 3 + 2];
                FL a; a.K = kc + (size_t)g * 1024 * 128; a.V = vc + (size_t)g * 1024 * 128; a.kstride = 128; a.vstride = 128; a.j_lo = 0; a.j_hi = (t0 / 16 + 2) / 64 + 1;
                a.cum = nullptr; a.cq = 0.f; a.t_lane = t_lane; a.t_w0 = t_w0; a.lut = lut + r * 2048; a.imp = imp + ((size_t)h * S_ + t_lane) * 256;
                float m = -1e30f, l = 0.f; f32x16 o[4];
#pragma unroll
                for (int d_ = 0; d_ < 4; ++d_)
#pragma unroll
                    for (int rr = 0; rr < 16; ++rr) o[d_][rr] = 0.f;
                flash_loop<1>(lds, a, qr, m, l, o, 0.f);
                const float inv_l = l > 0.f ? 1.f / l : 0.f;
                flash_loop<2>(lds, a, qr, m, l, o, inv_l);
                float* Pw = partial + (size_t)t_w0 * DM + h * 128;
                int lo_ = 4 * hi * DM + r32; asm volatile("" : "+v"(lo_));
                if (hi == 0) li_l[r32] = g0; asm volatile("s_waitcnt lgkmcnt(0)" ::: "memory");
#pragma unroll
                for (int rr = 0; rr < 16; ++rr) { const int orow = crow(rr, hi); const float f = li_l[orow];
#pragma unroll
                    for (int d0 = 0; d0 < 4; ++d0) Pw[lo_ + ((rr & 3) + 8 * (rr >> 2)) * DM + d0 * 32] = o[d0][rr] * f; }
                a.K = kv + 4 * 512 + g * 128; a.V = kv + 5 * 512 + g * 128; a.kstride = NKV; a.vstride = NKV; a.j_lo = tile >= 8 ? tile - 8 : 0; a.j_hi = tile + 1;
                m = -1e30f; l = 0.f;
#pragma unroll
                for (int d_ = 0; d_ < 4; ++d_)
#pragma unroll
                    for (int rr = 0; rr < 16; ++rr) o[d_][rr] = 0.f;
                flash_loop<3>(lds, a, qr, m, l, o, 0.f);
                asm volatile("s_waitcnt lgkmcnt(0)" ::: "memory");
                int lo2_ = 4 * hi * DM + r32; asm volatile("" : "+v"(lo2_));
                if (hi == 0) li_l[r32] = g2 * (l > 0.f ? 1.f / l : 0.f); asm volatile("s_waitcnt lgkmcnt(0)" ::: "memory");
#pragma unroll
                for (int rr = 0; rr < 16; ++rr) { const int orow = crow(rr, hi); const float f = li_l[orow];
#pragma unroll
                    for (int d0 = 0; d0 < 4; ++d0) { float* pp = Pw + (lo2_ + ((rr & 3) + 8 * (rr >> 2)) * DM + d0 * 32); *pp = *pp + o[d0][rr] * f; } }
            }
            __syncthreads();
            const int nf = tile >= 2 ? 3 : tile + 1;
            {
                int tid_ = threadIdx.x; asm volatile("" : "+v"(tid_));
#pragma nounroll
                for (int s_ = 0; s_ < nf; ++s_) { const int id = s_ == 0 ? 0 : (s_ == nf - 1 ? tile : tile - 1); const int base = s_ == 0 ? 0 : (s_ == 1 ? 32768 : L_END);
                    const u32x4* ks_ = (const u32x4*)(kfr + ((size_t)g * 256 + id) * 8192); const u32x4* vs_ = (const u32x4*)(vt + ((size_t)g * 256 + id) * 8192);
                    u32x4 tk[2], tv[2];
#pragma unroll
                    for (int i = 0; i < 2; ++i) { tk[i] = ks_[tid_ + 512 * i]; tv[i] = vs_[tid_ + 512 * i]; }
#pragma unroll
                    for (int i = 0; i < 2; ++i) { *(LAS u32x4*)(lds + base + (tid_ + 512 * i) * 16) = tk[i]; *(LAS u32x4*)(lds + base + 16384 + (tid_ + 512 * i) * 16) = tv[i]; } }
            }
            __syncthreads();
            {
#pragma nounroll
                for (int tt = 0; tt < 8; ++tt) {
                    int tid_ = threadIdx.x; asm volatile("" : "+v"(tid_));
                    const int lane = tid_ & 63;
                    const int n = lane & 15, kq = lane >> 4, hn = n & 3; const bool hv = n < 4;
                    const LAS float* lutn = lut + hn * 2048;
                    const int t = t0 + 8 * wid + tt; const int blk = tile;
                    float sc[4] = {0.f, 0.f, 0.f, 0.f};
#pragma unroll
                    for (int r = 0; r < 4; ++r) { const u32x2 raw = *(const u32x2*)(imp + ((size_t)(g * 4 + r) * S_ + t) * 256 + lane * 4);
                        sc[0] += __half2float(__ushort_as_half((unsigned short)(raw.x & 0xffffu))); sc[1] += __half2float(__ushort_as_half((unsigned short)(raw.x >> 16)));
                        sc[2] += __half2float(__ushort_as_half((unsigned short)(raw.y & 0xffffu))); sc[3] += __half2float(__ushort_as_half((unsigned short)(raw.y >> 16))); }
#pragma unroll
                    for (int e = 0; e < 4; ++e) { const int j = lane * 4 + e; const bool forced = (j == 0) | (j == blk) | (j == blk - 1);
                        sc[e] = forced ? 1e4f : (j <= blk ? sc[e] : -1.f); }
                    int mysel = -1;
#pragma nounroll
                    for (int k = 0; k < 16; ++k) {
                        float bv = sc[0]; int be = 0;
#pragma unroll
                        for (int e = 1; e < 4; ++e) if (sc[e] > bv) { bv = sc[e]; be = e; }
                        const float wmax = wave_max_fast(bv);
                        if (wmax < 0.f) break;
                        const unsigned long long msk = __ballot(bv == wmax);
                        const int src = __ffsll((long long)msk) - 1;
                        const int jw = __builtin_amdgcn_readlane(lane * 4 + be, src);
                        if (lane == k) mysel = jw;
                        if (lane == src) {
#pragma unroll
                            for (int e = 0; e < 4; ++e) if (be == e) sc[e] = -2.f; }
                    }
                    bf16x8 qb[4];
#pragma unroll
                    for (int ks = 0; ks < 4; ++ks) { qb[ks] = *(const bf16x8*)(Q + (size_t)t * DM + (g * 4 + hn) * 128 + 32 * ks + kq * 8);
                        if (!hv) qb[ks] = (bf16x8){0, 0, 0, 0, 0, 0, 0, 0}; }
                    float m = -1e30f, l = 0.f; f32x4 o[8];
#pragma unroll
                    for (int d_ = 0; d_ < 8; ++d_) o[d_] = (f32x4){0.f, 0.f, 0.f, 0.f};
                    const int nsel = __builtin_popcountll(__ballot(mysel >= 0));
                    bf16x8 kf[16], vf[16];
                    const bf16_t* Kg = kfr + (size_t)g * 256 * 8192 + lane * 8;
                    const bf16_t* Vg = vt + (size_t)g * 256 * 8192 + lane * 8;
#define SEL_QK() f32x4 s[4]; _Pragma("unroll") for (int sub = 0; sub < 4; ++sub) { s[sub] = (f32x4){0.f, 0.f, 0.f, 0.f}; \
                            _Pragma("unroll") for (int ks = 0; ks < 4; ++ks) s[sub] = __builtin_amdgcn_mfma_f32_16x16x32_bf16(kf[sub * 4 + ks], qb[ks], s[sub], 0, 0, 0); }
#define SEL_SM_PV(sb_) { const int dq = t - (sb_) * 64 - 4 * kq; float pmax = NEG; \
                        _Pragma("unroll") for (int sub = 0; sub < 4; ++sub) _Pragma("unroll") for (int i = 0; i < 4; ++i) { const int d = dq - 16 * sub - i; const unsigned idx = (unsigned)d < 2047u ? (unsigned)d : 2047u; \
                                const float v = d >= 0 ? s[sub][i] + lutn[idx] : NEG; s[sub][i] = v; pmax = fmaxf(pmax, v); } \
                        if (!__all(pmax <= m + 8.f)) {     \
                            pmax = fmaxf(pmax, __shfl_xor(pmax, 16)); pmax = fmaxf(pmax, __shfl_xor(pmax, 32)); \
                            const float mn = fmaxf(m, pmax); const float alpha = __builtin_amdgcn_exp2f((m - mn) * L2E); m = mn; l *= alpha; \
                            _Pragma("unroll") for (int d_ = 0; d_ < 8; ++d_) o[d_] = o[d_] * alpha; } \
                        const float mnL = -m * L2E; float ps = 0.f; \
                        _Pragma("unroll") for (int sub = 0; sub < 4; ++sub) _Pragma("unroll") for (int i = 0; i < 4; ++i) { s[sub][i] = __builtin_amdgcn_exp2f(fmaf(s[sub][i], L2E, mnL)); ps += s[sub][i]; } \
                        l += ps; \
                        bf16x8 pb[2]; { const u32x4 w0 = pack8bf(s[0], s[1]), w1 = pack8bf(s[2], s[3]); pb[0] = *reinterpret_cast<const bf16x8*>(&w0); pb[1] = *reinterpret_cast<const bf16x8*>(&w1); } \
                        SBAR(); \
                        _Pragma("unroll") for (int d_ = 0; d_ < 8; ++d_) _Pragma("unroll") for (int s2 = 0; s2 < 2; ++s2) o[d_] = __builtin_amdgcn_mfma_f32_16x16x32_bf16(vf[d_ * 2 + s2], pb[s2], o[d_], 0, 0, 0); }
#pragma nounroll
                    for (int b = 0; b < nf; ++b) {
                        const int sb = b == 0 ? 0 : (b == nf - 1 ? tile : tile - 1);
                        const LAS unsigned char* fb = lds + (b == 0 ? 0 : (b == 1 ? 32768 : L_END)) + lane * 16;
#pragma unroll
                        for (int f = 0; f < 16; ++f) { kf[f] = *(const LAS bf16x8*)(fb + f * 1024); vf[f] = *(const LAS bf16x8*)(fb + 16384 + f * 1024); }
                        SEL_QK();
                        SEL_SM_PV(sb);
                    }
                    if (nsel > nf) {
                    int sb = __builtin_amdgcn_readfirstlane(__shfl(mysel, nf));
                    { const bf16_t* Kp = Kg + (size_t)sb * 8192;
#pragma unroll
                      for (int f = 0; f < 16; ++f) kf[f] = *(const bf16x8*)(Kp + f * 512); }
#pragma nounroll
                    for (int b = nf; b < nsel; ++b) {
                        const int sbn = __builtin_amdgcn_readfirstlane(__shfl(mysel, b + 1 < nsel ? b + 1 : b));
                        { const bf16_t* Vp = Vg + (size_t)sb * 8192;
#pragma unroll
                          for (int f = 0; f < 16; ++f) vf[f] = *(const bf16x8*)(Vp + f * 512); }
                        SBAR();
                        SEL_QK();
                        SBAR();
                        { const bf16_t* Kp = Kg + (size_t)sbn * 8192;
#pragma unroll
                          for (int f = 0; f < 16; ++f) kf[f] = *(const bf16x8*)(Kp + f * 512); }
                        SBAR();
                        SEL_SM_PV(sb);
                        sb = sbn;
                    }
                    }
#undef SEL_QK
#undef SEL_SM_PV
                    l += __shfl_xor(l, 16); l += __shfl_xor(l, 32);
                    const float g1 = gates[(size_t)t * 48 + (g * 4 + hn) * 3 + 1];
                    const float f = g1 * (l > 0.f ? 1.f / l : 0.f);
                    if (hv) {
#pragma unroll
                        for (int d_ = 0; d_ < 8; ++d_) { const size_t off = (size_t)t * DM + (g * 4 + n) * 128 + 16 * d_ + 4 * kq;
                            const f32x4 pp = *(const f32x4*)(partial + off); const f32x4 r4 = pp + o[d_] * f;
                            u32x2 w; w.x = cvt_pk_bf16(r4[0], r4[1]); w.y = cvt_pk_bf16(r4[2], r4[3]); *(u32x2*)(attn + off) = w; }
                    }
                }
            }
        }
    }
}

#define XB_TMO      128
#define XB_XCNT(j)  (256  + 64 * (j))
#define XB_XSUB(j)  (1280 + 64 * (j))
#define XB_XGEN(j)  (2304 + 64 * (j))
#define XB_TOP      3328
#define XB_TOPGEN   3392
#define XCD_BAR_WORDS 3456
#define XB_SPIN_CAP (1u << 18)
__device__ __forceinline__ unsigned xb_ld(unsigned* p)              { return __hip_atomic_load(p, __ATOMIC_RELAXED, __HIP_MEMORY_SCOPE_AGENT); }
__device__ __forceinline__ unsigned xb_add(unsigned* p, unsigned v) { return __hip_atomic_fetch_add(p, v, __ATOMIC_RELAXED, __HIP_MEMORY_SCOPE_AGENT); }
__device__ __forceinline__ unsigned xb_xcc_id() { return (unsigned)__builtin_amdgcn_s_getreg((3 << 11) | 20) & 0xFu; }
#define XB_SPIN(cond, bar) do { unsigned _sp = 0; while (cond) { __builtin_amdgcn_s_sleep(1); \
    if ((++_sp & 255u) == 0u) { if (xb_ld(&(bar)[XB_TMO])) break; if (_sp > XB_SPIN_CAP) { atomicAdd(&(bar)[XB_TMO], 1u); break; } } } } while (0)

struct XcdBarrier {
    unsigned* bar; unsigned x;
    volatile LAS unsigned* st;
};

__device__ __forceinline__ XcdBarrier xcd_barrier_post(unsigned* bar, volatile LAS unsigned* st) {
    XcdBarrier b; b.bar = bar; b.x = xb_xcc_id(); b.st = st;
    if (threadIdx.x == 0) (void)xb_add(&bar[XB_XCNT(b.x)], 1u);
    return b;
}
__device__ __forceinline__ void xcd_barrier_complete(unsigned* bar, unsigned x, unsigned& nloc, unsigned& nx) {
    const unsigned G = gridDim.x * gridDim.y * gridDim.z;
    unsigned sum, cnt, mine, sp = 0u;
    for (;;) {
        sum = 0u; cnt = 0u; mine = 0u;
#pragma unroll
        for (unsigned j = 0; j < 16; ++j) { const unsigned c = xb_ld(&bar[XB_XCNT(j)]); sum += c; cnt += (c > 0u) ? 1u : 0u; mine = (j == x) ? c : mine; }
        if (sum == G) break;
        __builtin_amdgcn_s_sleep(1);
        if ((++sp & 255u) == 0u) { if (xb_ld(&bar[XB_TMO])) break; if (sp > XB_SPIN_CAP) { atomicAdd(&bar[XB_TMO], 1u); break; } }
    }
    nloc = mine > 0u ? mine : 1u; nx = cnt > 0u ? cnt : 1u;
}

__device__ __forceinline__ void xcd_barrier(const XcdBarrier& b) {
    asm volatile("s_waitcnt vmcnt(0)" ::: "memory");
    __syncthreads();
    if (threadIdx.x == 0) {
        unsigned* bar = b.bar;
        __builtin_amdgcn_s_waitcnt(0);
        unsigned nloc = b.st[0], nx = b.st[1];
        if (nloc == 0u) { xcd_barrier_complete(bar, b.x, nloc, nx); b.st[0] = nloc; b.st[1] = nx; }
        const unsigned old = xb_add(&bar[XB_XSUB(b.x)], 1u);
        const unsigned gen = old / nloc;
        if (old + 1u == (gen + 1u) * nloc) {
            __builtin_amdgcn_fence(__ATOMIC_RELEASE, "agent");
            asm volatile("s_waitcnt vmcnt(0)" ::: "memory");
            const unsigned og = xb_add(&bar[XB_TOP], 1u);
            const unsigned tg = og / nx;
            if (og + 1u == (tg + 1u) * nx) xb_add(&bar[XB_TOPGEN], 1u);
            else XB_SPIN(xb_ld(&bar[XB_TOPGEN]) == tg, bar);
            __builtin_amdgcn_fence(__ATOMIC_ACQUIRE, "agent");
            xb_add(&bar[XB_XGEN(b.x)], 1u);
            asm volatile("s_waitcnt vmcnt(0)" ::: "memory");
        } else {
            XB_SPIN(xb_ld(&bar[XB_XGEN(b.x)]) == gen, bar);
            __builtin_amdgcn_fence(__ATOMIC_ACQUIRE, "agent");
            asm volatile("s_waitcnt vmcnt(0)" ::: "memory");
        }
    }
    __syncthreads();
}


#define RUN_GEMM(EpiT, epi, Aptr, Btptr, Mv, Nv, Kv, ldav, cidx) do { const pg8::Gemm g_{(Aptr), (Btptr), (Mv), (Nv), (Kv), (ldav)}; pg8::StaticOrder so_; so_.init((Mv), (Nv), (int)gridDim.x, (cidx)); \
        pg8::gemm_phase<EpiT, pg8::StaticOrder, true, true>(lds, g_, so_, (epi)); } while (0)

__global__ void __launch_bounds__(512, 2) mega_fwd(Params p_unused) {
    extern __shared__ __attribute__((aligned(16))) unsigned char lds_raw[];
    LAS unsigned char* lds = (LAS unsigned char*)lds_raw;
    cg::grid_group grid = cg::this_grid();
    const size_t SD = (size_t)S_ * DM;
#define WSP(off) (KARGS()->ws + (off))
    LAS unsigned* bst = (LAS unsigned*)(lds + LDS_BYTES - 16);
    if (threadIdx.x < 4) bst[threadIdx.x] = 0u;
    __syncthreads();
    (void)xcd_barrier_post((unsigned*)(KARGS()->ws + WS_BAR), (volatile LAS unsigned*)bst);
#define GSYNC() do { XcdBarrier b_; b_.bar = (unsigned*)(KARGS()->ws + WS_BAR); b_.x = xb_xcc_id(); b_.st = (volatile LAS unsigned*)bst; xcd_barrier(b_); } while (0)
    prologue(KARGS(), lds);
    grid.sync();
#pragma nounroll
    for (int L = 0; L < 4; ++L) {
        const int bid = (int)blockIdx.x, G = (int)gridDim.x;
        if (L < 2) {
            { KP p = KARGS(); unsigned char* ws = p->ws; bf16_t* A0 = (bf16_t*)(ws + WS_A);
              EpiFoxQKV E{A0, (float*)(ws + WS_FLOG), p->in[I_FOXBF] + L * 16};
              RUN_GEMM(EpiFoxQKV, E, (const bf16_t*)(ws + WS_HBF), (const bf16_t*)(ws + WS_WFOXIN) + (size_t)L * NFOX * DM, S_, NFOX, DM, DM, bid); }
            GSYNC();
            scan_phase(KARGS(), lds, L == 0, L);
            GSYNC();
            fox_attn_phase(KARGS(), lds, L);
            GSYNC();
        } else {
            if (L == 2) {
                { KP p = KARGS(); unsigned char* ws = p->ws;
                  EpiKV E{(bf16_t*)(ws + WS_KV), (bf16_t*)(ws + WS_RAWK), (bf16_t*)(ws + WS_RAWV), (bf16_t*)(ws + WS_VT), (bf16_t*)(ws + WS_KF)};
                  RUN_GEMM(EpiKV, E, (const bf16_t*)(ws + WS_HBF), (const bf16_t*)(ws + WS_WKV), S_, NKV, DM, DM, bid); }
                GSYNC();
#pragma nounroll
                for (int mat = 0; mat < 2; ++mat) { KP p = KARGS(); unsigned char* ws = p->ws;
                    EpiCmp1 E{(bf16_t*)(ws + WS_CH) + (size_t)mat * 4096 * 256, (const float*)(ws + WS_CB) + mat * 256};
                    RUN_GEMM(EpiCmp1, E, (const bf16_t*)(ws + (mat ? WS_RAWV : WS_RAWK)), (const bf16_t*)(ws + WS_WC1) + (size_t)mat * 256 * 4096, 4096, 256, 4096, 2048, (bid + G - 16 * mat) % G);
                }
                GSYNC();
                cmp2_phase(KARGS());
                GSYNC();
            }
            { KP p = KARGS(); unsigned char* ws = p->ws;
              EpiNsaQ E{(bf16_t*)(ws + WS_A), (float*)(ws + WS_GATE)};
              RUN_GEMM(EpiNsaQ, E, (const bf16_t*)(ws + WS_HBF), (const bf16_t*)(ws + WS_WNSAIN) + (size_t)(L - 2) * NNSA * DM, S_, NNSA, DM, DM, bid); }
            GSYNC();
            nsa_attn_phase(KARGS(), lds);
            GSYNC();
        }
        { KP p = KARGS(); unsigned char* ws = p->ws; bf16_t* A0 = (bf16_t*)(ws + WS_A);
          const float* hres = L == 0 ? p->in[I_X] : p->out;
          const bf16_t* attn = L < 2 ? A0 + 3 * SD : A0 + SD;
          const bf16_t* wo = L < 2 ? (const bf16_t*)(ws + WS_WFOXO) + (size_t)L * DM * DM : (const bf16_t*)(ws + WS_WNSAO) + (size_t)(L - 2) * DM * DM;
          EpiRes E{hres, (float*)(ws + WS_PRE)}; RUN_GEMM(EpiRes, E, attn, wo, S_, DM, DM, DM, bid); }
        GSYNC();
        { KP p = KARGS(); ln_phase((const float*)(p->ws + WS_PRE), p->in[I_LN1G] + L * DM, p->in[I_LN1B] + L * DM, p->out, (bf16_t*)(p->ws + WS_HBF)); }
        GSYNC();
        { KP p = KARGS(); unsigned char* ws = p->ws;
          EpiRelu2 E{(bf16_t*)(ws + WS_A)}; RUN_GEMM(EpiRelu2, E, (const bf16_t*)(ws + WS_HBF), (const bf16_t*)(ws + WS_W1) + (size_t)L * FF * DM, S_, FF, DM, DM, bid); }
        GSYNC();
        { KP p = KARGS(); unsigned char* ws = p->ws;
          EpiRes E{p->out, (float*)(ws + WS_PRE)}; RUN_GEMM(EpiRes, E, (const bf16_t*)(ws + WS_A), (const bf16_t*)(ws + WS_W2) + (size_t)L * DM * FF, S_, DM, FF, FF, bid); }
        GSYNC();
        { KP p = KARGS(); ln_phase((const float*)(p->ws + WS_PRE), p->in[I_LN2G] + L * DM, p->in[I_LN2B] + L * DM, p->out, (bf16_t*)(p->ws + WS_HBF)); }
        GSYNC();
    }
}

extern "C" void kernel_launch(void* const* d_in, const int* in_sizes, int n_in, void* d_out, int out_size, void* d_ws, size_t ws_size, hipStream_t stream) {
    static int grid = 0;
    if (grid == 0) {
        if (n_in != 20 || out_size != S_ * DM || ws_size < WS_END) { fprintf(stderr, "kernel_launch: unexpected shapes (n_in %d out %d ws %zu)\n", n_in, out_size, ws_size); grid = -1; return; }
        int dev = 0, cus = 0, per_cu = 0;
        (void)hipGetDevice(&dev); (void)hipDeviceGetAttribute(&cus, hipDeviceAttributeMultiprocessorCount, dev);
        if (hipFuncSetAttribute((const void*)mega_fwd, hipFuncAttributeMaxDynamicSharedMemorySize, LDS_BYTES) != hipSuccess) fprintf(stderr, "kernel_launch: hipFuncSetAttribute failed\n");
        if (hipOccupancyMaxActiveBlocksPerMultiprocessor(&per_cu, (const void*)mega_fwd, 512, LDS_BYTES) != hipSuccess || per_cu < 1) per_cu = 1;
        (void)hipGetLastError();
        if (cus <= 0) cus = 256;
        grid = cus * per_cu;
    }
    if (grid < 0) return;
    Params p{};
    for (int i = 0; i < 20; ++i) p.in[i] = (const float*)d_in[i];
    p.out = (float*)d_out; p.ws = (unsigned char*)d_ws;
    (void)hipMemsetAsync((unsigned char*)d_ws + WS_BAR, 0, 16384, stream);
    void* args[] = {&p};
    hipError_t e = hipLaunchCooperativeKernel((const void*)mega_fwd, dim3(grid), dim3(512), args, LDS_BYTES, stream);
    if (e != hipSuccess) fprintf(stderr, "kernel_launch: cooperative launch failed: %s (grid %d)\n", hipGetErrorString(e), grid);
}
```

```cpp
#include <hip/hip_runtime.h>
#include <hip/hip_cooperative_groups.h>
#include <hip/hip_fp16.h>
#include <cstdio>
#include <cstdint>
namespace cg = cooperative_groups;
namespace pg8 {
#define PG8_LAS __attribute__((address_space(3)))
typedef unsigned short bf16_t;
typedef short bf16x8 __attribute__((ext_vector_type(8)));
typedef float f32x4 __attribute__((ext_vector_type(4)));
typedef unsigned u32x4 __attribute__((ext_vector_type(4)));
constexpr int BM = 256, BK = 64, HALF = 128, HTB = HALF * BK * 2  , STAGE_BYTES = 8 * HTB, NXCD = 8, WGM = 8;

__host__ __device__ __forceinline__ int lds_byte(int r, int c) { const int st = (r >> 4) * 2 + (c >> 5), rr = r & 15, cc = c & 31, ob = rr * 64 + cc * 2; return st * 1024 + (ob ^ (((ob >> 9) & 1) << 5)); }
__host__ __device__ __forceinline__ void stage_rc(int b, int& R, int& C) { const int st = b / 1024, sb = b % 1024, swz = sb ^ (((sb >> 9) & 1) << 5); R = (st >> 1) * 16 + swz / 64; C = (st & 1) * 32 + (swz % 64) / 2; }
__host__ __device__ __forceinline__ int perm32(int rho) { const int n = rho >> 4, i = rho & 15; return 8 * (i >> 2) + 4 * n + (i & 3); }

struct Unit { int pm, pn; };
struct Gemm { const bf16_t* A; const bf16_t* Bt; int M, N, K, lda, ldb; };

struct StaticOrder {
    int nM, nN, nwg, G, c;
    __host__ __device__ void init(int M, int N, int G_, int c_) { nM = M / BM; nN = N / BM; nwg = nM * nN; G = G_; c = c_; }
    __host__ __device__ bool next(int i, Unit& u) const {
        const long L = (long)i * G + c; if (L >= nwg) return false;
        int wgid = (int)L; { const int q = nwg / NXCD, r = nwg % NXCD, xcd = wgid % NXCD, off = wgid / NXCD; wgid = (xcd < r ? xcd * (q + 1) : r * (q + 1) + (xcd - r) * q) + off; }
        const int nig = WGM * nN, gid = wgid / nig, fm = gid * WGM, gsz = (nM - fm) < WGM ? (nM - fm) : WGM;
        u.pm = fm + ((wgid % nig) % gsz); u.pn = (wgid % nig) / gsz; return true;
    }
    __device__ __forceinline__ void a_ready(const Unit&) const {}
    __device__ __forceinline__ void done(const Unit&) const {}
};


__device__ __forceinline__ unsigned cvt_pk_bf16(float lo, float hi) { unsigned r; asm volatile("v_cvt_pk_bf16_f32 %0, %1, %2" : "=v"(r) : "v"(lo), "v"(hi)); return r; }
typedef float f32x2 __attribute__((ext_vector_type(2)));
template <class Epi, class Sched, bool ALIGN_EPI = false, bool SP2 = false>
__device__ __forceinline__ void gemm_phase(PG8_LAS unsigned char* lds, const Gemm g, const Sched& S, const Epi& E) {
    int tid_ = threadIdx.x; asm volatile("" : "+v"(tid_));
    const int tid = tid_, wid = __builtin_amdgcn_readfirstlane(tid >> 6), lane = tid & 63, wr = wid >> 2, wc = wid & 3, fr = lane & 15, fq = lane >> 4;
    const int K = g.K, nt = K / BK;
    unsigned voffA[2], voffB[2];
#pragma unroll
    for (int i = 0; i < 2; ++i) { int R, C; stage_rc(tid * 16 + i * 8192, R, C); const int Rb = Epi::PERM ? ((R & ~31) + perm32(R & 31)) : R;
        voffA[i] = (unsigned)(R * g.lda + C) * 2u; voffB[i] = (unsigned)(Rb * g.ldb + C) * 2u; }
    const size_t kstep = (size_t)(BK * 2);
    const size_t hstepB = (size_t)HALF * g.ldb * 2, hstepA = (size_t)HALF * g.lda * 2;
    const size_t tstepB = 2 * hstepB, tstepA = 2 * hstepA;
    const unsigned ldsw = (unsigned)wid * 1024u;
    const int aoff = lds_byte(wr * 64 + fr, fq * 8), boff = lds_byte(wc * 32 + fr, fq * 8);
#define PG8_SA(b, h) (((b) * 2 + (h)) * HTB)
#define PG8_SB(b, h) ((4 + (b) * 2 + (h)) * HTB)
#define PG8_STAGE(bufoff, gbase, voff) do { _Pragma("unroll") for (int _i = 0; _i < 2; ++_i) \
        __builtin_amdgcn_global_load_lds((const unsigned*)((const char*)(gbase) + (voff)[_i]), (PG8_LAS unsigned*)(lds + (bufoff) + ldsw + _i * 8192), 16, 0, 0); } while (0)
#define PG8_LDA(dst, b, h) do { _Pragma("unroll") for (int m = 0; m < 4; ++m) _Pragma("unroll") for (int k = 0; k < 2; ++k) dst[m][k] = *(const PG8_LAS bf16x8*)(lds + PG8_SA(b, h) + aoff + m * 2048 + k * 1024); } while (0)
#define PG8_LDB(dst, b, h) do { _Pragma("unroll") for (int n = 0; n < 2; ++n) _Pragma("unroll") for (int k = 0; k < 2; ++k) dst[n][k] = *(const PG8_LAS bf16x8*)(lds + PG8_SB(b, h) + boff + n * 2048 + k * 1024); } while (0)
#define PG8_MMA(ai, bj, At, Bt) do { __builtin_amdgcn_s_setprio(1); _Pragma("unroll") for (int m = 0; m < 4; ++m) _Pragma("unroll") for (int n = 0; n < 2; ++n) _Pragma("unroll") for (int k = 0; k < 2; ++k) \
        acc[ai][bj][m][n] = __builtin_amdgcn_mfma_f32_16x16x32_bf16(Bt[n][k], At[m][k], acc[ai][bj][m][n], 0, 0, 0); __builtin_amdgcn_s_setprio(0); } while (0)
#define PG8_WAIT_V(n) asm volatile("s_waitcnt vmcnt(" #n ")" ::: "memory")
#define PG8_WAIT_L(n) asm volatile("s_waitcnt lgkmcnt(" #n ")" ::: "memory")
#define PG8_BAR __builtin_amdgcn_s_barrier()
#define PG8_SCHED __builtin_amdgcn_sched_barrier(0)
    Unit cur, nxt; int ui = 0;
    if (!S.next(0, cur)) return;
    f32x4 acc[2][2][4][2];
#pragma unroll
    for (int a = 0; a < 2; ++a)
#pragma unroll
        for (int b = 0; b < 2; ++b)
#pragma unroll
            for (int m = 0; m < 4; ++m)
#pragma unroll
                for (int n = 0; n < 2; ++n) acc[a][b][m][n] = (f32x4){0.f, 0.f, 0.f, 0.f};
    bf16x8 At[4][2], B0[2][2], B1[2][2];
    const char* cA = (const char*)g.A + (size_t)cur.pm * tstepA; const char* cB = (const char*)g.Bt + (size_t)cur.pn * tstepB;
    S.a_ready(cur);
    if constexpr (SP2) {
        PG8_STAGE(PG8_SB(0, 0), cB, voffB); PG8_STAGE(PG8_SB(0, 1), cB + hstepB, voffB); PG8_STAGE(PG8_SA(0, 0), cA, voffA); PG8_STAGE(PG8_SA(0, 1), cA + hstepA, voffA);
        if (wr == 1) PG8_BAR;
        PG8_WAIT_V(2); PG8_BAR;
        PG8_STAGE(PG8_SB(1, 0), cB + kstep, voffB); PG8_STAGE(PG8_SA(1, 0), cA + kstep, voffA); PG8_STAGE(PG8_SB(1, 1), cB + hstepB + kstep, voffB);
        PG8_WAIT_V(6); PG8_BAR;
    } else {
        PG8_STAGE(PG8_SB(0, 0), cB, voffB); PG8_STAGE(PG8_SA(0, 0), cA, voffA); PG8_STAGE(PG8_SB(0, 1), cB + hstepB, voffB); PG8_STAGE(PG8_SA(0, 1), cA + hstepA, voffA);
        if (wr == 1) PG8_BAR;
        PG8_WAIT_V(4); PG8_BAR;
        PG8_STAGE(PG8_SB(1, 0), cB + kstep, voffB); PG8_STAGE(PG8_SA(1, 0), cA + kstep, voffA); PG8_STAGE(PG8_SB(1, 1), cB + hstepB + kstep, voffB);
        PG8_WAIT_V(6); PG8_BAR;
    }
    for (;;) {
        const bool has_next = S.next(ui + 1, nxt);
        const char* nA = has_next ? (const char*)g.A + (size_t)nxt.pm * tstepA : cA; const char* nB = has_next ? (const char*)g.Bt + (size_t)nxt.pn * tstepB : cB;
        for (int t = 0; t < nt; t += 2) {
            const bool last = (t == nt - 2);
            const char* a1 = cA + (size_t)(t + 1) * kstep;
            const char* a2 = last ? nA : cA + (size_t)(t + 2) * kstep; const char* b2 = last ? nB : cB + (size_t)(t + 2) * kstep;
            const char* a3 = a2 + kstep; const char* b3 = b2 + kstep;
            if (last && has_next) S.a_ready(nxt);
            if constexpr (SP2) {
            PG8_LDB(B0, 0, 0); PG8_LDB(B1, 0, 1); PG8_SCHED; PG8_LDA(At, 0, 0); PG8_STAGE(PG8_SA(1, 1), a1 + hstepA, voffA);
            PG8_WAIT_V(8); PG8_WAIT_L(0); PG8_BAR; PG8_MMA(0, 0, At, B0); PG8_MMA(0, 1, At, B1); PG8_BAR; PG8_SCHED;
            PG8_LDA(At, 0, 1); PG8_STAGE(PG8_SB(0, 0), b2, voffB); PG8_STAGE(PG8_SB(0, 1), b2 + hstepB, voffB); PG8_STAGE(PG8_SA(0, 0), a2, voffA);
            PG8_WAIT_V(8); PG8_WAIT_L(0); PG8_BAR; PG8_MMA(1, 0, At, B0); PG8_MMA(1, 1, At, B1); PG8_BAR; PG8_SCHED;
            PG8_LDB(B0, 1, 0); PG8_LDB(B1, 1, 1); PG8_SCHED; PG8_LDA(At, 1, 0); PG8_STAGE(PG8_SA(0, 1), a2 + hstepA, voffA);
            PG8_WAIT_V(8); PG8_WAIT_L(0); PG8_BAR; PG8_MMA(0, 0, At, B0); PG8_MMA(0, 1, At, B1); PG8_BAR; PG8_SCHED;
            PG8_LDA(At, 1, 1); PG8_STAGE(PG8_SB(1, 0), b3, voffB); PG8_STAGE(PG8_SB(1, 1), b3 + hstepB, voffB); PG8_STAGE(PG8_SA(1, 0), a3, voffA);
            PG8_WAIT_V(8); PG8_WAIT_L(0); PG8_BAR; PG8_MMA(1, 0, At, B0); PG8_MMA(1, 1, At, B1); PG8_BAR; PG8_SCHED;
            }
        }
        if constexpr (ALIGN_EPI) { if (wr == 0) PG8_BAR; }
        if constexpr (!Epi::AFTER_DRAIN) { E(acc, cur, wr, wc, fr, fq); S.done(cur); }
        if (!has_next) break;
#pragma unroll
        for (int a = 0; a < 2; ++a)
#pragma unroll
            for (int b = 0; b < 2; ++b)
#pragma unroll
                for (int m = 0; m < 4; ++m)
#pragma unroll
                    for (int n = 0; n < 2; ++n) acc[a][b][m][n] = (f32x4){0.f, 0.f, 0.f, 0.f};
        cur = nxt; cA = nA; cB = nB; ++ui;
        if constexpr (ALIGN_EPI) { if (wr == 1) PG8_BAR; }
    }
    PG8_WAIT_V(0);
    if constexpr (!ALIGN_EPI) { if (wr == 0) PG8_BAR; }
    PG8_BAR;
    if constexpr (Epi::AFTER_DRAIN) { E.fused(acc, cur, wr, wc, fr, fq, lds, wid, lane); S.done(cur); }
#undef PG8_SA
#undef PG8_SB
#undef PG8_STAGE
#undef PG8_LDA
#undef PG8_LDB
#undef PG8_MMA
#undef PG8_WAIT_V
#undef PG8_WAIT_L
#undef PG8_BAR
#undef PG8_SCHED
}
}

#define LAS __attribute__((address_space(3)))
using pg8::bf16_t; using pg8::bf16x8; using pg8::f32x4; using pg8::u32x4; using pg8::Unit; using pg8::cvt_pk_bf16;
typedef short s16x4 __attribute__((ext_vector_type(4)));
typedef float f32x16 __attribute__((ext_vector_type(16)));
typedef unsigned u32x2 __attribute__((ext_vector_type(2)));

constexpr int S_ = 16384, DM = 2048, FF = 8192, NH = 16, DH = 128, NG = 4;
constexpr int NFOX = 6400, NNSA = 2304, NKV = 3072;
constexpr float ALPHA_ = 1.6817928305074292f;
constexpr float QSCALE = 0.08838834764831845f;
constexpr float L2E = 1.4426950408889634f;
constexpr float LN_EPS_ = 1e-5f;

constexpr size_t MiB = 1u << 20;
constexpr size_t WS_WFOXIN = 0;
constexpr size_t WS_WFOXO  = 50 * MiB;
constexpr size_t WS_WNSAIN = 66 * MiB;
constexpr size_t WS_WNSAO  = 84 * MiB;
constexpr size_t WS_WKV    = 100 * MiB;
constexpr size_t WS_W1     = 112 * MiB;
constexpr size_t WS_W2     = 240 * MiB;
constexpr size_t WS_WC1    = 368 * MiB;
constexpr size_t WS_HBF    = 372 * MiB;
constexpr size_t WS_PRE    = 436 * MiB;
constexpr size_t WS_A      = 564 * MiB;
constexpr size_t WS_KV     = 820 * MiB;
constexpr size_t WS_RAWK   = 916 * MiB;
constexpr size_t WS_RAWV   = 933 * MiB;
constexpr size_t WS_VT     = 950 * MiB;
constexpr size_t WS_CH     = 966 * MiB;
constexpr size_t WS_KC     = 970 * MiB;
constexpr size_t WS_VC     = 971 * MiB;
constexpr size_t WS_CUM    = 972 * MiB;
constexpr size_t WS_FLOG   = 973 * MiB;
constexpr size_t WS_GATE   = 974 * MiB;
constexpr size_t WS_LUT    = 977 * MiB;
constexpr size_t WS_CBP    = 977 * MiB + 256 * 1024;
constexpr size_t WS_CB     = 977 * MiB + 512 * 1024;
constexpr size_t WS_NRM    = 977 * MiB + 768 * 1024;
constexpr size_t WS_KF     = 978 * MiB;
constexpr size_t WS_BAR    = 994 * MiB;
constexpr size_t WS_CPART  = 436 * MiB;
constexpr size_t WS_END    = 995 * MiB;

constexpr int SHM_K = 16384, SHM_V = 16384;
constexpr int L_V = 0, L_K = 32768, L_WS = 65536, L_CK = 65536 + 2048, L_LUT = 69632, L_END = 69632 + 32768;
constexpr int LDS_BYTES = 147456;

__device__ __forceinline__ u32x4 pack8bf(f32x4 a, f32x4 b) { u32x4 w; w.x = cvt_pk_bf16(a[0], a[1]); w.y = cvt_pk_bf16(a[2], a[3]); w.z = cvt_pk_bf16(b[0], b[1]); w.w = cvt_pk_bf16(b[2], b[3]); return w; }
__device__ __forceinline__ float log_sigmoid_f(float x) { return fminf(x, 0.f) - log1pf(__expf(-fabsf(x))); }
__device__ __forceinline__ float sigmoid_f(float x) { return 1.f / (1.f + __expf(-x)); }
__device__ __forceinline__ float gelu_tanh_f(float x) { const float u = 0.7978845608028654f * (x + 0.044715f * x * x * x); const float t = 1.f - 2.f / (__expf(2.f * u) + 1.f); return 0.5f * x * (1.f + t); }

struct EpiFoxQKV {
    static constexpr bool PERM = true, AFTER_DRAIN = false;
    bf16_t* q; float* flog; const float* bfg;
    __device__ __forceinline__ void operator()(const f32x4 (&acc)[2][2][4][2], const Unit& u, int wr, int wc, int fr, int fq) const {
        const int row0 = u.pm * 256 + wr * 64 + fr; const int colt = u.pn * 256;
        if (colt < 6144) {
            const int t = colt >> 11; bf16_t* base = q + (size_t)t * ((size_t)S_ * DM); const float sc = t == 0 ? QSCALE : 1.f;
            const int c0 = colt - t * 2048 + wc * 32 + 8 * fq;
#pragma unroll
            for (int ai = 0; ai < 2; ++ai)
#pragma unroll
                for (int m = 0; m < 4; ++m) { bf16_t* rowp = base + (size_t)(row0 + ai * 128 + m * 16) * DM + c0;
#pragma unroll
                    for (int bj = 0; bj < 2; ++bj) *(u32x4*)(rowp + bj * 128) = pack8bf(acc[ai][bj][m][0] * sc, acc[ai][bj][m][1] * sc); }
        } else if (wc == 0 && fq < 2) {
            float bb[8];
#pragma unroll
            for (int e = 0; e < 8; ++e) bb[e] = bfg[8 * fq + e];
#pragma unroll
            for (int ai = 0; ai < 2; ++ai)
#pragma unroll
                for (int m = 0; m < 4; ++m) { float* rowp = flog + (size_t)(row0 + ai * 128 + m * 16) * 16 + 8 * fq;
                    f32x4 a = acc[ai][0][m][0], b = acc[ai][0][m][1], oa, ob;
#pragma unroll
                    for (int e = 0; e < 4; ++e) { oa[e] = log_sigmoid_f(a[e] + bb[e]); ob[e] = log_sigmoid_f(b[e] + bb[4 + e]); }
                    *(f32x4*)rowp = oa; *(f32x4*)(rowp + 4) = ob; }
        }
    }
};
struct EpiNsaQ {
    static constexpr bool PERM = true, AFTER_DRAIN = false;
    bf16_t* q; float* gates;
    __device__ __forceinline__ void operator()(const f32x4 (&acc)[2][2][4][2], const Unit& u, int wr, int wc, int fr, int fq) const {
        const int row0 = u.pm * 256 + wr * 64 + fr; const int colt = u.pn * 256;
        if (colt < 2048) {
            const int c0 = colt + wc * 32 + 8 * fq;
#pragma unroll
            for (int ai = 0; ai < 2; ++ai)
#pragma unroll
                for (int m = 0; m < 4; ++m) { bf16_t* rowp = q + (size_t)(row0 + ai * 128 + m * 16) * DM + c0;
#pragma unroll
                    for (int bj = 0; bj < 2; ++bj) *(u32x4*)(rowp + bj * 128) = pack8bf(acc[ai][bj][m][0] * QSCALE, acc[ai][bj][m][1] * QSCALE); }
        } else { const int c0 = wc * 32 + 8 * fq;
            if (c0 < 48) {
#pragma unroll
            for (int ai = 0; ai < 2; ++ai)
#pragma unroll
                for (int m = 0; m < 4; ++m) { float* rowp = gates + (size_t)(row0 + ai * 128 + m * 16) * 48 + c0;
                    f32x4 a = acc[ai][0][m][0], b = acc[ai][0][m][1], oa, ob;
#pragma unroll
                    for (int e = 0; e < 4; ++e) { oa[e] = sigmoid_f(a[e]); ob[e] = sigmoid_f(b[e]); }
                    *(f32x4*)rowp = oa; *(f32x4*)(rowp + 4) = ob; } }
        }
    }
};
struct EpiRes {
    static constexpr bool PERM = true, AFTER_DRAIN = false;
    const float* res; float* out;
    __device__ __forceinline__ void operator()(const f32x4 (&acc)[2][2][4][2], const Unit& u, int wr, int wc, int fr, int fq) const {
        const int row0 = u.pm * 256 + wr * 64 + fr; const int c0 = u.pn * 256 + wc * 32 + 8 * fq;
#pragma unroll
        for (int ai = 0; ai < 2; ++ai)
#pragma unroll
            for (int m = 0; m < 4; ++m) { const size_t off = (size_t)(row0 + ai * 128 + m * 16) * DM + c0;
#pragma unroll
                for (int bj = 0; bj < 2; ++bj) { const f32x4 r0 = *(const f32x4*)(res + off + bj * 128), r1 = *(const f32x4*)(res + off + bj * 128 + 4);
                    *(f32x4*)(out + off + bj * 128) = r0 * ALPHA_ + acc[ai][bj][m][0]; *(f32x4*)(out + off + bj * 128 + 4) = r1 * ALPHA_ + acc[ai][bj][m][1]; } }
    }
};
struct EpiRelu2 {
    static constexpr bool PERM = true, AFTER_DRAIN = false;
    bf16_t* O;
    __device__ __forceinline__ void operator()(const f32x4 (&acc)[2][2][4][2], const Unit& u, int wr, int wc, int fr, int fq) const {
        const int row0 = u.pm * 256 + wr * 64 + fr; const int c0 = u.pn * 256 + wc * 32 + 8 * fq;
#pragma unroll
        for (int ai = 0; ai < 2; ++ai)
#pragma unroll
            for (int m = 0; m < 4; ++m) { bf16_t* rowp = O + (size_t)(row0 + ai * 128 + m * 16) * FF + c0;
#pragma unroll
                for (int bj = 0; bj < 2; ++bj) { f32x4 a = acc[ai][bj][m][0], b = acc[ai][bj][m][1];
#pragma unroll
                    for (int e = 0; e < 4; ++e) { a[e] = fmaxf(a[e], 0.f); a[e] *= a[e]; b[e] = fmaxf(b[e], 0.f); b[e] *= b[e]; }
                    *(u32x4*)(rowp + bj * 128) = pack8bf(a, b); } }
    }
};
__device__ __forceinline__ int vt_pos(int ko) { return ((ko & 15) >> 2) * 8 + ((ko >> 4) << 2) + (ko & 3); }
struct EpiKV {
    static constexpr bool PERM = true, AFTER_DRAIN = false;
    bf16_t* kv; bf16_t* rawk; bf16_t* rawv; bf16_t* vt; bf16_t* kf;
    __device__ __forceinline__ void operator()(const f32x4 (&acc)[2][2][4][2], const Unit& u, int wr, int wc, int fr, int fq) const {
        const int row0 = u.pm * 256 + wr * 64 + fr;
#pragma unroll
        for (int bj = 0; bj < 2; ++bj) {
            const int cg_ = u.pn * 256 + bj * 128; const int slot = cg_ >> 9, g = (cg_ & 511) >> 7; const int d0 = wc * 32 + 8 * fq;
#pragma unroll
            for (int ai = 0; ai < 2; ++ai)
#pragma unroll
                for (int m = 0; m < 4; ++m) { const int row = row0 + ai * 128 + m * 16; const f32x4 a = acc[ai][bj][m][0], b = acc[ai][bj][m][1];
                    if (slot < 2) { bf16_t* dst = (slot == 0 ? rawk : rawv) + ((size_t)g * S_ + row) * 128 + d0; *(u32x4*)dst = pack8bf(a, b); }
                    else if (slot == 2) { const int blk = row >> 6, kin = row & 63;
                        *(u32x4*)(kf + ((size_t)((g * 256 + blk) * 16 + (kin >> 4) * 4 + wc)) * 512 + (fq * 16 + (kin & 15)) * 8) = pack8bf(a, b); }
                    else if (slot == 3) { const u32x4 w = pack8bf(a, b); const int blk = row >> 6, kin = row & 63, pos = vt_pos(kin & 31);
                        bf16_t* dst = vt + ((size_t)((g * 256 + blk) * 16 + (wc * 2 + (fq >> 1)) * 2 + (kin >> 5))) * 512 + ((pos >> 3) * 16 + (fq & 1) * 8) * 8 + (pos & 7);
                        dst[0] = (bf16_t)(w.x & 0xffffu); dst[8] = (bf16_t)(w.x >> 16); dst[16] = (bf16_t)(w.y & 0xffffu); dst[24] = (bf16_t)(w.y >> 16);
                        dst[32] = (bf16_t)(w.z & 0xffffu); dst[40] = (bf16_t)(w.z >> 16); dst[48] = (bf16_t)(w.w & 0xffffu); dst[56] = (bf16_t)(w.w >> 16); }
                    else { *(u32x4*)(kv + (size_t)row * NKV + cg_ + d0) = pack8bf(a, b); } }
        }
    }
};
struct EpiPart {
    static constexpr bool PERM = true, AFTER_DRAIN = false;
    float* P;
    __device__ __forceinline__ void operator()(const f32x4 (&acc)[2][2][4][2], const Unit& u, int wr, int wc, int fr, int fq) const {
        const int row0 = u.pm * 256 + wr * 64 + fr; const int c0 = wc * 32 + 8 * fq;
#pragma unroll
        for (int ai = 0; ai < 2; ++ai)
#pragma unroll
            for (int m = 0; m < 4; ++m) { float* rowp = P + (size_t)(row0 + ai * 128 + m * 16) * 256 + c0;
#pragma unroll
                for (int bj = 0; bj < 2; ++bj) { *(f32x4*)(rowp + bj * 128) = acc[ai][bj][m][0]; *(f32x4*)(rowp + bj * 128 + 4) = acc[ai][bj][m][1]; } }
    }
};

__device__ __forceinline__ unsigned f2bf(float f) { unsigned u = __builtin_bit_cast(unsigned, f); return (u + 0x7fffu + ((u >> 16) & 1u)) >> 16; }
__device__ __forceinline__ unsigned pk2(float lo, float hi) { return f2bf(lo) | (f2bf(hi) << 16); }
__device__ __forceinline__ float wave_sum(float v) {
#pragma unroll
    for (int o = 1; o < 64; o <<= 1) v += __shfl_xor(v, o);
    return v;
}
template <int CTRL> __device__ __forceinline__ float dppf(float v) { return __uint_as_float((unsigned)__builtin_amdgcn_update_dpp(0, (int)__float_as_uint(v), CTRL, 0xF, 0xF, true)); }
__device__ __forceinline__ float wave_max_fast(float v) {
    v = fmaxf(v, dppf<0xB1>(v)); v = fmaxf(v, dppf<0x4E>(v)); v = fmaxf(v, dppf<0x141>(v)); v = fmaxf(v, dppf<0x140>(v));
    const float a = __uint_as_float((unsigned)__builtin_amdgcn_readlane((int)__float_as_uint(v), 0)), b = __uint_as_float((unsigned)__builtin_amdgcn_readlane((int)__float_as_uint(v), 16));
    const float c = __uint_as_float((unsigned)__builtin_amdgcn_readlane((int)__float_as_uint(v), 32)), d = __uint_as_float((unsigned)__builtin_amdgcn_readlane((int)__float_as_uint(v), 48));
    return fmaxf(fmaxf(a, b), fmaxf(c, d));
}
__device__ __forceinline__ float wave_sum_fast(float v) {
    v += dppf<0xB1>(v); v += dppf<0x4E>(v); v += dppf<0x141>(v); v += dppf<0x140>(v);
    const float a = __uint_as_float((unsigned)__builtin_amdgcn_readlane((int)__float_as_uint(v), 0)), b = __uint_as_float((unsigned)__builtin_amdgcn_readlane((int)__float_as_uint(v), 16));
    const float c = __uint_as_float((unsigned)__builtin_amdgcn_readlane((int)__float_as_uint(v), 32)), d = __uint_as_float((unsigned)__builtin_amdgcn_readlane((int)__float_as_uint(v), 48));
    return (a + b) + (c + d);
}
__device__ __forceinline__ float wave_max(float v) {
#pragma unroll
    for (int o = 1; o < 64; o <<= 1) v = fmaxf(v, __shfl_xor(v, o));
    return v;
}
__device__ __forceinline__ void transpose_item(const float* W, int K, int ld, int ncols, bf16_t* WT, LAS float* scr, int item, int lane) {
    const int nblk = ncols / 32, kb = item / nblk, nb = item % nblk, k0 = 64 * kb, n0 = 32 * nb;
#pragma unroll 8
    for (int i = 0; i < 32; ++i) { const int kk = 2 * i + (lane >> 5); scr[kk * 33 + (lane & 31)] = W[(size_t)(k0 + kk) * ld + n0 + (lane & 31)]; }
    asm volatile("s_waitcnt lgkmcnt(0)" ::: "memory");
    const int c = lane & 7;
#pragma unroll
    for (int j = 0; j < 4; ++j) { const int n = (lane >> 3) + 8 * j; const LAS float* s = scr + (8 * c) * 33 + n;
        u32x4 o; o.x = pk2(s[0 * 33], s[1 * 33]); o.y = pk2(s[2 * 33], s[3 * 33]); o.z = pk2(s[4 * 33], s[5 * 33]); o.w = pk2(s[6 * 33], s[7 * 33]);
        *(u32x4*)(WT + (size_t)(n0 + n) * K + k0 + 8 * c) = o; }
    asm volatile("s_waitcnt lgkmcnt(0)" ::: "memory");
}
__device__ __forceinline__ int rel_bucket_dev(int n) {
    if (n < 16) return n;
    int lg = 16 + (int)(__logf((float)n / 16.0f) / 4.852030263919617f * 16.0f);
    return lg > 31 ? 31 : lg;
}

struct Params { const float* in[20]; float* out; unsigned char* ws; };
typedef const Params __attribute__((address_space(4)))* KP;
#define KARGS() ({ KP q_ = (KP)__builtin_amdgcn_kernarg_segment_ptr(); asm volatile("" : "+s"(q_)); q_; })
enum { I_X = 0, I_FOXWIN, I_FOXBF, I_FOXWO, I_NSAWIN, I_NSAWO, I_KVW, I_POSK, I_POSV, I_CK1, I_CK2, I_CV1, I_CV2, I_RELB, I_W1, I_W2, I_LN1G, I_LN1B, I_LN2G, I_LN2B };

__device__ __forceinline__ void prologue(KP p, LAS unsigned char* lds) {
    int tid_ = threadIdx.x; asm volatile("" : "+v"(tid_));
    const int tid = tid_, lane = tid & 63, wave = tid >> 6;
    const int gw = blockIdx.x * 8 + wave, NGW = gridDim.x * 8;
    LAS float* scr = (LAS float*)(lds + wave * 16384);
    unsigned char* ws = p->ws;
    long base = 0;
#define TR(src, K, ld, ncols, dst) do { const long n_ = (long)((K) / 64) * ((ncols) / 32); \
        for (long it = gw; it < n_; it += NGW) transpose_item((src), (K), (ld), (ncols), (dst), scr, (int)it, lane); } while (0)
    for (int L = 0; L < 2; ++L) {
        TR(p->in[I_FOXWIN] + (size_t)L * DM * 6160, DM, 6160, 6144, (bf16_t*)(ws + WS_WFOXIN) + (size_t)L * NFOX * DM);
        TR(p->in[I_FOXWO] + (size_t)L * DM * DM, DM, DM, DM, (bf16_t*)(ws + WS_WFOXO) + (size_t)L * DM * DM);
        TR(p->in[I_NSAWIN] + (size_t)L * DM * 2096, DM, 2096, 2048, (bf16_t*)(ws + WS_WNSAIN) + (size_t)L * NNSA * DM);
        TR(p->in[I_NSAWO] + (size_t)L * DM * DM, DM, DM, DM, (bf16_t*)(ws + WS_WNSAO) + (size_t)L * DM * DM);
    }
    TR(p->in[I_KVW], DM, NKV, NKV, (bf16_t*)(ws + WS_WKV));
    for (int L = 0; L < 4; ++L) {
        TR(p->in[I_W1] + (size_t)L * DM * FF, DM, FF, FF, (bf16_t*)(ws + WS_W1) + (size_t)L * FF * DM);
        TR(p->in[I_W2] + (size_t)L * FF * DM, FF, DM, DM, (bf16_t*)(ws + WS_W2) + (size_t)L * DM * FF);
    }
    TR(p->in[I_CK1], 4096, 256, 256, (bf16_t*)(ws + WS_WC1));
    TR(p->in[I_CV1], 4096, 256, 256, (bf16_t*)(ws + WS_WC1) + (size_t)256 * 4096);
#undef TR
    (void)base;
    const int gt = blockIdx.x * 512 + tid, NGT = gridDim.x * 512;
    for (int i = gt; i < 2 * 256 * DM; i += NGT) { const int L = i / (256 * DM), r = (i / DM) % 256, k = i % DM;
        const float v = r < 16 ? p->in[I_FOXWIN][(size_t)L * DM * 6160 + (size_t)k * 6160 + 6144 + r] : 0.f;
        ((bf16_t*)(ws + WS_WFOXIN))[(size_t)L * NFOX * DM + (size_t)(6144 + r) * DM + k] = (bf16_t)f2bf(v); }
    for (int i = gt; i < 2 * 256 * DM; i += NGT) { const int L = i / (256 * DM), r = (i / DM) % 256, k = i % DM;
        const float v = r < 48 ? p->in[I_NSAWIN][(size_t)L * DM * 2096 + (size_t)k * 2096 + 2048 + r] : 0.f;
        ((bf16_t*)(ws + WS_WNSAIN))[(size_t)L * NNSA * DM + (size_t)(2048 + r) * DM + k] = (bf16_t)f2bf(v); }
    { const f32x4* x4 = (const f32x4*)p->in[I_X]; u32x2* o = (u32x2*)(ws + WS_HBF);
      for (int i = gt; i < S_ * DM / 4; i += NGT) { const f32x4 v = x4[i]; u32x2 w; w.x = pk2(v[0], v[1]); w.y = pk2(v[2], v[3]); o[i] = w; } }
    { float* lut = (float*)(ws + WS_LUT);
      for (int i = gt; i < 16 * 2048; i += NGT) { const int h = i >> 11, d = i & 2047; lut[i] = p->in[I_RELB][rel_bucket_dev(d) * 16 + h]; } }
    { float* part = (float*)(ws + WS_CBP);
      for (int i = gt; i < 2 * 64 * 256; i += NGT) { const int mat = i / (64 * 256), ch = (i / 256) % 64, c = i % 256;
          const float* pos = p->in[mat ? I_POSV : I_POSK]; const float* w1 = p->in[mat ? I_CV1 : I_CK1]; float s = 0.f;
          for (int j = ch * 64; j < ch * 64 + 64; ++j) s += pos[j] * w1[(size_t)j * 256 + c];
          part[i] = s; } }
    if (gt < 64) ((unsigned*)(ws + WS_NRM))[gt] = 0u;
    { bf16_t* rk = (bf16_t*)(ws + WS_RAWK) + (size_t)4 * S_ * 128; bf16_t* rv = (bf16_t*)(ws + WS_RAWV) + (size_t)4 * S_ * 128;
      for (int i = gt; i < 32 * 128; i += NGT) { rk[i] = 0; rv[i] = 0; } }
}

__device__ __forceinline__ void ln_phase(const float* pre, const float* gam, const float* bet, float* h32, bf16_t* hbf) {
    int tid_ = threadIdx.x; asm volatile("" : "+v"(tid_));
    const int tid = tid_, lane = tid & 63, wave = tid >> 6;
    const int gw = blockIdx.x * 8 + wave, NGW = gridDim.x * 8;
    f32x4 nx[8];
    if (gw < S_) { const f32x4* xr = (const f32x4*)(pre + (size_t)gw * DM) + lane;
#pragma unroll
        for (int j = 0; j < 8; ++j) nx[j] = xr[64 * j]; }
#pragma nounroll
    for (int row = gw; row < S_; row += NGW) {
        f32x4 v[8]; float s = 0.f;
#pragma unroll
        for (int j = 0; j < 8; ++j) { v[j] = nx[j]; s += (v[j][0] + v[j][1]) + (v[j][2] + v[j][3]); }
        if (row + NGW < S_) { const f32x4* xr = (const f32x4*)(pre + (size_t)(row + NGW) * DM) + lane;
#pragma unroll
            for (int j = 0; j < 8; ++j) nx[j] = xr[64 * j]; }
        const float mean = wave_sum_fast(s) * (1.f / DM); float s2 = 0.f;
#pragma unroll
        for (int j = 0; j < 8; ++j) { v[j] = v[j] - mean; s2 += (v[j][0] * v[j][0] + v[j][1] * v[j][1]) + (v[j][2] * v[j][2] + v[j][3] * v[j][3]); }
        const float rstd = 1.f / sqrtf(wave_sum_fast(s2) * (1.f / DM) + LN_EPS_);
        f32x4* o4 = (f32x4*)(h32 + (size_t)row * DM) + lane; u32x2* o2 = (u32x2*)(hbf + (size_t)row * DM) + lane;
#pragma unroll
        for (int j = 0; j < 8; ++j) { const f32x4 g4 = ((const f32x4*)gam)[lane + 64 * j], b4 = ((const f32x4*)bet)[lane + 64 * j];
            const f32x4 y = v[j] * rstd * g4 + b4; o4[64 * j] = y; u32x2 w; w.x = pk2(y[0], y[1]); w.y = pk2(y[2], y[3]); o2[64 * j] = w; }
    }
}

__device__ __forceinline__ void scan_phase(KP p, LAS unsigned char* lds, bool do_cbias, int layer) {
    int tid_ = threadIdx.x; asm volatile("" : "+v"(tid_));
    const int tid = tid_; unsigned char* ws = p->ws;
    if (blockIdx.x < 16) {
        const int h = blockIdx.x; const float* fl = (const float*)(ws + WS_FLOG); float* cum = (float*)(ws + WS_CUM) + (size_t)h * S_;
        LAS float* sh = (LAS float*)lds;
        float loc[32]; float tot = 0.f;
#pragma unroll
        for (int i = 0; i < 32; ++i) { loc[i] = fl[(size_t)(tid * 32 + i) * 16 + h]; }
#pragma unroll
        for (int i = 0; i < 32; ++i) { tot += loc[i]; loc[i] = tot; }
        sh[tid] = tot; __syncthreads();
        for (int off = 1; off < 512; off <<= 1) { const float v = tid >= off ? sh[tid - off] : 0.f; __syncthreads(); sh[tid] += v; __syncthreads(); }
        const float excl = sh[tid] - tot;
#pragma unroll
        for (int i = 0; i < 32; ++i) cum[tid * 32 + i] = excl + loc[i];
        __syncthreads();
    } else if (blockIdx.x == 16) {
        if (do_cbias) {
        const float* part = (const float*)(ws + WS_CBP); float* cb = (float*)(ws + WS_CB);
        const int mat = tid >> 8, c = tid & 255; float s = 0.f;
        for (int ch = 0; ch < 64; ++ch) s += part[(mat * 64 + ch) * 256 + c];
        cb[tid] = s; }
    } else {
        const int nb = (int)gridDim.x - 17, b = (int)blockIdx.x - 17;
        const int h = tid & 15; float mq = 0.f, mk = 0.f;
        const bf16_t* Q = (const bf16_t*)(ws + WS_A); const bf16_t* K = Q + (size_t)S_ * DM;
        for (int t = b * 32 + (tid >> 4); t < S_; t += nb * 32) {
            const u32x4* qp = (const u32x4*)(Q + (size_t)t * DM + h * 128); const u32x4* kp = (const u32x4*)(K + (size_t)t * DM + h * 128);
            float sq = 0.f, sk = 0.f;
#pragma unroll 4
            for (int i = 0; i < 16; ++i) { const u32x4 a = qp[i], c = kp[i];
#pragma unroll
                for (int e = 0; e < 4; ++e) { const float q0 = __uint_as_float(a[e] << 16), q1 = __uint_as_float(a[e] & 0xffff0000u), k0 = __uint_as_float(c[e] << 16), k1 = __uint_as_float(c[e] & 0xffff0000u);
                    sq += q0 * q0 + q1 * q1; sk += k0 * k0 + k1 * k1; } }
            mq = fmaxf(mq, sq); mk = fmaxf(mk, sk);
        }
        mq = fmaxf(mq, __shfl_xor(mq, 16)); mq = fmaxf(mq, __shfl_xor(mq, 32)); mk = fmaxf(mk, __shfl_xor(mk, 16)); mk = fmaxf(mk, __shfl_xor(mk, 32));
        if ((tid & 63) < 16) { unsigned* nr = (unsigned*)(ws + WS_NRM) + (layer * 16 + h) * 2; atomicMax(nr, __float_as_uint(mq)); atomicMax(nr + 1, __float_as_uint(mk)); }
    }
}

__device__ __forceinline__ void cmp2_phase(KP p, LAS unsigned char* lds) {
    int tid_ = threadIdx.x; asm volatile("" : "+v"(tid_));
    const int tid = tid_; unsigned char* ws = p->ws;
    const int rr = tid >> 7, d = tid & 127;
    LAS float* hid = (LAS float*)lds;
    for (int it = blockIdx.x; it < 2 * 1024; it += gridDim.x) {
        const int mat = it >> 10, row0 = (it & 1023) * 4;
        const float* part = (const float*)(ws + WS_CPART) + (size_t)mat * 8 * 4096 * 256; const float* cb = (const float*)(ws + WS_CB) + mat * 256;
        __syncthreads();
#pragma unroll
        for (int i = 0; i < 2; ++i) { const int e = tid + 512 * i, r_ = e >> 8, k = e & 255; float s = cb[k];
#pragma unroll
            for (int c = 0; c < 8; ++c) s += part[((size_t)c * 4096 + row0 + r_) * 256 + k];
            hid[e] = gelu_tanh_f(s); }
        __syncthreads();
        const int row = row0 + rr;
        const float* w2 = p->in[mat ? I_CV2 : I_CK2];
        float s = 0.f;
#pragma unroll 8
        for (int k = 0; k < 256; ++k) s += hid[rr * 256 + k] * w2[k * 128 + d];
        if ((row & 1023) == 1023) s = 0.f;
        ((bf16_t*)(ws + (mat ? WS_VC : WS_KC)))[(size_t)row * 128 + d] = (bf16_t)f2bf(s);
    }
}

#define KSWZ(row, colB) ((row) * 256 + ((colB) ^ (((row) & 7) << 4)))
#define SBAR() __builtin_amdgcn_sched_barrier(0)
__device__ __forceinline__ int v_st(int k, int c) { const int kk = (k & ~0xC) | ((k & 4) << 1) | ((k & 8) >> 1); return ((kk >> 3) * 4 + (c >> 5)) * 512 + ((kk & 7) * 32 + (c & 31)) * 2; }
__device__ __forceinline__ int v_rd_base(int lane) { return ((lane & 3) << 3) | (((lane >> 2) & 3) << 6) | (((lane >> 4) & 1) << 5) | (((lane >> 5) & 1) << 8); }
constexpr int v_rd_off(int d0, int ks, int half) { return d0 * 512 + ks * 4096 + half * 2048; }
__device__ __forceinline__ int crow(int r, int hi) { return (r & 3) + 8 * (r >> 2) + 4 * hi; }

__device__ __forceinline__ void qkt(f32x16& p0, f32x16& p1, const LAS unsigned char* Kb, int r32, int hi, const bf16x8* qr) {
#pragma unroll
    for (int r = 0; r < 16; ++r) { p0[r] = 0.f; p1[r] = 0.f; }
    const LAS unsigned char* kb[4];
#pragma unroll
    for (int dd = 0; dd < 4; ++dd) kb[dd] = Kb + KSWZ(r32, (dd * 16 + hi * 8) * 2);
#pragma unroll
    for (int d0 = 0; d0 < 8; ++d0) { const LAS unsigned char* a = kb[d0 & 3] + (d0 >> 2) * 128;
        const bf16x8 b0 = *(const LAS bf16x8*)a;
        const bf16x8 b1 = *(const LAS bf16x8*)(a + 32 * 256);
        p0 = __builtin_amdgcn_mfma_f32_32x32x16_bf16(b0, qr[d0], p0, 0, 0, 0);
        p1 = __builtin_amdgcn_mfma_f32_32x32x16_bf16(b1, qr[d0], p1, 0, 0, 0); }
}
__device__ __forceinline__ void pv_tile(f32x16* o, int vb, bf16x8 pa0, bf16x8 pa1, bf16x8 pa2, bf16x8 pa3) {
#define TRRD(dst, off) asm volatile("ds_read_b64_tr_b16 %0, %1 offset:%2" : "=&v"(dst) : "v"(vb), "i"(off) : "memory")
#define PV_D0(d0) do { s16x4 l0, l1, l2, l3, h0, h1, h2, h3; constexpr int b_ = v_rd_off(d0, 0, 0); \
        TRRD(l0, b_); TRRD(h0, b_ + 2048); TRRD(l1, b_ + 4096); TRRD(h1, b_ + 6144); TRRD(l2, b_ + 8192); TRRD(h2, b_ + 10240); TRRD(l3, b_ + 12288); TRRD(h3, b_ + 14336); \
        asm volatile("s_waitcnt lgkmcnt(0)" ::: "memory"); SBAR(); \
        o[d0] = __builtin_amdgcn_mfma_f32_32x32x16_bf16(pa0, (bf16x8){l0[0], l0[1], l0[2], l0[3], h0[0], h0[1], h0[2], h0[3]}, o[d0], 0, 0, 0);   \
        o[d0] = __builtin_amdgcn_mfma_f32_32x32x16_bf16(pa1, (bf16x8){l1[0], l1[1], l1[2], l1[3], h1[0], h1[1], h1[2], h1[3]}, o[d0], 0, 0, 0);   \
        o[d0] = __builtin_amdgcn_mfma_f32_32x32x16_bf16(pa2, (bf16x8){l2[0], l2[1], l2[2], l2[3], h2[0], h2[1], h2[2], h2[3]}, o[d0], 0, 0, 0);   \
        o[d0] = __builtin_amdgcn_mfma_f32_32x32x16_bf16(pa3, (bf16x8){l3[0], l3[1], l3[2], l3[3], h3[0], h3[1], h3[2], h3[3]}, o[d0], 0, 0, 0); } while (0)
    PV_D0(0); PV_D0(1); PV_D0(2); PV_D0(3);
#undef PV_D0
#undef TRRD
}
__device__ __forceinline__ void p_to_frags(const f32x16& p0, const f32x16& p1, bf16x8& pa0, bf16x8& pa1, bf16x8& pa2, bf16x8& pa3) {
#define PK4(P, B_, OUT) do { unsigned a0 = cvt_pk_bf16(P[B_+0], P[B_+1]), a1 = cvt_pk_bf16(P[B_+2], P[B_+3]);                          \
        unsigned b0 = cvt_pk_bf16(P[B_+4], P[B_+5]), b1 = cvt_pk_bf16(P[B_+6], P[B_+7]);                                             \
        auto r0 = __builtin_amdgcn_permlane32_swap(a0, b0, false, false); auto r1 = __builtin_amdgcn_permlane32_swap(a1, b1, false, false); \
        u32x4 w = {r0[0], r1[0], r0[1], r1[1]}; OUT = *reinterpret_cast<bf16x8*>(&w); } while (0)
    PK4(p0, 0, pa0); PK4(p0, 8, pa1); PK4(p1, 0, pa2); PK4(p1, 8, pa3);
#undef PK4
}
__device__ __forceinline__ float half_swap_max(float v) { auto rr = __builtin_amdgcn_permlane32_swap(__float_as_uint(v), __float_as_uint(v), false, false); return fmaxf(__uint_as_float(rr[0]), __uint_as_float(rr[1])); }
__device__ __forceinline__ float half_swap_sum(float v) { auto rr = __builtin_amdgcn_permlane32_swap(__float_as_uint(v), __float_as_uint(v), false, false); return __uint_as_float(rr[0]) + __uint_as_float(rr[1]); }
__device__ __forceinline__ float online_sm(f32x16& p0, f32x16& p1, float& m, float& l) {
    float pmax = p0[0];
#pragma unroll
    for (int r = 1; r < 16; ++r) pmax = fmaxf(pmax, p0[r]);
#pragma unroll
    for (int r = 0; r < 16; ++r) pmax = fmaxf(pmax, p1[r]);
    pmax = half_swap_max(pmax);
    float mn = m, alpha = 1.f;
    if (!__all(pmax <= m + 8.f)) { mn = fmaxf(m, pmax); alpha = __builtin_amdgcn_exp2f((m - mn) * L2E); m = mn; }
    const float mnL = -mn * L2E; float ps = 0.f;
#pragma unroll
    for (int r = 0; r < 16; ++r) { p0[r] = __builtin_amdgcn_exp2f(fmaf(p0[r], L2E, mnL)); p1[r] = __builtin_amdgcn_exp2f(fmaf(p1[r], L2E, mnL)); ps += p0[r] + p1[r]; }
    ps = half_swap_sum(ps);
    l = l * alpha + ps;
    return alpha;
}

struct FL {
    const bf16_t* K; const bf16_t* V; int kstride, vstride;
    int j_lo, j_hi;
    const float* cum; float cq;
    int t_lane, t_w0;
    const LAS float* lut;
    __half* imp;
};
template <int MODE>
__device__ __forceinline__ void flash_loop(LAS unsigned char* lds, const FL& a, const bf16x8* qr, float& m, float& l, f32x16* o, float inv_l) {
    int tid_ = threadIdx.x; asm volatile("" : "+v"(tid_));
    const int tid = tid_, wid = __builtin_amdgcn_readfirstlane(tid >> 6), lane = tid & 63, r32 = lane & 31, hi = lane >> 5;
    LAS unsigned char* V_lds = lds + L_V; LAS unsigned char* K_lds = lds + L_K;
    LAS float* al_l = (LAS float*)(lds + L_WS) + wid * 64 + 32;
    LAS float* ckb = (LAS float*)(lds + L_CK);
    const int sr = tid >> 4, sc = (tid & 15) * 8, vst0 = v_st(sr, sc), vst1 = v_st(32 + sr, sc), kws = KSWZ(sr, sc * 2);
    const int vb0 = (int)(size_t)V_lds + v_rd_base(lane);
    constexpr bool HASV = (MODE != 1);
    bf16x8 sk0, sk1, sv0, sv1; float sck = 0.f;
    const float NEG = -__builtin_inff();
    float carry = 0.f;
#define FL_LOAD(j) do { const int kb_ = (j) * 64; \
        sk0 = *(const bf16x8*)(a.K + (size_t)(kb_ + sr) * a.kstride + sc); sk1 = *(const bf16x8*)(a.K + (size_t)(kb_ + 32 + sr) * a.kstride + sc); \
        if (HASV) { sv0 = *(const bf16x8*)(a.V + (size_t)(kb_ + sr) * a.vstride + sc); sv1 = *(const bf16x8*)(a.V + (size_t)(kb_ + 32 + sr) * a.vstride + sc); } \
        if (MODE == 0) { if (tid < 64) sck = a.cum[kb_ + tid]; } } while (0)
#define FL_WRITE(buf) do { *(LAS bf16x8*)(K_lds + (buf) * SHM_K + kws) = sk0; *(LAS bf16x8*)(K_lds + (buf) * SHM_K + kws + 32 * 256) = sk1; \
        if (HASV) { *(LAS bf16x8*)(V_lds + (buf) * SHM_V + vst0) = sv0; *(LAS bf16x8*)(V_lds + (buf) * SHM_V + vst1) = sv1; } \
        if (MODE == 0) { if (tid < 64) ckb[(buf) * 64 + tid] = sck; } } while (0)
    __syncthreads();
    FL_LOAD(a.j_lo); FL_WRITE(0); __syncthreads();
#pragma nounroll
    for (int j = a.j_lo; j < a.j_hi; ++j) {
        const int buf = (j - a.j_lo) & 1; const int kb = j * 64;
        if (j + 1 < a.j_hi) FL_LOAD(j + 1);
        const bool act = (MODE != 0) || (kb <= a.t_w0 + 31);
        if (act) {
            f32x16 p0, p1;
            qkt(p0, p1, K_lds + buf * SHM_K, r32, hi, qr);
            if (MODE == 0) {
#pragma unroll
                for (int i = 0; i < 4; ++i) { const f32x4 c0 = *(const LAS f32x4*)(ckb + buf * 64 + 4 * hi + 8 * i), c1 = *(const LAS f32x4*)(ckb + buf * 64 + 32 + 4 * hi + 8 * i);
#pragma unroll
                    for (int e = 0; e < 4; ++e) { p0[4 * i + e] += a.cq - c0[e]; p1[4 * i + e] += a.cq - c1[e]; } }
                if (kb + 63 > a.t_w0) { const int dq = a.t_lane - kb - 4 * hi;
#pragma unroll
                    for (int r = 0; r < 16; ++r) { const int c = (r & 3) + 8 * (r >> 2); if (dq - c < 0) p0[r] = NEG; if (dq - c - 32 < 0) p1[r] = NEG; } }
            } else if (MODE == 1 || MODE == 2) {
                const int dq = a.t_lane - 16 * kb - 31 - 64 * hi;
#pragma unroll
                for (int r = 0; r < 16; ++r) { const int d0_ = dq - 16 * (r & 3) - 128 * (r >> 2), d1_ = d0_ - 512;
                    const unsigned i0 = (unsigned)d0_ < 2047u ? (unsigned)d0_ : 2047u, i1 = (unsigned)d1_ < 2047u ? (unsigned)d1_ : 2047u;
                    const float b0 = a.lut[i0], b1 = a.lut[i1];
                    p0[r] = d0_ >= 0 ? p0[r] + b0 : NEG; p1[r] = d1_ >= 0 ? p1[r] + b1 : NEG; }
            } else {
                const int dq = a.t_lane - kb - 4 * hi;
#pragma unroll
                for (int r = 0; r < 16; ++r) { const int d0_ = dq - ((r & 3) + 8 * (r >> 2)), d1_ = d0_ - 32;
                    const unsigned i0 = (unsigned)d0_ < 2047u ? (unsigned)d0_ : 2047u, i1 = (unsigned)d1_ < 2047u ? (unsigned)d1_ : 2047u;
                    const float b0 = a.lut[i0], b1 = a.lut[i1];
                    p0[r] = (unsigned)d0_ < 512u ? p0[r] + b0 : NEG; p1[r] = (unsigned)d1_ < 512u ? p1[r] + b1 : NEG; }
            }
            if (MODE == 1) { (void)online_sm(p0, p1, m, l); }
            else if (MODE == 2) {
                const float mnL = -m * L2E;
#pragma unroll
                for (int r = 0; r < 16; ++r) { p0[r] = __builtin_amdgcn_exp2f(fmaf(p0[r], L2E, mnL)) * inv_l; p1[r] = __builtin_amdgcn_exp2f(fmaf(p1[r], L2E, mnL)) * inv_l; }
                float a0[4], a1[4], x0[4], x1[4];
#pragma unroll
                for (int i = 0; i < 4; ++i) { a0[i] = (p0[4 * i] + p0[4 * i + 1]) + (p0[4 * i + 2] + p0[4 * i + 3]); a1[i] = (p1[4 * i] + p1[4 * i + 1]) + (p1[4 * i + 2] + p1[4 * i + 3]);
                    x0[i] = __shfl_xor(p0[4 * i + 3], 32); x1[i] = __shfl_xor(p1[4 * i + 3], 32); }
                __half* ip = a.imp + 16 * j + hi;
#pragma unroll
                for (int i = 0; i < 4; ++i) { const float e0 = hi ? x0[i] : (i ? x0[i > 0 ? i - 1 : 0] : carry); const float e1 = hi ? x1[i] : (i ? x1[i > 0 ? i - 1 : 0] : x0[3]);
                    ip[2 * i] = __float2half(a0[i] + e0); ip[8 + 2 * i] = __float2half(a1[i] + e1); }
                carry = x1[3];
                bf16x8 pa0, pa1, pa2, pa3; p_to_frags(p0, p1, pa0, pa1, pa2, pa3);
                pv_tile(o, vb0 + buf * SHM_V, pa0, pa1, pa2, pa3);
            } else {
                const float alpha = online_sm(p0, p1, m, l);
                if (__any(alpha < 1.f)) { if (hi == 0) al_l[r32] = alpha; asm volatile("s_waitcnt lgkmcnt(0)" ::: "memory");
#pragma unroll
                    for (int d_ = 0; d_ < 4; ++d_)
#pragma unroll
                        for (int r = 0; r < 16; ++r) o[d_][r] *= al_l[crow(r, hi)]; }
                bf16x8 pa0, pa1, pa2, pa3; p_to_frags(p0, p1, pa0, pa1, pa2, pa3);
                pv_tile(o, vb0 + buf * SHM_V, pa0, pa1, pa2, pa3);
            }
        }
        if (j + 1 < a.j_hi) FL_WRITE(buf ^ 1);
        __syncthreads();
    }
#undef FL_LOAD
#undef FL_WRITE
}

__device__ __forceinline__ void fox_attn_phase(KP p, LAS unsigned char* lds, int layer) {
    const int wid = __builtin_amdgcn_readfirstlane(threadIdx.x >> 6);
    unsigned char* ws = p->ws;
    const bf16_t* Q = (const bf16_t*)(ws + WS_A); const bf16_t* K = Q + (size_t)S_ * DM; const bf16_t* V = K + (size_t)S_ * DM; bf16_t* O = (bf16_t*)(V + (size_t)S_ * DM);
    const float* cumall = (const float*)(ws + WS_CUM);
    const unsigned* nrm = (const unsigned*)(ws + WS_NRM) + layer * 32;
    LAS float* li_l = (LAS float*)(lds + L_WS) + wid * 64;
    LAS int* jl = (LAS int*)(lds + L_CK + 1024);
    for (int I = blockIdx.x; I < 1024; I += gridDim.x) {
        const int kk = I >> 8, qbi = (I >> 4) & 63, h = ((I & 15) + 5 * kk) & 15;
        const int c_ = qbi & 15; const int qb = kk == 0 ? 63 - c_ : (kk == 1 ? c_ : (kk == 2 ? 47 - c_ : 16 + c_));
        {
            int tid_ = threadIdx.x; asm volatile("" : "+v"(tid_));
            const int lane = tid_ & 63, r32 = lane & 31, hi = lane >> 5;
            const int t_w0 = qb * 256 + wid * 32, t_lane = t_w0 + r32;
            const float* cum = cumall + (size_t)h * S_;
            const float B2 = 2.f * sqrtf(__uint_as_float(nrm[h * 2]) * __uint_as_float(nrm[h * 2 + 1])) * 1.01f;
            const float T = cum[qb * 256] + 110.f + B2;
            __syncthreads();
            { const bool ok = (tid_ < qb * 4 + 4) && (cum[64 * (tid_ < 256 ? tid_ : 0) + 63] <= T);
              const unsigned long long bm = __ballot(ok);
              if (lane == 0) jl[wid] = bm ? wid * 64 + (__ffsll((long long)bm) - 1) : (1 << 30); }
            __syncthreads();
            int j_lo = jl[0];
#pragma unroll
            for (int w = 1; w < 8; ++w) j_lo = min(j_lo, jl[w]);
            j_lo = __builtin_amdgcn_readfirstlane(j_lo);
            if (j_lo > qb * 4) j_lo = qb * 4;
            bf16x8 qr[8];
#pragma unroll
            for (int d0 = 0; d0 < 8; ++d0) qr[d0] = *(const bf16x8*)(Q + (size_t)t_lane * DM + h * 128 + d0 * 16 + hi * 8);
            FL a; a.K = K + h * 128; a.V = V + h * 128; a.kstride = DM; a.vstride = DM; a.j_lo = j_lo; a.j_hi = qb * 4 + 4;
            a.cum = cum; a.cq = cum[t_lane]; a.t_lane = t_lane; a.t_w0 = t_w0; a.lut = nullptr; a.imp = nullptr;
            float m = -1e30f, l = 0.f; f32x16 o[4];
#pragma unroll
            for (int d_ = 0; d_ < 4; ++d_)
#pragma unroll
                for (int r = 0; r < 16; ++r) o[d_][r] = 0.f;
            flash_loop<0>(lds, a, qr, m, l, o, 0.f);
            if (hi == 0) li_l[r32] = l; asm volatile("s_waitcnt lgkmcnt(0)" ::: "memory");
            bf16_t* Ow = O + (size_t)t_w0 * DM + h * 128;
            int lo_ = 4 * hi * DM + r32; asm volatile("" : "+v"(lo_));
#pragma unroll
            for (int r = 0; r < 16; ++r) { const int orow = crow(r, hi); const float rli = __builtin_amdgcn_rcpf(li_l[orow]);
#pragma unroll
                for (int d0 = 0; d0 < 4; ++d0) { const float v = o[d0][r] * rli; const float vn = __shfl_xor(v, 1);
                    if ((r32 & 1) == 0) *(unsigned*)(Ow + (lo_ + ((r & 3) + 8 * (r >> 2)) * DM + d0 * 32)) = cvt_pk_bf16(v, vn); } }
        }
    }
}

__device__ __forceinline__ void nsa_attn_phase(KP p, LAS unsigned char* lds) {
    const int tid = threadIdx.x, wid = __builtin_amdgcn_readfirstlane(tid >> 6);
    unsigned char* ws = p->ws;
    const bf16_t* Q = (const bf16_t*)(ws + WS_A); bf16_t* attn = (bf16_t*)(ws + WS_A) + (size_t)S_ * DM; __half* imp = (__half*)(ws + WS_A + 128 * MiB);
    float* partial = (float*)(ws + WS_PRE); const float* gates = (const float*)(ws + WS_GATE);
    const bf16_t* kv = (const bf16_t*)(ws + WS_KV); const bf16_t* kc = (const bf16_t*)(ws + WS_KC); const bf16_t* vc = (const bf16_t*)(ws + WS_VC);
    const bf16_t* vt = (const bf16_t*)(ws + WS_VT); const bf16_t* kfr = (const bf16_t*)(ws + WS_KF); const float* lutg = (const float*)(ws + WS_LUT);
    LAS float* lut = (LAS float*)(lds + L_LUT);
    LAS float* li_l = (LAS float*)(lds + L_WS) + wid * 64;
    const float NEG = -__builtin_inff();
    int g_loaded = -1;
    for (int it = blockIdx.x; it < 1024; it += gridDim.x) {
        const int g = it & 3, tile = 2 * (it >> 3) + ((it >> 2) & 1);
        if (g != g_loaded) {
            __syncthreads();
            for (int i = tid; i < 4 * 2048; i += 512) lut[i] = lutg[g * 4 * 2048 + i];
            __syncthreads();
            g_loaded = g;
        }
        {
            const int t0 = tile * 64;
            {
                const int r = wid & 3, th = wid >> 2, h = g * 4 + r;
                int tid_ = threadIdx.x; asm volatile("" : "+v"(tid_));
                const int lane = tid_ & 63, r32 = lane & 31, hi = lane >> 5;
                const int t_w0 = t0 + 32 * th, t_lane = t_w0 + r32;
                bf16x8 qr[8];
#pragma unroll
                for (int d0 = 0; d0 < 8; ++d0) qr[d0] = *(const bf16x8*)(Q + (size_t)t_lane * DM + h * 128 + d0 * 16 + hi * 8);
                const float g0 = gates[(size_t)t_lane * 48 + h * 3 + 0], g2 = gates[(size_t)t_lane * 48 + h * 3 + 2];
                FL a; a.K = kc + (size_t)g * 1024 * 128; a.V = vc + (size_t)g * 1024 * 128; a.kstride = 128; a.vstride = 128; a.j_lo = 0; a.j_hi = (t0 / 16 + 2) / 64 + 1;
                a.cum = nullptr; a.cq = 0.f; a.t_lane = t_lane; a.t_w0 = t_w0; a.lut = lut + r * 2048; a.imp = imp + ((size_t)h * S_ + t_lane) * 256;
                float m = -1e30f, l = 0.f; f32x16 o[4];
#pragma unroll
                for (int d_ = 0; d_ < 4; ++d_)
#pragma unroll
                    for (int rr = 0; rr < 16; ++rr) o[d_][rr] = 0.f;
                flash_loop<1>(lds, a, qr, m, l, o, 0.f);
                const float inv_l = l > 0.f ? 1.f / l : 0.f;
                flash_loop<2>(lds, a, qr, m, l, o, inv_l);
                float* Pw = partial + (size_t)t_w0 * DM + h * 128;
                int lo_ = 4 * hi * DM + r32; asm volatile("" : "+v"(lo_));
                if (hi == 0) li_l[r32] = g0; asm volatile("s_waitcnt lgkmcnt(0)" ::: "memory");
#pragma unroll
                for (int rr = 0; rr < 16; ++rr) { const int orow = crow(rr, hi); const float f = li_l[orow];
#pragma unroll
                    for (int d0 = 0; d0 < 4; ++d0) Pw[lo_ + ((rr & 3) + 8 * (rr >> 2)) * DM + d0 * 32] = o[d0][rr] * f; }
                a.K = kv + 4 * 512 + g * 128; a.V = kv + 5 * 512 + g * 128; a.kstride = NKV; a.vstride = NKV; a.j_lo = tile >= 8 ? tile - 8 : 0; a.j_hi = tile + 1;
                m = -1e30f; l = 0.f;
#pragma unroll
                for (int d_ = 0; d_ < 4; ++d_)
#pragma unroll
                    for (int rr = 0; rr < 16; ++rr) o[d_][rr] = 0.f;
                flash_loop<3>(lds, a, qr, m, l, o, 0.f);
                asm volatile("s_waitcnt lgkmcnt(0)" ::: "memory");
                int lo2_ = 4 * hi * DM + r32; asm volatile("" : "+v"(lo2_));
                if (hi == 0) li_l[r32] = g2 * (l > 0.f ? 1.f / l : 0.f); asm volatile("s_waitcnt lgkmcnt(0)" ::: "memory");
#pragma unroll
                for (int rr = 0; rr < 16; ++rr) { const int orow = crow(rr, hi); const float f = li_l[orow];
#pragma unroll
                    for (int d0 = 0; d0 < 4; ++d0) { float* pp = Pw + (lo2_ + ((rr & 3) + 8 * (rr >> 2)) * DM + d0 * 32); *pp = *pp + o[d0][rr] * f; } }
            }
            __syncthreads();
            const int nf = tile >= 2 ? 3 : tile + 1;
            {
                int tid_ = threadIdx.x; asm volatile("" : "+v"(tid_));
#pragma nounroll
                for (int s_ = 0; s_ < nf; ++s_) { const int id = s_ == 0 ? 0 : (s_ == nf - 1 ? tile : tile - 1); const int base = s_ == 0 ? 0 : (s_ == 1 ? 32768 : L_END);
                    const u32x4* ks_ = (const u32x4*)(kfr + ((size_t)g * 256 + id) * 8192); const u32x4* vs_ = (const u32x4*)(vt + ((size_t)g * 256 + id) * 8192);
                    u32x4 tk[2], tv[2];
#pragma unroll
                    for (int i = 0; i < 2; ++i) { tk[i] = ks_[tid_ + 512 * i]; tv[i] = vs_[tid_ + 512 * i]; }
#pragma unroll
                    for (int i = 0; i < 2; ++i) { *(LAS u32x4*)(lds + base + (tid_ + 512 * i) * 16) = tk[i]; *(LAS u32x4*)(lds + base + 16384 + (tid_ + 512 * i) * 16) = tv[i]; } }
            }
            __syncthreads();
            {
#pragma nounroll
                for (int tt = 0; tt < 8; ++tt) {
                    int tid_ = threadIdx.x; asm volatile("" : "+v"(tid_));
                    const int lane = tid_ & 63;
                    const int n = lane & 15, kq = lane >> 4, hn = n & 3; const bool hv = n < 4;
                    const LAS float* lutn = lut + hn * 2048;
                    const int t = t0 + 8 * wid + tt; const int blk = tile;
                    float sc[4] = {0.f, 0.f, 0.f, 0.f};
#pragma unroll
                    for (int r = 0; r < 4; ++r) { const u32x2 raw = *(const u32x2*)(imp + ((size_t)(g * 4 + r) * S_ + t) * 256 + lane * 4);
                        sc[0] += __half2float(__ushort_as_half((unsigned short)(raw.x & 0xffffu))); sc[1] += __half2float(__ushort_as_half((unsigned short)(raw.x >> 16)));
                        sc[2] += __half2float(__ushort_as_half((unsigned short)(raw.y & 0xffffu))); sc[3] += __half2float(__ushort_as_half((unsigned short)(raw.y >> 16))); }
#pragma unroll
                    for (int e = 0; e < 4; ++e) { const int j = lane * 4 + e; const bool forced = (j == 0) | (j == blk) | (j == blk - 1);
                        sc[e] = forced ? 1e4f : (j <= blk ? sc[e] : -1.f); }
                    int mysel = -1;
#pragma nounroll
                    for (int k = 0; k < 16; ++k) {
                        float bv = sc[0]; int be = 0;
#pragma unroll
                        for (int e = 1; e < 4; ++e) if (sc[e] > bv) { bv = sc[e]; be = e; }
                        const float wmax = wave_max_fast(bv);
                        if (wmax < 0.f) break;
                        const unsigned long long msk = __ballot(bv == wmax);
                        const int src = __ffsll((long long)msk) - 1;
                        const int jw = __builtin_amdgcn_readlane(lane * 4 + be, src);
                        if (lane == k) mysel = jw;
                        if (lane == src) {
#pragma unroll
                            for (int e = 0; e < 4; ++e) if (be == e) sc[e] = -2.f; }
                    }
                    bf16x8 qb[4];
#pragma unroll
                    for (int ks = 0; ks < 4; ++ks) { qb[ks] = *(const bf16x8*)(Q + (size_t)t * DM + (g * 4 + hn) * 128 + 32 * ks + kq * 8);
                        if (!hv) qb[ks] = (bf16x8){0, 0, 0, 0, 0, 0, 0, 0}; }
                    float m = -1e30f, l = 0.f; f32x4 o[8];
#pragma unroll
                    for (int d_ = 0; d_ < 8; ++d_) o[d_] = (f32x4){0.f, 0.f, 0.f, 0.f};
                    const int nsel = __builtin_popcountll(__ballot(mysel >= 0));
                    bf16x8 kf[16], vf[16];
                    const bf16_t* Kg = kfr + (size_t)g * 256 * 8192 + lane * 8;
                    const bf16_t* Vg = vt + (size_t)g * 256 * 8192 + lane * 8;
#define SEL_QK() f32x4 s[4]; _Pragma("unroll") for (int sub = 0; sub < 4; ++sub) { s[sub] = (f32x4){0.f, 0.f, 0.f, 0.f}; \
                            _Pragma("unroll") for (int ks = 0; ks < 4; ++ks) s[sub] = __builtin_amdgcn_mfma_f32_16x16x32_bf16(kf[sub * 4 + ks], qb[ks], s[sub], 0, 0, 0); }
#define SEL_SM_PV(sb_) { const int dq = t - (sb_) * 64 - 4 * kq; float pmax = NEG; \
                        _Pragma("unroll") for (int sub = 0; sub < 4; ++sub) _Pragma("unroll") for (int i = 0; i < 4; ++i) { const int d = dq - 16 * sub - i; const unsigned idx = (unsigned)d < 2047u ? (unsigned)d : 2047u; \
                                const float v = d >= 0 ? s[sub][i] + lutn[idx] : NEG; s[sub][i] = v; pmax = fmaxf(pmax, v); } \
                        if (!__all(pmax <= m + 8.f)) {     \
                            pmax = fmaxf(pmax, __shfl_xor(pmax, 16)); pmax = fmaxf(pmax, __shfl_xor(pmax, 32)); \
                            const float mn = fmaxf(m, pmax); const float alpha = __builtin_amdgcn_exp2f((m - mn) * L2E); m = mn; l *= alpha; \
                            _Pragma("unroll") for (int d_ = 0; d_ < 8; ++d_) o[d_] = o[d_] * alpha; } \
                        const float mnL = -m * L2E; float ps = 0.f; \
                        _Pragma("unroll") for (int sub = 0; sub < 4; ++sub) _Pragma("unroll") for (int i = 0; i < 4; ++i) { s[sub][i] = __builtin_amdgcn_exp2f(fmaf(s[sub][i], L2E, mnL)); ps += s[sub][i]; } \
                        l += ps; \
                        bf16x8 pb[2]; { const u32x4 w0 = pack8bf(s[0], s[1]), w1 = pack8bf(s[2], s[3]); pb[0] = *reinterpret_cast<const bf16x8*>(&w0); pb[1] = *reinterpret_cast<const bf16x8*>(&w1); } \
                        SBAR(); \
                        _Pragma("unroll") for (int d_ = 0; d_ < 8; ++d_) _Pragma("unroll") for (int s2 = 0; s2 < 2; ++s2) o[d_] = __builtin_amdgcn_mfma_f32_16x16x32_bf16(vf[d_ * 2 + s2], pb[s2], o[d_], 0, 0, 0); }
#pragma nounroll
                    for (int b = 0; b < nf; ++b) {
                        const int sb = b == 0 ? 0 : (b == nf - 1 ? tile : tile - 1);
                        const LAS unsigned char* fb = lds + (b == 0 ? 0 : (b == 1 ? 32768 : L_END)) + lane * 16;
#pragma unroll
                        for (int f = 0; f < 16; ++f) { kf[f] = *(const LAS bf16x8*)(fb + f * 1024); vf[f] = *(const LAS bf16x8*)(fb + 16384 + f * 1024); }
                        SEL_QK();
                        SEL_SM_PV(sb);
                    }
                    if (nsel > nf) {
                    int sb = __builtin_amdgcn_readfirstlane(__shfl(mysel, nf));
                    { const bf16_t* Kp = Kg + (size_t)sb * 8192;
#pragma unroll
                      for (int f = 0; f < 16; ++f) kf[f] = *(const bf16x8*)(Kp + f * 512); }
#pragma nounroll
                    for (int b = nf; b < nsel; ++b) {
                        const int sbn = __builtin_amdgcn_readfirstlane(__shfl(mysel, b + 1 < nsel ? b + 1 : b));
                        { const bf16_t* Vp = Vg + (size_t)sb * 8192;
#pragma unroll
                          for (int f = 0; f < 16; ++f) vf[f] = *(const bf16x8*)(Vp + f * 512); }
                        SBAR();
                        SEL_QK();
                        SBAR();
                        { const bf16_t* Kp = Kg + (size_t)sbn * 8192;
#pragma unroll
                          for (int f = 0; f < 16; ++f) kf[f] = *(const bf16x8*)(Kp + f * 512); }
                        SBAR();
                        SEL_SM_PV(sb);
                        sb = sbn;
                    }
                    }
#undef SEL_QK
#undef SEL_SM_PV
                    l += __shfl_xor(l, 16); l += __shfl_xor(l, 32);
                    const float g1 = gates[(size_t)t * 48 + (g * 4 + hn) * 3 + 1];
                    const float f = g1 * (l > 0.f ? 1.f / l : 0.f);
                    if (hv) {
#pragma unroll
                        for (int d_ = 0; d_ < 8; ++d_) { const size_t off = (size_t)t * DM + (g * 4 + n) * 128 + 16 * d_ + 4 * kq;
                            const f32x4 pp = *(const f32x4*)(partial + off); const f32x4 r4 = pp + o[d_] * f;
                            u32x2 w; w.x = cvt_pk_bf16(r4[0], r4[1]); w.y = cvt_pk_bf16(r4[2], r4[3]); *(u32x2*)(attn + off) = w; }
                    }
                }
            }
        }
    }
}

#define XB_TMO      128
#define XB_XCNT(j)  (256  + 64 * (j))
#define XB_XSUB(j)  (1280 + 64 * (j))
#define XB_XGEN(j)  (2304 + 64 * (j))
#define XB_TOP      3328
#define XB_TOPGEN   3392
#define XCD_BAR_WORDS 3456
#define XB_SPIN_CAP (1u << 18)
__device__ __forceinline__ unsigned xb_ld(unsigned* p)              { return __hip_atomic_load(p, __ATOMIC_RELAXED, __HIP_MEMORY_SCOPE_AGENT); }
__device__ __forceinline__ unsigned xb_add(unsigned* p, unsigned v) { return __hip_atomic_fetch_add(p, v, __ATOMIC_RELAXED, __HIP_MEMORY_SCOPE_AGENT); }
__device__ __forceinline__ unsigned xb_xcc_id() { return (unsigned)__builtin_amdgcn_s_getreg((3 << 11) | 20) & 0xFu; }
#define XB_SPIN(cond, bar) do { unsigned _sp = 0; while (cond) { __builtin_amdgcn_s_sleep(1); \
    if ((++_sp & 255u) == 0u) { if (xb_ld(&(bar)[XB_TMO])) break; if (_sp > XB_SPIN_CAP) { atomicAdd(&(bar)[XB_TMO], 1u); break; } } } } while (0)

struct XcdBarrier {
    unsigned* bar; unsigned x;
    volatile LAS unsigned* st;
};

__device__ __forceinline__ XcdBarrier xcd_barrier_post(unsigned* bar, volatile LAS unsigned* st) {
    XcdBarrier b; b.bar = bar; b.x = xb_xcc_id(); b.st = st;
    if (threadIdx.x == 0) (void)xb_add(&bar[XB_XCNT(b.x)], 1u);
    return b;
}
__device__ __forceinline__ void xcd_barrier_complete(unsigned* bar, unsigned x, unsigned& nloc, unsigned& nx) {
    const unsigned G = gridDim.x * gridDim.y * gridDim.z;
    unsigned sum, cnt, mine, sp = 0u;
    for (;;) {
        sum = 0u; cnt = 0u; mine = 0u;
#pragma unroll
        for (unsigned j = 0; j < 16; ++j) { const unsigned c = xb_ld(&bar[XB_XCNT(j)]); sum += c; cnt += (c > 0u) ? 1u : 0u; mine = (j == x) ? c : mine; }
        if (sum == G) break;
        __builtin_amdgcn_s_sleep(1);
        if ((++sp & 255u) == 0u) { if (xb_ld(&bar[XB_TMO])) break; if (sp > XB_SPIN_CAP) { atomicAdd(&bar[XB_TMO], 1u); break; } }
    }
    nloc = mine > 0u ? mine : 1u; nx = cnt > 0u ? cnt : 1u;
}

__device__ __forceinline__ void xcd_barrier(const XcdBarrier& b) {
    asm volatile("s_waitcnt vmcnt(0)" ::: "memory");
    __syncthreads();
    if (threadIdx.x == 0) {
        unsigned* bar = b.bar;
        __builtin_amdgcn_s_waitcnt(0);
        unsigned nloc = b.st[0], nx = b.st[1];
        if (nloc == 0u) { xcd_barrier_complete(bar, b.x, nloc, nx); b.st[0] = nloc; b.st[1] = nx; }
        const unsigned old = xb_add(&bar[XB_XSUB(b.x)], 1u);
        const unsigned gen = old / nloc;
        if (old + 1u == (gen + 1u) * nloc) {
            __builtin_amdgcn_fence(__ATOMIC_RELEASE, "agent");
            asm volatile("s_waitcnt vmcnt(0)" ::: "memory");
            const unsigned og = xb_add(&bar[XB_TOP], 1u);
            const unsigned tg = og / nx;
            if (og + 1u == (tg + 1u) * nx) xb_add(&bar[XB_TOPGEN], 1u);
            else XB_SPIN(xb_ld(&bar[XB_TOPGEN]) == tg, bar);
            __builtin_amdgcn_fence(__ATOMIC_ACQUIRE, "agent");
            xb_add(&bar[XB_XGEN(b.x)], 1u);
            asm volatile("s_waitcnt vmcnt(0)" ::: "memory");
        } else {
            XB_SPIN(xb_ld(&bar[XB_XGEN(b.x)]) == gen, bar);
            __builtin_amdgcn_fence(__ATOMIC_ACQUIRE, "agent");
            asm volatile("s_waitcnt vmcnt(0)" ::: "memory");
        }
    }
    __syncthreads();
}


#define RUN_GEMM2(EpiT, epi, Aptr, Btptr, Mv, Nv, Kv, ldav, ldbv, cidx) do { const pg8::Gemm g_{(Aptr), (Btptr), (Mv), (Nv), (Kv), (ldav), (ldbv)}; pg8::StaticOrder so_; so_.init((Mv), (Nv), (int)gridDim.x, (cidx)); \
        pg8::gemm_phase<EpiT, pg8::StaticOrder, true, true>(lds, g_, so_, (epi)); } while (0)
#define RUN_GEMM(EpiT, epi, Aptr, Btptr, Mv, Nv, Kv, ldav, cidx) RUN_GEMM2(EpiT, epi, Aptr, Btptr, Mv, Nv, Kv, ldav, Kv, cidx)

__global__ void __launch_bounds__(512, 2) mega_fwd(Params p_unused) {
    extern __shared__ __attribute__((aligned(16))) unsigned char lds_raw[];
    LAS unsigned char* lds = (LAS unsigned char*)lds_raw;
    cg::grid_group grid = cg::this_grid();
    const size_t SD = (size_t)S_ * DM;
#define WSP(off) (KARGS()->ws + (off))
    LAS unsigned* bst = (LAS unsigned*)(lds + LDS_BYTES - 16);
    if (threadIdx.x < 4) bst[threadIdx.x] = 0u;
    __syncthreads();
    (void)xcd_barrier_post((unsigned*)(KARGS()->ws + WS_BAR), (volatile LAS unsigned*)bst);
#define GSYNC() do { XcdBarrier b_; b_.bar = (unsigned*)(KARGS()->ws + WS_BAR); b_.x = xb_xcc_id(); b_.st = (volatile LAS unsigned*)bst; xcd_barrier(b_); } while (0)
    prologue(KARGS(), lds);
    grid.sync();
#pragma nounroll
    for (int L = 0; L < 4; ++L) {
        const int bid = (int)blockIdx.x, G = (int)gridDim.x;
        if (L < 2) {
            { KP p = KARGS(); unsigned char* ws = p->ws; bf16_t* A0 = (bf16_t*)(ws + WS_A);
              EpiFoxQKV E{A0, (float*)(ws + WS_FLOG), p->in[I_FOXBF] + L * 16};
              RUN_GEMM(EpiFoxQKV, E, (const bf16_t*)(ws + WS_HBF), (const bf16_t*)(ws + WS_WFOXIN) + (size_t)L * NFOX * DM, S_, NFOX, DM, DM, bid); }
            GSYNC();
            scan_phase(KARGS(), lds, L == 0, L);
            GSYNC();
            fox_attn_phase(KARGS(), lds, L);
            GSYNC();
        } else {
            if (L == 2) {
                { KP p = KARGS(); unsigned char* ws = p->ws;
                  EpiKV E{(bf16_t*)(ws + WS_KV), (bf16_t*)(ws + WS_RAWK), (bf16_t*)(ws + WS_RAWV), (bf16_t*)(ws + WS_VT), (bf16_t*)(ws + WS_KF)};
                  RUN_GEMM(EpiKV, E, (const bf16_t*)(ws + WS_HBF), (const bf16_t*)(ws + WS_WKV), S_, NKV, DM, DM, bid); }
                GSYNC();
#pragma nounroll
                for (int idx = 0; idx < 16; ++idx) { KP p = KARGS(); unsigned char* ws = p->ws; const int mat = idx >> 3, ch = idx & 7;
                    EpiPart E{(float*)(ws + WS_CPART) + (size_t)idx * 4096 * 256};
                    RUN_GEMM2(EpiPart, E, (const bf16_t*)(ws + (mat ? WS_RAWV : WS_RAWK)) + ch * 512, (const bf16_t*)(ws + WS_WC1) + (size_t)mat * 256 * 4096 + ch * 512, 4096, 256, 512, 2048, 4096, (bid + G - 16 * idx) % G);
                }
                GSYNC();
                cmp2_phase(KARGS(), lds);
                GSYNC();
            }
            { KP p = KARGS(); unsigned char* ws = p->ws;
              EpiNsaQ E{(bf16_t*)(ws + WS_A), (float*)(ws + WS_GATE)};
              RUN_GEMM(EpiNsaQ, E, (const bf16_t*)(ws + WS_HBF), (const bf16_t*)(ws + WS_WNSAIN) + (size_t)(L - 2) * NNSA * DM, S_, NNSA, DM, DM, bid); }
            GSYNC();
            nsa_attn_phase(KARGS(), lds);
            GSYNC();
        }
        { KP p = KARGS(); unsigned char* ws = p->ws; bf16_t* A0 = (bf16_t*)(ws + WS_A);
          const float* hres = L == 0 ? p->in[I_X] : p->out;
          const bf16_t* attn = L < 2 ? A0 + 3 * SD : A0 + SD;
          const bf16_t* wo = L < 2 ? (const bf16_t*)(ws + WS_WFOXO) + (size_t)L * DM * DM : (const bf16_t*)(ws + WS_WNSAO) + (size_t)(L - 2) * DM * DM;
          EpiRes E{hres, (float*)(ws + WS_PRE)}; RUN_GEMM(EpiRes, E, attn, wo, S_, DM, DM, DM, bid); }
        GSYNC();
        { KP p = KARGS(); ln_phase((const float*)(p->ws + WS_PRE), p->in[I_LN1G] + L * DM, p->in[I_LN1B] + L * DM, p->out, (bf16_t*)(p->ws + WS_HBF)); }
        GSYNC();
        { KP p = KARGS(); unsigned char* ws = p->ws;
          EpiRelu2 E{(bf16_t*)(ws + WS_A)}; RUN_GEMM(EpiRelu2, E, (const bf16_t*)(ws + WS_HBF), (const bf16_t*)(ws + WS_W1) + (size_t)L * FF * DM, S_, FF, DM, DM, bid); }
        GSYNC();
        { KP p = KARGS(); unsigned char* ws = p->ws;
          EpiRes E{p->out, (float*)(ws + WS_PRE)}; RUN_GEMM(EpiRes, E, (const bf16_t*)(ws + WS_A), (const bf16_t*)(ws + WS_W2) + (size_t)L * DM * FF, S_, DM, FF, FF, bid); }
        GSYNC();
        { KP p = KARGS(); ln_phase((const float*)(p->ws + WS_PRE), p->in[I_LN2G] + L * DM, p->in[I_LN2B] + L * DM, p->out, (bf16_t*)(p->ws + WS_HBF)); }
        GSYNC();
    }
}

extern "C" void kernel_launch(void* const* d_in, const int* in_sizes, int n_in, void* d_out, int out_size, void* d_ws, size_t ws_size, hipStream_t stream) {
    static int grid = 0;
    if (grid == 0) {
        if (n_in != 20 || out_size != S_ * DM || ws_size < WS_END) { fprintf(stderr, "kernel_launch: unexpected shapes (n_in %d out %d ws %zu)\n", n_in, out_size, ws_size); grid = -1; return; }
        int dev = 0, cus = 0, per_cu = 0;
        (void)hipGetDevice(&dev); (void)hipDeviceGetAttribute(&cus, hipDeviceAttributeMultiprocessorCount, dev);
        if (hipFuncSetAttribute((const void*)mega_fwd, hipFuncAttributeMaxDynamicSharedMemorySize, LDS_BYTES) != hipSuccess) fprintf(stderr, "kernel_launch: hipFuncSetAttribute failed\n");
        if (hipOccupancyMaxActiveBlocksPerMultiprocessor(&per_cu, (const void*)mega_fwd, 512, LDS_BYTES) != hipSuccess || per_cu < 1) per_cu = 1;
        (void)hipGetLastError();
        if (cus <= 0) cus = 256;
        grid = cus * per_cu;
    }
    if (grid < 0) return;
    Params p{};
    for (int i = 0; i < 20; ++i) p.in[i] = (const float*)d_in[i];
    p.out = (float*)d_out; p.ws = (unsigned char*)d_ws;
    (void)hipMemsetAsync((unsigned char*)d_ws + WS_BAR, 0, 16384, stream);
    void* args[] = {&p};
    hipError_t e = hipLaunchCooperativeKernel((const void*)mega_fwd, dim3(grid), dim3(512), args, LDS_BYTES, stream);
    if (e != hipSuccess) fprintf(stderr, "kernel_launch: cooperative launch failed: %s (grid %d)\n", hipGetErrorString(e), grid);
}
```

```cpp
#include <hip/hip_runtime.h>
#include <hip/hip_cooperative_groups.h>
#include <hip/hip_fp16.h>
#include <cstdio>
#include <cstdint>
namespace cg = cooperative_groups;
namespace pg8 {
#define PG8_LAS __attribute__((address_space(3)))
typedef unsigned short bf16_t;
typedef short bf16x8 __attribute__((ext_vector_type(8)));
typedef float f32x4 __attribute__((ext_vector_type(4)));
typedef unsigned u32x4 __attribute__((ext_vector_type(4)));
constexpr int BM = 256, BK = 64, HALF = 128, HTB = HALF * BK * 2  , STAGE_BYTES = 8 * HTB, NXCD = 8, WGM = 8;

__host__ __device__ __forceinline__ int lds_byte(int r, int c) { const int st = (r >> 4) * 2 + (c >> 5), rr = r & 15, cc = c & 31, ob = rr * 64 + cc * 2; return st * 1024 + (ob ^ (((ob >> 9) & 1) << 5)); }
__host__ __device__ __forceinline__ void stage_rc(int b, int& R, int& C) { const int st = b / 1024, sb = b % 1024, swz = sb ^ (((sb >> 9) & 1) << 5); R = (st >> 1) * 16 + swz / 64; C = (st & 1) * 32 + (swz % 64) / 2; }
__host__ __device__ __forceinline__ int perm32(int rho) { const int n = rho >> 4, i = rho & 15; return 8 * (i >> 2) + 4 * n + (i & 3); }

struct Unit { int pm, pn; };
struct Gemm { const bf16_t* A; const bf16_t* Bt; int M, N, K, lda, ldb; };

struct StaticOrder {
    int nM, nN, nwg, G, c;
    __host__ __device__ void init(int M, int N, int G_, int c_) { nM = M / BM; nN = N / BM; nwg = nM * nN; G = G_; c = c_; }
    __host__ __device__ bool next(int i, Unit& u) const {
        const long L = (long)i * G + c; if (L >= nwg) return false;
        int wgid = (int)L; { const int q = nwg / NXCD, r = nwg % NXCD, xcd = wgid % NXCD, off = wgid / NXCD; wgid = (xcd < r ? xcd * (q + 1) : r * (q + 1) + (xcd - r) * q) + off; }
        const int nig = WGM * nN, gid = wgid / nig, fm = gid * WGM, gsz = (nM - fm) < WGM ? (nM - fm) : WGM;
        u.pm = fm + ((wgid % nig) % gsz); u.pn = (wgid % nig) / gsz; return true;
    }
    __device__ __forceinline__ void a_ready(const Unit&) const {}
    __device__ __forceinline__ void done(const Unit&) const {}
};


__device__ __forceinline__ unsigned cvt_pk_bf16(float lo, float hi) { unsigned r; asm volatile("v_cvt_pk_bf16_f32 %0, %1, %2" : "=v"(r) : "v"(lo), "v"(hi)); return r; }
typedef float f32x2 __attribute__((ext_vector_type(2)));
template <class Epi, class Sched, bool ALIGN_EPI = false, bool SP2 = false>
__device__ __forceinline__ void gemm_phase(PG8_LAS unsigned char* lds, const Gemm g, const Sched& S, const Epi& E) {
    int tid_ = threadIdx.x; asm volatile("" : "+v"(tid_));
    const int tid = tid_, wid = __builtin_amdgcn_readfirstlane(tid >> 6), lane = tid & 63, wr = wid >> 2, wc = wid & 3, fr = lane & 15, fq = lane >> 4;
    const int K = g.K, nt = K / BK;
    unsigned voffA[2], voffB[2];
#pragma unroll
    for (int i = 0; i < 2; ++i) { int R, C; stage_rc(tid * 16 + i * 8192, R, C); const int Rb = Epi::PERM ? ((R & ~31) + perm32(R & 31)) : R;
        voffA[i] = (unsigned)(R * g.lda + C) * 2u; voffB[i] = (unsigned)(Rb * g.ldb + C) * 2u; }
    const size_t kstep = (size_t)(BK * 2);
    const size_t hstepB = (size_t)HALF * g.ldb * 2, hstepA = (size_t)HALF * g.lda * 2;
    const size_t tstepB = 2 * hstepB, tstepA = 2 * hstepA;
    const unsigned ldsw = (unsigned)wid * 1024u;
    const int aoff = lds_byte(wr * 64 + fr, fq * 8), boff = lds_byte(wc * 32 + fr, fq * 8);
#define PG8_SA(b, h) (((b) * 2 + (h)) * HTB)
#define PG8_SB(b, h) ((4 + (b) * 2 + (h)) * HTB)
#define PG8_STAGE(bufoff, gbase, voff) do { _Pragma("unroll") for (int _i = 0; _i < 2; ++_i) \
        __builtin_amdgcn_global_load_lds((const unsigned*)((const char*)(gbase) + (voff)[_i]), (PG8_LAS unsigned*)(lds + (bufoff) + ldsw + _i * 8192), 16, 0, 0); } while (0)
#define PG8_LDA(dst, b, h) do { _Pragma("unroll") for (int m = 0; m < 4; ++m) _Pragma("unroll") for (int k = 0; k < 2; ++k) dst[m][k] = *(const PG8_LAS bf16x8*)(lds + PG8_SA(b, h) + aoff + m * 2048 + k * 1024); } while (0)
#define PG8_LDB(dst, b, h) do { _Pragma("unroll") for (int n = 0; n < 2; ++n) _Pragma("unroll") for (int k = 0; k < 2; ++k) dst[n][k] = *(const PG8_LAS bf16x8*)(lds + PG8_SB(b, h) + boff + n * 2048 + k * 1024); } while (0)
#define PG8_MMA(ai, bj, At, Bt) do { __builtin_amdgcn_s_setprio(1); _Pragma("unroll") for (int m = 0; m < 4; ++m) _Pragma("unroll") for (int n = 0; n < 2; ++n) _Pragma("unroll") for (int k = 0; k < 2; ++k) \
        acc[ai][bj][m][n] = __builtin_amdgcn_mfma_f32_16x16x32_bf16(Bt[n][k], At[m][k], acc[ai][bj][m][n], 0, 0, 0); __builtin_amdgcn_s_setprio(0); } while (0)
#define PG8_WAIT_V(n) asm volatile("s_waitcnt vmcnt(" #n ")" ::: "memory")
#define PG8_WAIT_L(n) asm volatile("s_waitcnt lgkmcnt(" #n ")" ::: "memory")
#define PG8_BAR __builtin_amdgcn_s_barrier()
#define PG8_SCHED __builtin_amdgcn_sched_barrier(0)
    Unit cur, nxt; int ui = 0;
    if (!S.next(0, cur)) return;
    f32x4 acc[2][2][4][2];
#pragma unroll
    for (int a = 0; a < 2; ++a)
#pragma unroll
        for (int b = 0; b < 2; ++b)
#pragma unroll
            for (int m = 0; m < 4; ++m)
#pragma unroll
                for (int n = 0; n < 2; ++n) acc[a][b][m][n] = (f32x4){0.f, 0.f, 0.f, 0.f};
    bf16x8 At[4][2], B0[2][2], B1[2][2];
    const char* cA = (const char*)g.A + (size_t)cur.pm * tstepA; const char* cB = (const char*)g.Bt + (size_t)cur.pn * tstepB;
    S.a_ready(cur);
    if constexpr (SP2) {
        PG8_STAGE(PG8_SB(0, 0), cB, voffB); PG8_STAGE(PG8_SB(0, 1), cB + hstepB, voffB); PG8_STAGE(PG8_SA(0, 0), cA, voffA); PG8_STAGE(PG8_SA(0, 1), cA + hstepA, voffA);
        if (wr == 1) PG8_BAR;
        PG8_WAIT_V(2); PG8_BAR;
        PG8_STAGE(PG8_SB(1, 0), cB + kstep, voffB); PG8_STAGE(PG8_SA(1, 0), cA + kstep, voffA); PG8_STAGE(PG8_SB(1, 1), cB + hstepB + kstep, voffB);
        PG8_WAIT_V(6); PG8_BAR;
    } else {
        PG8_STAGE(PG8_SB(0, 0), cB, voffB); PG8_STAGE(PG8_SA(0, 0), cA, voffA); PG8_STAGE(PG8_SB(0, 1), cB + hstepB, voffB); PG8_STAGE(PG8_SA(0, 1), cA + hstepA, voffA);
        if (wr == 1) PG8_BAR;
        PG8_WAIT_V(4); PG8_BAR;
        PG8_STAGE(PG8_SB(1, 0), cB + kstep, voffB); PG8_STAGE(PG8_SA(1, 0), cA + kstep, voffA); PG8_STAGE(PG8_SB(1, 1), cB + hstepB + kstep, voffB);
        PG8_WAIT_V(6); PG8_BAR;
    }
    for (;;) {
        const bool has_next = S.next(ui + 1, nxt);
        const char* nA = has_next ? (const char*)g.A + (size_t)nxt.pm * tstepA : cA; const char* nB = has_next ? (const char*)g.Bt + (size_t)nxt.pn * tstepB : cB;
        for (int t = 0; t < nt; t += 2) {
            const bool last = (t == nt - 2);
            const char* a1 = cA + (size_t)(t + 1) * kstep;
            const char* a2 = last ? nA : cA + (size_t)(t + 2) * kstep; const char* b2 = last ? nB : cB + (size_t)(t + 2) * kstep;
            const char* a3 = a2 + kstep; const char* b3 = b2 + kstep;
            if (last && has_next) S.a_ready(nxt);
            if constexpr (SP2) {
            PG8_LDB(B0, 0, 0); PG8_LDB(B1, 0, 1); PG8_SCHED; PG8_LDA(At, 0, 0); PG8_STAGE(PG8_SA(1, 1), a1 + hstepA, voffA);
            PG8_WAIT_V(8); PG8_WAIT_L(0); PG8_BAR; PG8_MMA(0, 0, At, B0); PG8_MMA(0, 1, At, B1); PG8_BAR; PG8_SCHED;
            PG8_LDA(At, 0, 1); PG8_STAGE(PG8_SB(0, 0), b2, voffB); PG8_STAGE(PG8_SB(0, 1), b2 + hstepB, voffB); PG8_STAGE(PG8_SA(0, 0), a2, voffA);
            PG8_WAIT_V(8); PG8_WAIT_L(0); PG8_BAR; PG8_MMA(1, 0, At, B0); PG8_MMA(1, 1, At, B1); PG8_BAR; PG8_SCHED;
            PG8_LDB(B0, 1, 0); PG8_LDB(B1, 1, 1); PG8_SCHED; PG8_LDA(At, 1, 0); PG8_STAGE(PG8_SA(0, 1), a2 + hstepA, voffA);
            PG8_WAIT_V(8); PG8_WAIT_L(0); PG8_BAR; PG8_MMA(0, 0, At, B0); PG8_MMA(0, 1, At, B1); PG8_BAR; PG8_SCHED;
            PG8_LDA(At, 1, 1); PG8_STAGE(PG8_SB(1, 0), b3, voffB); PG8_STAGE(PG8_SB(1, 1), b3 + hstepB, voffB); PG8_STAGE(PG8_SA(1, 0), a3, voffA);
            PG8_WAIT_V(8); PG8_WAIT_L(0); PG8_BAR; PG8_MMA(1, 0, At, B0); PG8_MMA(1, 1, At, B1); PG8_BAR; PG8_SCHED;
            }
        }
        if constexpr (ALIGN_EPI) { if (wr == 0) PG8_BAR; }
        if constexpr (!Epi::AFTER_DRAIN) { E(acc, cur, wr, wc, fr, fq); S.done(cur); }
        if (!has_next) break;
#pragma unroll
        for (int a = 0; a < 2; ++a)
#pragma unroll
            for (int b = 0; b < 2; ++b)
#pragma unroll
                for (int m = 0; m < 4; ++m)
#pragma unroll
                    for (int n = 0; n < 2; ++n) acc[a][b][m][n] = (f32x4){0.f, 0.f, 0.f, 0.f};
        cur = nxt; cA = nA; cB = nB; ++ui;
        if constexpr (ALIGN_EPI) { if (wr == 1) PG8_BAR; }
    }
    PG8_WAIT_V(0);
    if constexpr (!ALIGN_EPI) { if (wr == 0) PG8_BAR; }
    PG8_BAR;
    if constexpr (Epi::AFTER_DRAIN) { E.fused(acc, cur, wr, wc, fr, fq, lds, wid, lane); S.done(cur); }
#undef PG8_SA
#undef PG8_SB
#undef PG8_STAGE
#undef PG8_LDA
#undef PG8_LDB
#undef PG8_MMA
#undef PG8_WAIT_V
#undef PG8_WAIT_L
#undef PG8_BAR
#undef PG8_SCHED
}
}

#define LAS __attribute__((address_space(3)))
using pg8::bf16_t; using pg8::bf16x8; using pg8::f32x4; using pg8::u32x4; using pg8::Unit; using pg8::cvt_pk_bf16;
typedef short s16x4 __attribute__((ext_vector_type(4)));
typedef float f32x16 __attribute__((ext_vector_type(16)));
typedef unsigned u32x2 __attribute__((ext_vector_type(2)));

constexpr int S_ = 16384, DM = 2048, FF = 8192, NH = 16, DH = 128, NG = 4;
constexpr int NFOX = 6400, NNSA = 2304, NKV = 3072;
constexpr float ALPHA_ = 1.6817928305074292f;
constexpr float QSCALE = 0.08838834764831845f;
constexpr float L2E = 1.4426950408889634f;
constexpr float LN_EPS_ = 1e-5f;

constexpr size_t MiB = 1u << 20;
constexpr size_t WS_WFOXIN = 0;
constexpr size_t WS_WFOXO  = 50 * MiB;
constexpr size_t WS_WNSAIN = 66 * MiB;
constexpr size_t WS_WNSAO  = 84 * MiB;
constexpr size_t WS_WKV    = 100 * MiB;
constexpr size_t WS_W1     = 112 * MiB;
constexpr size_t WS_W2     = 240 * MiB;
constexpr size_t WS_WC1    = 368 * MiB;
constexpr size_t WS_HBF    = 372 * MiB;
constexpr size_t WS_PRE    = 436 * MiB;
constexpr size_t WS_A      = 564 * MiB;
constexpr size_t WS_KV     = 820 * MiB;
constexpr size_t WS_RAWK   = 916 * MiB;
constexpr size_t WS_RAWV   = 933 * MiB;
constexpr size_t WS_VT     = 950 * MiB;
constexpr size_t WS_CH     = 966 * MiB;
constexpr size_t WS_KC     = 970 * MiB;
constexpr size_t WS_VC     = 971 * MiB;
constexpr size_t WS_CUM    = 972 * MiB;
constexpr size_t WS_FLOG   = 973 * MiB;
constexpr size_t WS_GATE   = 974 * MiB;
constexpr size_t WS_LUT    = 977 * MiB;
constexpr size_t WS_CBP    = 977 * MiB + 256 * 1024;
constexpr size_t WS_CB     = 977 * MiB + 512 * 1024;
constexpr size_t WS_NRM    = 977 * MiB + 768 * 1024;
constexpr size_t WS_KF     = 978 * MiB;
constexpr size_t WS_BAR    = 994 * MiB;
constexpr size_t WS_CPART  = 436 * MiB;
constexpr size_t WS_END    = 995 * MiB;

constexpr int SHM_K = 16384, SHM_V = 16384;
constexpr int L_V = 0, L_K = 32768, L_WS = 65536, L_CK = 65536 + 2048, L_LUT = 69632, L_END = 69632 + 32768;
constexpr int LDS_BYTES = 147456;

__device__ __forceinline__ u32x4 pack8bf(f32x4 a, f32x4 b) { u32x4 w; w.x = cvt_pk_bf16(a[0], a[1]); w.y = cvt_pk_bf16(a[2], a[3]); w.z = cvt_pk_bf16(b[0], b[1]); w.w = cvt_pk_bf16(b[2], b[3]); return w; }
__device__ __forceinline__ float log_sigmoid_f(float x) { return fminf(x, 0.f) - log1pf(__expf(-fabsf(x))); }
__device__ __forceinline__ float sigmoid_f(float x) { return 1.f / (1.f + __expf(-x)); }
__device__ __forceinline__ float gelu_tanh_f(float x) { const float u = 0.7978845608028654f * (x + 0.044715f * x * x * x); const float t = 1.f - 2.f / (__expf(2.f * u) + 1.f); return 0.5f * x * (1.f + t); }

struct EpiFoxQKV {
    static constexpr bool PERM = true, AFTER_DRAIN = false;
    bf16_t* q; float* flog; const float* bfg;
    __device__ __forceinline__ void operator()(const f32x4 (&acc)[2][2][4][2], const Unit& u, int wr, int wc, int fr, int fq) const {
        const int row0 = u.pm * 256 + wr * 64 + fr; const int colt = u.pn * 256;
        if (colt < 6144) {
            const int t = colt >> 11; bf16_t* base = q + (size_t)t * ((size_t)S_ * DM); const float sc = t == 0 ? QSCALE : 1.f;
            const int c0 = colt - t * 2048 + wc * 32 + 8 * fq;
#pragma unroll
            for (int ai = 0; ai < 2; ++ai)
#pragma unroll
                for (int m = 0; m < 4; ++m) { bf16_t* rowp = base + (size_t)(row0 + ai * 128 + m * 16) * DM + c0;
#pragma unroll
                    for (int bj = 0; bj < 2; ++bj) *(u32x4*)(rowp + bj * 128) = pack8bf(acc[ai][bj][m][0] * sc, acc[ai][bj][m][1] * sc); }
        } else if (wc == 0 && fq < 2) {
            float bb[8];
#pragma unroll
            for (int e = 0; e < 8; ++e) bb[e] = bfg[8 * fq + e];
#pragma unroll
            for (int ai = 0; ai < 2; ++ai)
#pragma unroll
                for (int m = 0; m < 4; ++m) { float* rowp = flog + (size_t)(row0 + ai * 128 + m * 16) * 16 + 8 * fq;
                    f32x4 a = acc[ai][0][m][0], b = acc[ai][0][m][1], oa, ob;
#pragma unroll
                    for (int e = 0; e < 4; ++e) { oa[e] = log_sigmoid_f(a[e] + bb[e]); ob[e] = log_sigmoid_f(b[e] + bb[4 + e]); }
                    *(f32x4*)rowp = oa; *(f32x4*)(rowp + 4) = ob; }
        }
    }
};
struct EpiNsaQ {
    static constexpr bool PERM = true, AFTER_DRAIN = false;
    bf16_t* q; float* gates;
    __device__ __forceinline__ void operator()(const f32x4 (&acc)[2][2][4][2], const Unit& u, int wr, int wc, int fr, int fq) const {
        const int row0 = u.pm * 256 + wr * 64 + fr; const int colt = u.pn * 256;
        if (colt < 2048) {
            const int c0 = colt + wc * 32 + 8 * fq;
#pragma unroll
            for (int ai = 0; ai < 2; ++ai)
#pragma unroll
                for (int m = 0; m < 4; ++m) { bf16_t* rowp = q + (size_t)(row0 + ai * 128 + m * 16) * DM + c0;
#pragma unroll
                    for (int bj = 0; bj < 2; ++bj) *(u32x4*)(rowp + bj * 128) = pack8bf(acc[ai][bj][m][0] * QSCALE, acc[ai][bj][m][1] * QSCALE); }
        } else { const int c0 = wc * 32 + 8 * fq;
            if (c0 < 48) {
#pragma unroll
            for (int ai = 0; ai < 2; ++ai)
#pragma unroll
                for (int m = 0; m < 4; ++m) { float* rowp = gates + (size_t)(row0 + ai * 128 + m * 16) * 48 + c0;
                    f32x4 a = acc[ai][0][m][0], b = acc[ai][0][m][1], oa, ob;
#pragma unroll
                    for (int e = 0; e < 4; ++e) { oa[e] = sigmoid_f(a[e]); ob[e] = sigmoid_f(b[e]); }
                    *(f32x4*)rowp = oa; *(f32x4*)(rowp + 4) = ob; } }
        }
    }
};
struct EpiRes {
    static constexpr bool PERM = true, AFTER_DRAIN = false;
    const float* res; float* out;
    __device__ __forceinline__ void operator()(const f32x4 (&acc)[2][2][4][2], const Unit& u, int wr, int wc, int fr, int fq) const {
        const int row0 = u.pm * 256 + wr * 64 + fr; const int c0 = u.pn * 256 + wc * 32 + 8 * fq;
#pragma unroll
        for (int ai = 0; ai < 2; ++ai)
#pragma unroll
            for (int m = 0; m < 4; ++m) { const size_t off = (size_t)(row0 + ai * 128 + m * 16) * DM + c0;
#pragma unroll
                for (int bj = 0; bj < 2; ++bj) { const f32x4 r0 = *(const f32x4*)(res + off + bj * 128), r1 = *(const f32x4*)(res + off + bj * 128 + 4);
                    *(f32x4*)(out + off + bj * 128) = r0 * ALPHA_ + acc[ai][bj][m][0]; *(f32x4*)(out + off + bj * 128 + 4) = r1 * ALPHA_ + acc[ai][bj][m][1]; } }
    }
};
struct EpiRelu2 {
    static constexpr bool PERM = true, AFTER_DRAIN = false;
    bf16_t* O;
    __device__ __forceinline__ void operator()(const f32x4 (&acc)[2][2][4][2], const Unit& u, int wr, int wc, int fr, int fq) const {
        const int row0 = u.pm * 256 + wr * 64 + fr; const int c0 = u.pn * 256 + wc * 32 + 8 * fq;
#pragma unroll
        for (int ai = 0; ai < 2; ++ai)
#pragma unroll
            for (int m = 0; m < 4; ++m) { bf16_t* rowp = O + (size_t)(row0 + ai * 128 + m * 16) * FF + c0;
#pragma unroll
                for (int bj = 0; bj < 2; ++bj) { f32x4 a = acc[ai][bj][m][0], b = acc[ai][bj][m][1];
#pragma unroll
                    for (int e = 0; e < 4; ++e) { a[e] = fmaxf(a[e], 0.f); a[e] *= a[e]; b[e] = fmaxf(b[e], 0.f); b[e] *= b[e]; }
                    *(u32x4*)(rowp + bj * 128) = pack8bf(a, b); } }
    }
};
__device__ __forceinline__ int vt_pos(int ko) { return ((ko & 15) >> 2) * 8 + ((ko >> 4) << 2) + (ko & 3); }
struct EpiKV {
    static constexpr bool PERM = true, AFTER_DRAIN = false;
    bf16_t* kv; bf16_t* rawk; bf16_t* rawv; bf16_t* vt; bf16_t* kf;
    __device__ __forceinline__ void operator()(const f32x4 (&acc)[2][2][4][2], const Unit& u, int wr, int wc, int fr, int fq) const {
        const int row0 = u.pm * 256 + wr * 64 + fr;
#pragma unroll
        for (int bj = 0; bj < 2; ++bj) {
            const int cg_ = u.pn * 256 + bj * 128; const int slot = cg_ >> 9, g = (cg_ & 511) >> 7; const int d0 = wc * 32 + 8 * fq;
#pragma unroll
            for (int ai = 0; ai < 2; ++ai)
#pragma unroll
                for (int m = 0; m < 4; ++m) { const int row = row0 + ai * 128 + m * 16; const f32x4 a = acc[ai][bj][m][0], b = acc[ai][bj][m][1];
                    if (slot < 2) { bf16_t* dst = (slot == 0 ? rawk : rawv) + ((size_t)g * S_ + row) * 128 + d0; *(u32x4*)dst = pack8bf(a, b); }
                    else if (slot == 2) { const int blk = row >> 6, kin = row & 63;
                        *(u32x4*)(kf + ((size_t)((g * 256 + blk) * 16 + (kin >> 4) * 4 + wc)) * 512 + (fq * 16 + (kin & 15)) * 8) = pack8bf(a, b); }
                    else if (slot == 3) { const u32x4 w = pack8bf(a, b); const int blk = row >> 6, kin = row & 63, pos = vt_pos(kin & 31);
                        bf16_t* dst = vt + ((size_t)((g * 256 + blk) * 16 + (wc * 2 + (fq >> 1)) * 2 + (kin >> 5))) * 512 + ((pos >> 3) * 16 + (fq & 1) * 8) * 8 + (pos & 7);
                        dst[0] = (bf16_t)(w.x & 0xffffu); dst[8] = (bf16_t)(w.x >> 16); dst[16] = (bf16_t)(w.y & 0xffffu); dst[24] = (bf16_t)(w.y >> 16);
                        dst[32] = (bf16_t)(w.z & 0xffffu); dst[40] = (bf16_t)(w.z >> 16); dst[48] = (bf16_t)(w.w & 0xffffu); dst[56] = (bf16_t)(w.w >> 16); }
                    else { *(u32x4*)(kv + (size_t)row * NKV + cg_ + d0) = pack8bf(a, b); } }
        }
    }
};
struct EpiPart {
    static constexpr bool PERM = true, AFTER_DRAIN = false;
    float* P;
    __device__ __forceinline__ void operator()(const f32x4 (&acc)[2][2][4][2], const Unit& u, int wr, int wc, int fr, int fq) const {
        const int row0 = u.pm * 256 + wr * 64 + fr; const int c0 = wc * 32 + 8 * fq;
#pragma unroll
        for (int ai = 0; ai < 2; ++ai)
#pragma unroll
            for (int m = 0; m < 4; ++m) { float* rowp = P + (size_t)(row0 + ai * 128 + m * 16) * 256 + c0;
#pragma unroll
                for (int bj = 0; bj < 2; ++bj) { *(f32x4*)(rowp + bj * 128) = acc[ai][bj][m][0]; *(f32x4*)(rowp + bj * 128 + 4) = acc[ai][bj][m][1]; } }
    }
};

__device__ __forceinline__ unsigned f2bf(float f) { unsigned u = __builtin_bit_cast(unsigned, f); return (u + 0x7fffu + ((u >> 16) & 1u)) >> 16; }
__device__ __forceinline__ unsigned pk2(float lo, float hi) { return f2bf(lo) | (f2bf(hi) << 16); }
__device__ __forceinline__ float wave_sum(float v) {
#pragma unroll
    for (int o = 1; o < 64; o <<= 1) v += __shfl_xor(v, o);
    return v;
}
template <int CTRL> __device__ __forceinline__ float dppf(float v) { return __uint_as_float((unsigned)__builtin_amdgcn_update_dpp(0, (int)__float_as_uint(v), CTRL, 0xF, 0xF, true)); }
__device__ __forceinline__ float wave_max_fast(float v) {
    v = fmaxf(v, dppf<0xB1>(v)); v = fmaxf(v, dppf<0x4E>(v)); v = fmaxf(v, dppf<0x141>(v)); v = fmaxf(v, dppf<0x140>(v));
    const float a = __uint_as_float((unsigned)__builtin_amdgcn_readlane((int)__float_as_uint(v), 0)), b = __uint_as_float((unsigned)__builtin_amdgcn_readlane((int)__float_as_uint(v), 16));
    const float c = __uint_as_float((unsigned)__builtin_amdgcn_readlane((int)__float_as_uint(v), 32)), d = __uint_as_float((unsigned)__builtin_amdgcn_readlane((int)__float_as_uint(v), 48));
    return fmaxf(fmaxf(a, b), fmaxf(c, d));
}
__device__ __forceinline__ float wave_sum_fast(float v) {
    v += dppf<0xB1>(v); v += dppf<0x4E>(v); v += dppf<0x141>(v); v += dppf<0x140>(v);
    const float a = __uint_as_float((unsigned)__builtin_amdgcn_readlane((int)__float_as_uint(v), 0)), b = __uint_as_float((unsigned)__builtin_amdgcn_readlane((int)__float_as_uint(v), 16));
    const float c = __uint_as_float((unsigned)__builtin_amdgcn_readlane((int)__float_as_uint(v), 32)), d = __uint_as_float((unsigned)__builtin_amdgcn_readlane((int)__float_as_uint(v), 48));
    return (a + b) + (c + d);
}
__device__ __forceinline__ float wave_max(float v) {
#pragma unroll
    for (int o = 1; o < 64; o <<= 1) v = fmaxf(v, __shfl_xor(v, o));
    return v;
}
__device__ __forceinline__ void transpose_item(const float* W, int K, int ld, int ncols, bf16_t* WT, LAS float* scr, int item, int lane) {
    const int nblk = ncols / 32, kb = item / nblk, nb = item % nblk, k0 = 64 * kb, n0 = 32 * nb;
#pragma unroll 8
    for (int i = 0; i < 32; ++i) { const int kk = 2 * i + (lane >> 5); scr[kk * 33 + (lane & 31)] = W[(size_t)(k0 + kk) * ld + n0 + (lane & 31)]; }
    asm volatile("s_waitcnt lgkmcnt(0)" ::: "memory");
    const int c = lane & 7;
#pragma unroll
    for (int j = 0; j < 4; ++j) { const int n = (lane >> 3) + 8 * j; const LAS float* s = scr + (8 * c) * 33 + n;
        u32x4 o; o.x = pk2(s[0 * 33], s[1 * 33]); o.y = pk2(s[2 * 33], s[3 * 33]); o.z = pk2(s[4 * 33], s[5 * 33]); o.w = pk2(s[6 * 33], s[7 * 33]);
        *(u32x4*)(WT + (size_t)(n0 + n) * K + k0 + 8 * c) = o; }
    asm volatile("s_waitcnt lgkmcnt(0)" ::: "memory");
}
__device__ __forceinline__ int rel_bucket_dev(int n) {
    if (n < 16) return n;
    int lg = 16 + (int)(__logf((float)n / 16.0f) / 4.852030263919617f * 16.0f);
    return lg > 31 ? 31 : lg;
}

struct Params { const float* in[20]; float* out; unsigned char* ws; };
typedef const Params __attribute__((address_space(4)))* KP;
#define KARGS() ({ KP q_ = (KP)__builtin_amdgcn_kernarg_segment_ptr(); asm volatile("" : "+s"(q_)); q_; })
enum { I_X = 0, I_FOXWIN, I_FOXBF, I_FOXWO, I_NSAWIN, I_NSAWO, I_KVW, I_POSK, I_POSV, I_CK1, I_CK2, I_CV1, I_CV2, I_RELB, I_W1, I_W2, I_LN1G, I_LN1B, I_LN2G, I_LN2B };

__device__ __forceinline__ void prologue(KP p, LAS unsigned char* lds) {
    int tid_ = threadIdx.x; asm volatile("" : "+v"(tid_));
    const int tid = tid_, lane = tid & 63, wave = tid >> 6;
    const int gw = blockIdx.x * 8 + wave, NGW = gridDim.x * 8;
    LAS float* scr = (LAS float*)(lds + wave * 16384);
    unsigned char* ws = p->ws;
    long base = 0;
#define TR(src, K, ld, ncols, dst) do { const long n_ = (long)((K) / 64) * ((ncols) / 32); \
        for (long it = gw; it < n_; it += NGW) transpose_item((src), (K), (ld), (ncols), (dst), scr, (int)it, lane); } while (0)
    for (int L = 0; L < 2; ++L) {
        TR(p->in[I_FOXWIN] + (size_t)L * DM * 6160, DM, 6160, 6144, (bf16_t*)(ws + WS_WFOXIN) + (size_t)L * NFOX * DM);
        TR(p->in[I_FOXWO] + (size_t)L * DM * DM, DM, DM, DM, (bf16_t*)(ws + WS_WFOXO) + (size_t)L * DM * DM);
        TR(p->in[I_NSAWIN] + (size_t)L * DM * 2096, DM, 2096, 2048, (bf16_t*)(ws + WS_WNSAIN) + (size_t)L * NNSA * DM);
        TR(p->in[I_NSAWO] + (size_t)L * DM * DM, DM, DM, DM, (bf16_t*)(ws + WS_WNSAO) + (size_t)L * DM * DM);
    }
    TR(p->in[I_KVW], DM, NKV, NKV, (bf16_t*)(ws + WS_WKV));
    for (int L = 0; L < 4; ++L) {
        TR(p->in[I_W1] + (size_t)L * DM * FF, DM, FF, FF, (bf16_t*)(ws + WS_W1) + (size_t)L * FF * DM);
        TR(p->in[I_W2] + (size_t)L * FF * DM, FF, DM, DM, (bf16_t*)(ws + WS_W2) + (size_t)L * DM * FF);
    }
    TR(p->in[I_CK1], 4096, 256, 256, (bf16_t*)(ws + WS_WC1));
    TR(p->in[I_CV1], 4096, 256, 256, (bf16_t*)(ws + WS_WC1) + (size_t)256 * 4096);
#undef TR
    (void)base;
    const int gt = blockIdx.x * 512 + tid, NGT = gridDim.x * 512;
    for (int i = gt; i < 2 * 256 * DM; i += NGT) { const int L = i / (256 * DM), r = (i / DM) % 256, k = i % DM;
        const float v = r < 16 ? p->in[I_FOXWIN][(size_t)L * DM * 6160 + (size_t)k * 6160 + 6144 + r] : 0.f;
        ((bf16_t*)(ws + WS_WFOXIN))[(size_t)L * NFOX * DM + (size_t)(6144 + r) * DM + k] = (bf16_t)f2bf(v); }
    for (int i = gt; i < 2 * 256 * DM; i += NGT) { const int L = i / (256 * DM), r = (i / DM) % 256, k = i % DM;
        const float v = r < 48 ? p->in[I_NSAWIN][(size_t)L * DM * 2096 + (size_t)k * 2096 + 2048 + r] : 0.f;
        ((bf16_t*)(ws + WS_WNSAIN))[(size_t)L * NNSA * DM + (size_t)(2048 + r) * DM + k] = (bf16_t)f2bf(v); }
    { const f32x4* x4 = (const f32x4*)p->in[I_X]; u32x2* o = (u32x2*)(ws + WS_HBF);
      for (int i = gt; i < S_ * DM / 4; i += NGT) { const f32x4 v = x4[i]; u32x2 w; w.x = pk2(v[0], v[1]); w.y = pk2(v[2], v[3]); o[i] = w; } }
    { float* lut = (float*)(ws + WS_LUT);
      for (int i = gt; i < 16 * 2048; i += NGT) { const int h = i >> 11, d = i & 2047; lut[i] = p->in[I_RELB][rel_bucket_dev(d) * 16 + h]; } }
    { float* part = (float*)(ws + WS_CBP);
      for (int i = gt; i < 2 * 64 * 256; i += NGT) { const int mat = i / (64 * 256), ch = (i / 256) % 64, c = i % 256;
          const float* pos = p->in[mat ? I_POSV : I_POSK]; const float* w1 = p->in[mat ? I_CV1 : I_CK1]; float s = 0.f;
          for (int j = ch * 64; j < ch * 64 + 64; ++j) s += pos[j] * w1[(size_t)j * 256 + c];
          part[i] = s; } }
    if (gt < 64) ((unsigned*)(ws + WS_NRM))[gt] = 0u;
    { bf16_t* rk = (bf16_t*)(ws + WS_RAWK) + (size_t)4 * S_ * 128; bf16_t* rv = (bf16_t*)(ws + WS_RAWV) + (size_t)4 * S_ * 128;
      for (int i = gt; i < 32 * 128; i += NGT) { rk[i] = 0; rv[i] = 0; } }
}

__device__ __forceinline__ void ln_phase(const float* pre, const float* gam, const float* bet, float* h32, bf16_t* hbf) {
    int tid_ = threadIdx.x; asm volatile("" : "+v"(tid_));
    const int tid = tid_, lane = tid & 63, wave = tid >> 6;
    const int gw = blockIdx.x * 8 + wave, NGW = gridDim.x * 8;
    f32x4 nx[8];
    if (gw < S_) { const f32x4* xr = (const f32x4*)(pre + (size_t)gw * DM) + lane;
#pragma unroll
        for (int j = 0; j < 8; ++j) nx[j] = xr[64 * j]; }
#pragma nounroll
    for (int row = gw; row < S_; row += NGW) {
        f32x4 v[8]; float s = 0.f;
#pragma unroll
        for (int j = 0; j < 8; ++j) { v[j] = nx[j]; s += (v[j][0] + v[j][1]) + (v[j][2] + v[j][3]); }
        if (row + NGW < S_) { const f32x4* xr = (const f32x4*)(pre + (size_t)(row + NGW) * DM) + lane;
#pragma unroll
            for (int j = 0; j < 8; ++j) nx[j] = xr[64 * j]; }
        const float mean = wave_sum_fast(s) * (1.f / DM); float s2 = 0.f;
#pragma unroll
        for (int j = 0; j < 8; ++j) { v[j] = v[j] - mean; s2 += (v[j][0] * v[j][0] + v[j][1] * v[j][1]) + (v[j][2] * v[j][2] + v[j][3] * v[j][3]); }
        const float rstd = 1.f / sqrtf(wave_sum_fast(s2) * (1.f / DM) + LN_EPS_);
        f32x4* o4 = (f32x4*)(h32 + (size_t)row * DM) + lane; u32x2* o2 = (u32x2*)(hbf + (size_t)row * DM) + lane;
#pragma unroll
        for (int j = 0; j < 8; ++j) { const f32x4 g4 = ((const f32x4*)gam)[lane + 64 * j], b4 = ((const f32x4*)bet)[lane + 64 * j];
            const f32x4 y = v[j] * rstd * g4 + b4; o4[64 * j] = y; u32x2 w; w.x = pk2(y[0], y[1]); w.y = pk2(y[2], y[3]); o2[64 * j] = w; }
    }
}

__device__ __forceinline__ void scan_phase(KP p, LAS unsigned char* lds, bool do_cbias, int layer) {
    int tid_ = threadIdx.x; asm volatile("" : "+v"(tid_));
    const int tid = tid_; unsigned char* ws = p->ws;
    if (blockIdx.x < 16) {
        const int h = blockIdx.x; const float* fl = (const float*)(ws + WS_FLOG); float* cum = (float*)(ws + WS_CUM) + (size_t)h * S_;
        LAS float* sh = (LAS float*)lds;
        float loc[32]; float tot = 0.f;
#pragma unroll
        for (int i = 0; i < 32; ++i) { loc[i] = fl[(size_t)(tid * 32 + i) * 16 + h]; }
#pragma unroll
        for (int i = 0; i < 32; ++i) { tot += loc[i]; loc[i] = tot; }
        sh[tid] = tot; __syncthreads();
        for (int off = 1; off < 512; off <<= 1) { const float v = tid >= off ? sh[tid - off] : 0.f; __syncthreads(); sh[tid] += v; __syncthreads(); }
        const float excl = sh[tid] - tot;
#pragma unroll
        for (int i = 0; i < 32; ++i) cum[tid * 32 + i] = excl + loc[i];
        __syncthreads();
    } else if (blockIdx.x == 16) {
        if (do_cbias) {
        const float* part = (const float*)(ws + WS_CBP); float* cb = (float*)(ws + WS_CB);
        const int mat = tid >> 8, c = tid & 255; float s = 0.f;
        for (int ch = 0; ch < 64; ++ch) s += part[(mat * 64 + ch) * 256 + c];
        cb[tid] = s; }
    } else {
        const int nb = (int)gridDim.x - 17, b = (int)blockIdx.x - 17;
        const int h = tid & 15; float mq = 0.f, mk = 0.f;
        const bf16_t* Q = (const bf16_t*)(ws + WS_A); const bf16_t* K = Q + (size_t)S_ * DM;
        for (int t = b * 32 + (tid >> 4); t < S_; t += nb * 32) {
            const u32x4* qp = (const u32x4*)(Q + (size_t)t * DM + h * 128); const u32x4* kp = (const u32x4*)(K + (size_t)t * DM + h * 128);
            float sq = 0.f, sk = 0.f;
#pragma unroll 4
            for (int i = 0; i < 16; ++i) { const u32x4 a = qp[i], c = kp[i];
#pragma unroll
                for (int e = 0; e < 4; ++e) { const float q0 = __uint_as_float(a[e] << 16), q1 = __uint_as_float(a[e] & 0xffff0000u), k0 = __uint_as_float(c[e] << 16), k1 = __uint_as_float(c[e] & 0xffff0000u);
                    sq += q0 * q0 + q1 * q1; sk += k0 * k0 + k1 * k1; } }
            mq = fmaxf(mq, sq); mk = fmaxf(mk, sk);
        }
        mq = fmaxf(mq, __shfl_xor(mq, 16)); mq = fmaxf(mq, __shfl_xor(mq, 32)); mk = fmaxf(mk, __shfl_xor(mk, 16)); mk = fmaxf(mk, __shfl_xor(mk, 32));
        if ((tid & 63) < 16) { unsigned* nr = (unsigned*)(ws + WS_NRM) + (layer * 16 + h) * 2; atomicMax(nr, __float_as_uint(mq)); atomicMax(nr + 1, __float_as_uint(mk)); }
    }
}

__device__ __forceinline__ void cmp2_phase(KP p, LAS unsigned char* lds) {
    int tid_ = threadIdx.x; asm volatile("" : "+v"(tid_));
    const int tid = tid_; unsigned char* ws = p->ws;
    const int rr = tid >> 7, d = tid & 127;
    LAS float* hid = (LAS float*)lds;
    for (int it = blockIdx.x; it < 2 * 1024; it += gridDim.x) {
        const int mat = it >> 10, row0 = (it & 1023) * 4;
        const float* part = (const float*)(ws + WS_CPART) + (size_t)mat * 8 * 4096 * 256; const float* cb = (const float*)(ws + WS_CB) + mat * 256;
        __syncthreads();
#pragma unroll
        for (int i = 0; i < 2; ++i) { const int e = tid + 512 * i, r_ = e >> 8, k = e & 255; float s = cb[k];
#pragma unroll
            for (int c = 0; c < 8; ++c) s += part[((size_t)c * 4096 + row0 + r_) * 256 + k];
            hid[e] = gelu_tanh_f(s); }
        __syncthreads();
        const int row = row0 + rr;
        const float* w2 = p->in[mat ? I_CV2 : I_CK2];
        float s = 0.f;
#pragma unroll 8
        for (int k = 0; k < 256; ++k) s += hid[rr * 256 + k] * w2[k * 128 + d];
        if ((row & 1023) == 1023) s = 0.f;
        ((bf16_t*)(ws + (mat ? WS_VC : WS_KC)))[(size_t)row * 128 + d] = (bf16_t)f2bf(s);
    }
}

#define KSWZ(row, colB) ((row) * 256 + ((colB) ^ (((row) & 7) << 4)))
#define SBAR() __builtin_amdgcn_sched_barrier(0)
__device__ __forceinline__ int v_st(int k, int c) { const int kk = (k & ~0xC) | ((k & 4) << 1) | ((k & 8) >> 1); return ((kk >> 3) * 4 + (c >> 5)) * 512 + ((kk & 7) * 32 + (c & 31)) * 2; }
__device__ __forceinline__ int v_rd_base(int lane) { return ((lane & 3) << 3) | (((lane >> 2) & 3) << 6) | (((lane >> 4) & 1) << 5) | (((lane >> 5) & 1) << 8); }
constexpr int v_rd_off(int d0, int ks, int half) { return d0 * 512 + ks * 4096 + half * 2048; }
__device__ __forceinline__ int crow(int r, int hi) { return (r & 3) + 8 * (r >> 2) + 4 * hi; }

__device__ __forceinline__ void qkt(f32x16& p0, f32x16& p1, const LAS unsigned char* Kb, int r32, int hi, const bf16x8* qr) {
#pragma unroll
    for (int r = 0; r < 16; ++r) { p0[r] = 0.f; p1[r] = 0.f; }
    const LAS unsigned char* kb[4];
#pragma unroll
    for (int dd = 0; dd < 4; ++dd) kb[dd] = Kb + KSWZ(r32, (dd * 16 + hi * 8) * 2);
#pragma unroll
    for (int d0 = 0; d0 < 8; ++d0) { const LAS unsigned char* a = kb[d0 & 3] + (d0 >> 2) * 128;
        const bf16x8 b0 = *(const LAS bf16x8*)a;
        const bf16x8 b1 = *(const LAS bf16x8*)(a + 32 * 256);
        p0 = __builtin_amdgcn_mfma_f32_32x32x16_bf16(b0, qr[d0], p0, 0, 0, 0);
        p1 = __builtin_amdgcn_mfma_f32_32x32x16_bf16(b1, qr[d0], p1, 0, 0, 0); }
}
__device__ __forceinline__ void pv_tile(f32x16* o, int vb, bf16x8 pa0, bf16x8 pa1, bf16x8 pa2, bf16x8 pa3) {
#define TRRD(dst, off) asm volatile("ds_read_b64_tr_b16 %0, %1 offset:%2" : "=&v"(dst) : "v"(vb), "i"(off) : "memory")
#define PV_D0(d0) do { s16x4 l0, l1, l2, l3, h0, h1, h2, h3; constexpr int b_ = v_rd_off(d0, 0, 0); \
        TRRD(l0, b_); TRRD(h0, b_ + 2048); TRRD(l1, b_ + 4096); TRRD(h1, b_ + 6144); TRRD(l2, b_ + 8192); TRRD(h2, b_ + 10240); TRRD(l3, b_ + 12288); TRRD(h3, b_ + 14336); \
        asm volatile("s_waitcnt lgkmcnt(0)" ::: "memory"); SBAR(); \
        o[d0] = __builtin_amdgcn_mfma_f32_32x32x16_bf16(pa0, (bf16x8){l0[0], l0[1], l0[2], l0[3], h0[0], h0[1], h0[2], h0[3]}, o[d0], 0, 0, 0);   \
        o[d0] = __builtin_amdgcn_mfma_f32_32x32x16_bf16(pa1, (bf16x8){l1[0], l1[1], l1[2], l1[3], h1[0], h1[1], h1[2], h1[3]}, o[d0], 0, 0, 0);   \
        o[d0] = __builtin_amdgcn_mfma_f32_32x32x16_bf16(pa2, (bf16x8){l2[0], l2[1], l2[2], l2[3], h2[0], h2[1], h2[2], h2[3]}, o[d0], 0, 0, 0);   \
        o[d0] = __builtin_amdgcn_mfma_f32_32x32x16_bf16(pa3, (bf16x8){l3[0], l3[1], l3[2], l3[3], h3[0], h3[1], h3[2], h3[3]}, o[d0], 0, 0, 0); } while (0)
    PV_D0(0); PV_D0(1); PV_D0(2); PV_D0(3);
#undef PV_D0
#undef TRRD
}
__device__ __forceinline__ void p_to_frags(const f32x16& p0, const f32x16& p1, bf16x8& pa0, bf16x8& pa1, bf16x8& pa2, bf16x8& pa3) {
#define PK4(P, B_, OUT) do { unsigned a0 = cvt_pk_bf16(P[B_+0], P[B_+1]), a1 = cvt_pk_bf16(P[B_+2], P[B_+3]);                          \
        unsigned b0 = cvt_pk_bf16(P[B_+4], P[B_+5]), b1 = cvt_pk_bf16(P[B_+6], P[B_+7]);                                             \
        auto r0 = __builtin_amdgcn_permlane32_swap(a0, b0, false, false); auto r1 = __builtin_amdgcn_permlane32_swap(a1, b1, false, false); \
        u32x4 w = {r0[0], r1[0], r0[1], r1[1]}; OUT = *reinterpret_cast<bf16x8*>(&w); } while (0)
    PK4(p0, 0, pa0); PK4(p0, 8, pa1); PK4(p1, 0, pa2); PK4(p1, 8, pa3);
#undef PK4
}
__device__ __forceinline__ float half_swap_max(float v) { auto rr = __builtin_amdgcn_permlane32_swap(__float_as_uint(v), __float_as_uint(v), false, false); return fmaxf(__uint_as_float(rr[0]), __uint_as_float(rr[1])); }
__device__ __forceinline__ float half_swap_sum(float v) { auto rr = __builtin_amdgcn_permlane32_swap(__float_as_uint(v), __float_as_uint(v), false, false); return __uint_as_float(rr[0]) + __uint_as_float(rr[1]); }
__device__ __forceinline__ float online_sm(f32x16& p0, f32x16& p1, float& m, float& l) {
    float pmax = p0[0];
#pragma unroll
    for (int r = 1; r < 16; ++r) pmax = fmaxf(pmax, p0[r]);
#pragma unroll
    for (int r = 0; r < 16; ++r) pmax = fmaxf(pmax, p1[r]);
    pmax = half_swap_max(pmax);
    float mn = m, alpha = 1.f;
    if (!__all(pmax <= m + 8.f)) { mn = fmaxf(m, pmax); alpha = __builtin_amdgcn_exp2f((m - mn) * L2E); m = mn; }
    const float mnL = -mn * L2E; float ps = 0.f;
#pragma unroll
    for (int r = 0; r < 16; ++r) { p0[r] = __builtin_amdgcn_exp2f(fmaf(p0[r], L2E, mnL)); p1[r] = __builtin_amdgcn_exp2f(fmaf(p1[r], L2E, mnL)); ps += p0[r] + p1[r]; }
    ps = half_swap_sum(ps);
    l = l * alpha + ps;
    return alpha;
}

struct FL {
    const bf16_t* K; const bf16_t* V; int kstride, vstride;
    int j_lo, j_hi;
    const float* cum; float cq;
    int t_lane, t_w0;
    const LAS float* lut;
    __half* imp;
};
template <int MODE>
__device__ __forceinline__ void flash_loop(LAS unsigned char* lds, const FL& a, const bf16x8* qr, float& m, float& l, f32x16* o, float inv_l) {
    int tid_ = threadIdx.x; asm volatile("" : "+v"(tid_));
    const int tid = tid_, wid = __builtin_amdgcn_readfirstlane(tid >> 6), lane = tid & 63, r32 = lane & 31, hi = lane >> 5;
    LAS unsigned char* V_lds = lds + L_V; LAS unsigned char* K_lds = lds + L_K;
    LAS float* al_l = (LAS float*)(lds + L_WS) + wid * 64 + 32;
    LAS float* ckb = (LAS float*)(lds + L_CK);
    const int sr = tid >> 4, sc = (tid & 15) * 8, vst0 = v_st(sr, sc), vst1 = v_st(32 + sr, sc), kws = KSWZ(sr, sc * 2);
    const int vb0 = (int)(size_t)V_lds + v_rd_base(lane);
    constexpr bool HASV = (MODE != 1);
    bf16x8 sk0, sk1, sv0, sv1; float sck = 0.f;
    const float NEG = -__builtin_inff();
    float carry = 0.f;
#define FL_LOAD(j) do { const int kb_ = (j) * 64; \
        sk0 = *(const bf16x8*)(a.K + (size_t)(kb_ + sr) * a.kstride + sc); sk1 = *(const bf16x8*)(a.K + (size_t)(kb_ + 32 + sr) * a.kstride + sc); \
        if (HASV) { sv0 = *(const bf16x8*)(a.V + (size_t)(kb_ + sr) * a.vstride + sc); sv1 = *(const bf16x8*)(a.V + (size_t)(kb_ + 32 + sr) * a.vstride + sc); } \
        if (MODE == 0) { if (tid < 64) sck = a.cum[kb_ + tid]; } } while (0)
#define FL_WRITE(buf) do { *(LAS bf16x8*)(K_lds + (buf) * SHM_K + kws) = sk0; *(LAS bf16x8*)(K_lds + (buf) * SHM_K + kws + 32 * 256) = sk1; \
        if (HASV) { *(LAS bf16x8*)(V_lds + (buf) * SHM_V + vst0) = sv0; *(LAS bf16x8*)(V_lds + (buf) * SHM_V + vst1) = sv1; } \
        if (MODE == 0) { if (tid < 64) ckb[(buf) * 64 + tid] = sck; } } while (0)
    __syncthreads();
    FL_LOAD(a.j_lo); FL_WRITE(0); __syncthreads();
#pragma nounroll
    for (int j = a.j_lo; j < a.j_hi; ++j) {
        const int buf = (j - a.j_lo) & 1; const int kb = j * 64;
        if (j + 1 < a.j_hi) FL_LOAD(j + 1);
        const bool act = (MODE != 0) || (kb <= a.t_w0 + 31);
        if (act) {
            f32x16 p0, p1;
            qkt(p0, p1, K_lds + buf * SHM_K, r32, hi, qr);
            if (MODE == 0) {
#pragma unroll
                for (int i = 0; i < 4; ++i) { const f32x4 c0 = *(const LAS f32x4*)(ckb + buf * 64 + 4 * hi + 8 * i), c1 = *(const LAS f32x4*)(ckb + buf * 64 + 32 + 4 * hi + 8 * i);
#pragma unroll
                    for (int e = 0; e < 4; ++e) { p0[4 * i + e] += a.cq - c0[e]; p1[4 * i + e] += a.cq - c1[e]; } }
                if (kb + 63 > a.t_w0) { const int dq = a.t_lane - kb - 4 * hi;
#pragma unroll
                    for (int r = 0; r < 16; ++r) { const int c = (r & 3) + 8 * (r >> 2); if (dq - c < 0) p0[r] = NEG; if (dq - c - 32 < 0) p1[r] = NEG; } }
            } else if (MODE == 1 || MODE == 2) {
                const int dq = a.t_lane - 16 * kb - 31 - 64 * hi;
#pragma unroll
                for (int r = 0; r < 16; ++r) { const int d0_ = dq - 16 * (r & 3) - 128 * (r >> 2), d1_ = d0_ - 512;
                    const unsigned i0 = (unsigned)d0_ < 2047u ? (unsigned)d0_ : 2047u, i1 = (unsigned)d1_ < 2047u ? (unsigned)d1_ : 2047u;
                    const float b0 = a.lut[i0], b1 = a.lut[i1];
                    p0[r] = d0_ >= 0 ? p0[r] + b0 : NEG; p1[r] = d1_ >= 0 ? p1[r] + b1 : NEG; }
            } else {
                const int dq = a.t_lane - kb - 4 * hi;
#pragma unroll
                for (int r = 0; r < 16; ++r) { const int d0_ = dq - ((r & 3) + 8 * (r >> 2)), d1_ = d0_ - 32;
                    const unsigned i0 = (unsigned)d0_ < 2047u ? (unsigned)d0_ : 2047u, i1 = (unsigned)d1_ < 2047u ? (unsigned)d1_ : 2047u;
                    const float b0 = a.lut[i0], b1 = a.lut[i1];
                    p0[r] = (unsigned)d0_ < 512u ? p0[r] + b0 : NEG; p1[r] = (unsigned)d1_ < 512u ? p1[r] + b1 : NEG; }
            }
            if (MODE == 1) { (void)online_sm(p0, p1, m, l); }
            else if (MODE == 2) {
                const float mnL = -m * L2E;
#pragma unroll
                for (int r = 0; r < 16; ++r) { p0[r] = __builtin_amdgcn_exp2f(fmaf(p0[r], L2E, mnL)) * inv_l; p1[r] = __builtin_amdgcn_exp2f(fmaf(p1[r], L2E, mnL)) * inv_l; }
                float a0[4], a1[4], x0[4], x1[4];
#pragma unroll
                for (int i = 0; i < 4; ++i) { a0[i] = (p0[4 * i] + p0[4 * i + 1]) + (p0[4 * i + 2] + p0[4 * i + 3]); a1[i] = (p1[4 * i] + p1[4 * i + 1]) + (p1[4 * i + 2] + p1[4 * i + 3]);
                    x0[i] = __shfl_xor(p0[4 * i + 3], 32); x1[i] = __shfl_xor(p1[4 * i + 3], 32); }
                __half* ip = a.imp + 16 * j + hi;
#pragma unroll
                for (int i = 0; i < 4; ++i) { const float e0 = hi ? x0[i] : (i ? x0[i > 0 ? i - 1 : 0] : carry); const float e1 = hi ? x1[i] : (i ? x1[i > 0 ? i - 1 : 0] : x0[3]);
                    ip[2 * i] = __float2half(a0[i] + e0); ip[8 + 2 * i] = __float2half(a1[i] + e1); }
                carry = x1[3];
                bf16x8 pa0, pa1, pa2, pa3; p_to_frags(p0, p1, pa0, pa1, pa2, pa3);
                pv_tile(o, vb0 + buf * SHM_V, pa0, pa1, pa2, pa3);
            } else {
                const float alpha = online_sm(p0, p1, m, l);
                if (__any(alpha < 1.f)) { if (hi == 0) al_l[r32] = alpha; asm volatile("s_waitcnt lgkmcnt(0)" ::: "memory");
#pragma unroll
                    for (int d_ = 0; d_ < 4; ++d_)
#pragma unroll
                        for (int r = 0; r < 16; ++r) o[d_][r] *= al_l[crow(r, hi)]; }
                bf16x8 pa0, pa1, pa2, pa3; p_to_frags(p0, p1, pa0, pa1, pa2, pa3);
                pv_tile(o, vb0 + buf * SHM_V, pa0, pa1, pa2, pa3);
            }
        }
        if (j + 1 < a.j_hi) FL_WRITE(buf ^ 1);
        __syncthreads();
    }
#undef FL_LOAD
#undef FL_WRITE
}

__device__ __forceinline__ void fox_attn_phase(KP p, LAS unsigned char* lds, int layer) {
    const int wid = __builtin_amdgcn_readfirstlane(threadIdx.x >> 6);
    unsigned char* ws = p->ws;
    const bf16_t* Q = (const bf16_t*)(ws + WS_A); const bf16_t* K = Q + (size_t)S_ * DM; const bf16_t* V = K + (size_t)S_ * DM; bf16_t* O = (bf16_t*)(V + (size_t)S_ * DM);
    const float* cumall = (const float*)(ws + WS_CUM);
    const unsigned* nrm = (const unsigned*)(ws + WS_NRM) + layer * 32;
    LAS float* li_l = (LAS float*)(lds + L_WS) + wid * 64;
    LAS int* jl = (LAS int*)(lds + L_CK + 1024);
    for (int I = blockIdx.x; I < 1024; I += gridDim.x) {
        const int kk = I >> 8, qbi = (I >> 4) & 63, h = ((I & 15) + 5 * kk) & 15;
        const int c_ = qbi & 15; const int qb = kk == 0 ? 63 - c_ : (kk == 1 ? c_ : (kk == 2 ? 47 - c_ : 16 + c_));
        {
            int tid_ = threadIdx.x; asm volatile("" : "+v"(tid_));
            const int lane = tid_ & 63, r32 = lane & 31, hi = lane >> 5;
            const int t_w0 = qb * 256 + wid * 32, t_lane = t_w0 + r32;
            const float* cum = cumall + (size_t)h * S_;
            const float B2 = 2.f * sqrtf(__uint_as_float(nrm[h * 2]) * __uint_as_float(nrm[h * 2 + 1])) * 1.01f;
            const float T = cum[qb * 256] + 110.f + B2;
            __syncthreads();
            { const bool ok = (tid_ < qb * 4 + 4) && (cum[64 * (tid_ < 256 ? tid_ : 0) + 63] <= T);
              const unsigned long long bm = __ballot(ok);
              if (lane == 0) jl[wid] = bm ? wid * 64 + (__ffsll((long long)bm) - 1) : (1 << 30); }
            __syncthreads();
            int j_lo = jl[0];
#pragma unroll
            for (int w = 1; w < 8; ++w) j_lo = min(j_lo, jl[w]);
            j_lo = __builtin_amdgcn_readfirstlane(j_lo);
            if (j_lo > qb * 4) j_lo = qb * 4;
            bf16x8 qr[8];
#pragma unroll
            for (int d0 = 0; d0 < 8; ++d0) qr[d0] = *(const bf16x8*)(Q + (size_t)t_lane * DM + h * 128 + d0 * 16 + hi * 8);
            FL a; a.K = K + h * 128; a.V = V + h * 128; a.kstride = DM; a.vstride = DM; a.j_lo = j_lo; a.j_hi = qb * 4 + 4;
            a.cum = cum; a.cq = cum[t_lane]; a.t_lane = t_lane; a.t_w0 = t_w0; a.lut = nullptr; a.imp = nullptr;
            float m = -1e30f, l = 0.f; f32x16 o[4];
#pragma unroll
            for (int d_ = 0; d_ < 4; ++d_)
#pragma unroll
                for (int r = 0; r < 16; ++r) o[d_][r] = 0.f;
            flash_loop<0>(lds, a, qr, m, l, o, 0.f);
            if (hi == 0) li_l[r32] = l; asm volatile("s_waitcnt lgkmcnt(0)" ::: "memory");
            bf16_t* Ow = O + (size_t)t_w0 * DM + h * 128;
            int lo_ = 4 * hi * DM + r32; asm volatile("" : "+v"(lo_));
#pragma unroll
            for (int r = 0; r < 16; ++r) { const int orow = crow(r, hi); const float rli = __builtin_amdgcn_rcpf(li_l[orow]);
#pragma unroll
                for (int d0 = 0; d0 < 4; ++d0) { const float v = o[d0][r] * rli; const float vn = __shfl_xor(v, 1);
                    if ((r32 & 1) == 0) *(unsigned*)(Ow + (lo_ + ((r & 3) + 8 * (r >> 2)) * DM + d0 * 32)) = cvt_pk_bf16(v, vn); } }
        }
    }
}

__device__ __forceinline__ void nsa_attn_phase(KP p, LAS unsigned char* lds) {
    const int tid = threadIdx.x, wid = __builtin_amdgcn_readfirstlane(tid >> 6);
    unsigned char* ws = p->ws;
    const bf16_t* Q = (const bf16_t*)(ws + WS_A); bf16_t* attn = (bf16_t*)(ws + WS_A) + (size_t)S_ * DM; __half* imp = (__half*)(ws + WS_A + 128 * MiB);
    float* partial = (float*)(ws + WS_PRE); const float* gates = (const float*)(ws + WS_GATE);
    const bf16_t* kv = (const bf16_t*)(ws + WS_KV); const bf16_t* kc = (const bf16_t*)(ws + WS_KC); const bf16_t* vc = (const bf16_t*)(ws + WS_VC);
    const bf16_t* vt = (const bf16_t*)(ws + WS_VT); const bf16_t* kfr = (const bf16_t*)(ws + WS_KF); const float* lutg = (const float*)(ws + WS_LUT);
    LAS float* lut = (LAS float*)(lds + L_LUT);
    LAS float* li_l = (LAS float*)(lds + L_WS) + wid * 64;
    const float NEG = -__builtin_inff();
    int g_loaded = -1;
    for (int it = blockIdx.x; it < 1024; it += gridDim.x) {
        const int g = it & 3, tile = 2 * (it >> 3) + ((it >> 2) & 1);
        if (g != g_loaded) {
            __syncthreads();
            for (int i = tid; i < 4 * 2048; i += 512) lut[i] = lutg[g * 4 * 2048 + i];
            __syncthreads();
            g_loaded = g;
        }
        {
            const int t0 = tile * 64;
            {
                const int r = wid & 3, th = wid >> 2, h = g * 4 + r;
                int tid_ = threadIdx.x; asm volatile("" : "+v"(tid_));
                const int lane = tid_ & 63, r32 = lane & 31, hi = lane >> 5;
                const int t_w0 = t0 + 32 * th, t_lane = t_w0 + r32;
                bf16x8 qr[8];
#pragma unroll
                for (int d0 = 0; d0 < 8; ++d0) qr[d0] = *(const bf16x8*)(Q + (size_t)t_lane * DM + h * 128 + d0 * 16 + hi * 8);
                const float g0 = gates[(size_t)t_lane * 48 + h * 3 + 0], g2 = gates[(size_t)t_lane * 48 + h * 3 + 2];
                FL a; a.K = kc + (size_t)g * 1024 * 128; a.V = vc + (size_t)g * 1024 * 128; a.kstride = 128; a.vstride = 128; a.j_lo = 0; a.j_hi = (t0 / 16 + 2) / 64 + 1;
                a.cum = nullptr; a.cq = 0.f; a.t_lane = t_lane; a.t_w0 = t_w0; a.lut = lut + r * 2048; a.imp = imp + ((size_t)h * S_ + t_lane) * 256;
                float m = -1e30f, l = 0.f; f32x16 o[4];
#pragma unroll
                for (int d_ = 0; d_ < 4; ++d_)
#pragma unroll
                    for (int rr = 0; rr < 16; ++rr) o[d_][rr] = 0.f;
                flash_loop<1>(lds, a, qr, m, l, o, 0.f);
                const float inv_l = l > 0.f ? 1.f / l : 0.f;
                flash_loop<2>(lds, a, qr, m, l, o, inv_l);
                float* Pw = partial + (size_t)t_w0 * DM + h * 128;
                int lo_ = 4 * hi * DM + r32; asm volatile("" : "+v"(lo_));
                if (hi == 0) li_l[r32] = g0; asm volatile("s_waitcnt lgkmcnt(0)" ::: "memory");
#pragma unroll
                for (int rr = 0; rr < 16; ++rr) { const int orow = crow(rr, hi); const float f = li_l[orow];
#pragma unroll
                    for (int d0 = 0; d0 < 4; ++d0) Pw[lo_ + ((rr & 3) + 8 * (rr >> 2)) * DM + d0 * 32] = o[d0][rr] * f; }
                a.K = kv + 4 * 512 + g * 128; a.V = kv + 5 * 512 + g * 128; a.kstride = NKV; a.vstride = NKV; a.j_lo = tile >= 8 ? tile - 8 : 0; a.j_hi = tile + 1;
                m = -1e30f; l = 0.f;
#pragma unroll
                for (int d_ = 0; d_ < 4; ++d_)
#pragma unroll
                    for (int rr = 0; rr < 16; ++rr) o[d_][rr] = 0.f;
                flash_loop<3>(lds, a, qr, m, l, o, 0.f);
                asm volatile("s_waitcnt lgkmcnt(0)" ::: "memory");
                int lo2_ = 4 * hi * DM + r32; asm volatile("" : "+v"(lo2_));
                if (hi == 0) li_l[r32] = g2 * (l > 0.f ? 1.f / l : 0.f); asm volatile("s_waitcnt lgkmcnt(0)" ::: "memory");
#pragma unroll
                for (int rr = 0; rr < 16; ++rr) { const int orow = crow(rr, hi); const float f = li_l[orow];
#pragma unroll
                    for (int d0 = 0; d0 < 4; ++d0) { float* pp = Pw + (lo2_ + ((rr & 3) + 8 * (rr >> 2)) * DM + d0 * 32); *pp = *pp + o[d0][rr] * f; } }
            }
            __syncthreads();
            LAS int* selbuf = (LAS int*)(lds + L_END);
            LAS unsigned* bmw = (LAS unsigned*)(lds + L_END + 4096) + wid * 8;
            LAS unsigned char* listw = (LAS unsigned char*)(lds + L_END + 4096 + 256) + wid * 256;
#pragma nounroll
            for (int tt = 0; tt < 8; ++tt) {
                int tid_ = threadIdx.x; asm volatile("" : "+v"(tid_));
                const int lane = tid_ & 63;
                const int t = t0 + 8 * wid + tt; const int blk = tile;
                float sc[4] = {0.f, 0.f, 0.f, 0.f};
#pragma unroll
                for (int r = 0; r < 4; ++r) { const u32x2 raw = *(const u32x2*)(imp + ((size_t)(g * 4 + r) * S_ + t) * 256 + lane * 4);
                    sc[0] += __half2float(__ushort_as_half((unsigned short)(raw.x & 0xffffu))); sc[1] += __half2float(__ushort_as_half((unsigned short)(raw.x >> 16)));
                    sc[2] += __half2float(__ushort_as_half((unsigned short)(raw.y & 0xffffu))); sc[3] += __half2float(__ushort_as_half((unsigned short)(raw.y >> 16))); }
#pragma unroll
                for (int e = 0; e < 4; ++e) { const int j = lane * 4 + e; const bool forced = (j == 0) | (j == blk) | (j == blk - 1);
                    sc[e] = forced ? 1e4f : (j <= blk ? sc[e] : -1.f); }
                int mysel = -1;
#pragma nounroll
                for (int k = 0; k < 16; ++k) {
                    float bv = sc[0]; int be = 0;
#pragma unroll
                    for (int e = 1; e < 4; ++e) if (sc[e] > bv) { bv = sc[e]; be = e; }
                    const float wmax = wave_max_fast(bv);
                    if (wmax < 0.f) break;
                    const unsigned long long msk = __ballot(bv == wmax);
                    const int src = __ffsll((long long)msk) - 1;
                    const int jw = __builtin_amdgcn_readlane(lane * 4 + be, src);
                    if (lane == k) mysel = jw;
                    if (lane == src) {
#pragma unroll
                        for (int e = 0; e < 4; ++e) if (be == e) sc[e] = -2.f; }
                }
                if (lane < 16) selbuf[(8 * wid + tt) * 16 + lane] = mysel;
            }
            asm volatile("s_waitcnt lgkmcnt(0)" ::: "memory");
#pragma nounroll
            for (int cgi = 0; cgi < 2; ++cgi) {
                int tid_ = threadIdx.x; asm volatile("" : "+v"(tid_));
                const int lane = tid_ & 63, n = lane & 15, kq = lane >> 4, hn = n & 3, tq = n >> 2;
                const LAS float* lutn = lut + hn * 2048;
                const int pk = selbuf[(8 * wid + cgi * 4 + (lane >> 4)) * 16 + (lane & 15)];
                if (lane < 8) bmw[lane] = 0u;
                asm volatile("s_waitcnt lgkmcnt(0)" ::: "memory");
                if (pk >= 0) atomicOr((unsigned*)(bmw + (pk >> 5)), 1u << (pk & 31));
                asm volatile("s_waitcnt vmcnt(0) lgkmcnt(0)" ::: "memory");
                int nl = 0;
#pragma unroll
                for (int c = 0; c < 4; ++c) { const unsigned long long mc = (unsigned long long)bmw[2 * c] | ((unsigned long long)bmw[2 * c + 1] << 32);
                    if ((mc >> lane) & 1ull) listw[nl + __builtin_popcountll(mc & ((1ull << lane) - 1ull))] = (unsigned char)(64 * c + lane);
                    nl += __builtin_popcountll(mc); }
                nl = __builtin_amdgcn_readfirstlane(nl);
                asm volatile("s_waitcnt lgkmcnt(0)" ::: "memory");
                const int tcol = t0 + 8 * wid + cgi * 4 + tq;
                bf16x8 qb[4];
#pragma unroll
                for (int ks = 0; ks < 4; ++ks) qb[ks] = *(const bf16x8*)(Q + (size_t)tcol * DM + (g * 4 + hn) * 128 + 32 * ks + kq * 8);
                const float g1 = gates[(size_t)tcol * 48 + (g * 4 + hn) * 3 + 1];
                float m = -1e30f, l = 0.f; f32x4 o[8];
#pragma unroll
                for (int d_ = 0; d_ < 8; ++d_) o[d_] = (f32x4){0.f, 0.f, 0.f, 0.f};
                bf16x8 kf[16], vf[16];
                const bf16_t* Kg = kfr + (size_t)g * 256 * 8192 + lane * 8;
                const bf16_t* Vg = vt + (size_t)g * 256 * 8192 + lane * 8;
                int sb = __builtin_amdgcn_readfirstlane((int)listw[0]);
                { const bf16_t* Kp = Kg + (size_t)sb * 8192;
#pragma unroll
                  for (int f = 0; f < 16; ++f) kf[f] = *(const bf16x8*)(Kp + f * 512); }
#pragma nounroll
                for (int b = 0; b < nl; ++b) {
                    const int sbn = __builtin_amdgcn_readfirstlane((int)listw[b + 1 < nl ? b + 1 : b]);
                    { const bf16_t* Vp = Vg + (size_t)sb * 8192;
#pragma unroll
                      for (int f = 0; f < 16; ++f) vf[f] = *(const bf16x8*)(Vp + f * 512); }
                    const unsigned long long bal = __ballot(pk == sb);
                    const bool colpick = ((bal >> (16 * tq)) & 0xFFFFull) != 0ull;
                    SBAR();
                    f32x4 s[4];
#pragma unroll
                    for (int sub = 0; sub < 4; ++sub) { s[sub] = (f32x4){0.f, 0.f, 0.f, 0.f};
#pragma unroll
                        for (int ks = 0; ks < 4; ++ks) s[sub] = __builtin_amdgcn_mfma_f32_16x16x32_bf16(kf[sub * 4 + ks], qb[ks], s[sub], 0, 0, 0); }
                    SBAR();
                    { const bf16_t* Kp = Kg + (size_t)sbn * 8192;
#pragma unroll
                      for (int f = 0; f < 16; ++f) kf[f] = *(const bf16x8*)(Kp + f * 512); }
                    SBAR();
                    const int dq = tcol - sb * 64 - 4 * kq; float pmax = NEG;
#pragma unroll
                    for (int sub = 0; sub < 4; ++sub)
#pragma unroll
                        for (int i = 0; i < 4; ++i) { const int d = dq - 16 * sub - i; const unsigned idx = (unsigned)d < 2047u ? (unsigned)d : 2047u;
                            const float v = (colpick && d >= 0) ? s[sub][i] + lutn[idx] : NEG; s[sub][i] = v; pmax = fmaxf(pmax, v); }
                    if (!__all(pmax <= m + 8.f)) {
                        pmax = fmaxf(pmax, __shfl_xor(pmax, 16)); pmax = fmaxf(pmax, __shfl_xor(pmax, 32));
                        const float mn = fmaxf(m, pmax); const float alpha = __builtin_amdgcn_exp2f((m - mn) * L2E); m = mn; l *= alpha;
#pragma unroll
                        for (int d_ = 0; d_ < 8; ++d_) o[d_] = o[d_] * alpha; }
                    const float mnL = -m * L2E; float ps = 0.f;
#pragma unroll
                    for (int sub = 0; sub < 4; ++sub)
#pragma unroll
                        for (int i = 0; i < 4; ++i) { s[sub][i] = __builtin_amdgcn_exp2f(fmaf(s[sub][i], L2E, mnL)); ps += s[sub][i]; }
                    l += ps;
                    bf16x8 pb[2];
                    { const u32x4 w0 = pack8bf(s[0], s[1]), w1 = pack8bf(s[2], s[3]); pb[0] = *reinterpret_cast<const bf16x8*>(&w0); pb[1] = *reinterpret_cast<const bf16x8*>(&w1); }
                    SBAR();
#pragma unroll
                    for (int d_ = 0; d_ < 8; ++d_)
#pragma unroll
                        for (int s2 = 0; s2 < 2; ++s2) o[d_] = __builtin_amdgcn_mfma_f32_16x16x32_bf16(vf[d_ * 2 + s2], pb[s2], o[d_], 0, 0, 0);
                    sb = sbn;
                }
                l += __shfl_xor(l, 16); l += __shfl_xor(l, 32);
                const float f = g1 * (l > 0.f ? 1.f / l : 0.f);
#pragma unroll
                for (int d_ = 0; d_ < 8; ++d_) { const size_t off = (size_t)tcol * DM + (g * 4 + hn) * 128 + 16 * d_ + 4 * kq;
                    const f32x4 pp = *(const f32x4*)(partial + off); const f32x4 r4 = pp + o[d_] * f;
                    u32x2 w; w.x = cvt_pk_bf16(r4[0], r4[1]); w.y = cvt_pk_bf16(r4[2], r4[3]); *(u32x2*)(attn + off) = w; }
            }
        }
    }
}


#define XB_TMO      128
#define XB_XCNT(j)  (256  + 64 * (j))
#define XB_XSUB(j)  (1280 + 64 * (j))
#define XB_XGEN(j)  (2304 + 64 * (j))
#define XB_TOP      3328
#define XB_TOPGEN   3392
#define XCD_BAR_WORDS 3456
#define XB_SPIN_CAP (1u << 18)
__device__ __forceinline__ unsigned xb_ld(unsigned* p)              { return __hip_atomic_load(p, __ATOMIC_RELAXED, __HIP_MEMORY_SCOPE_AGENT); }
__device__ __forceinline__ unsigned xb_add(unsigned* p, unsigned v) { return __hip_atomic_fetch_add(p, v, __ATOMIC_RELAXED, __HIP_MEMORY_SCOPE_AGENT); }
__device__ __forceinline__ unsigned xb_xcc_id() { return (unsigned)__builtin_amdgcn_s_getreg((3 << 11) | 20) & 0xFu; }
#define XB_SPIN(cond, bar) do { unsigned _sp = 0; while (cond) { __builtin_amdgcn_s_sleep(1); \
    if ((++_sp & 255u) == 0u) { if (xb_ld(&(bar)[XB_TMO])) break; if (_sp > XB_SPIN_CAP) { atomicAdd(&(bar)[XB_TMO], 1u); break; } } } } while (0)

struct XcdBarrier {
    unsigned* bar; unsigned x;
    volatile LAS unsigned* st;
};

__device__ __forceinline__ XcdBarrier xcd_barrier_post(unsigned* bar, volatile LAS unsigned* st) {
    XcdBarrier b; b.bar = bar; b.x = xb_xcc_id(); b.st = st;
    if (threadIdx.x == 0) (void)xb_add(&bar[XB_XCNT(b.x)], 1u);
    return b;
}
__device__ __forceinline__ void xcd_barrier_complete(unsigned* bar, unsigned x, unsigned& nloc, unsigned& nx) {
    const unsigned G = gridDim.x * gridDim.y * gridDim.z;
    unsigned sum, cnt, mine, sp = 0u;
    for (;;) {
        sum = 0u; cnt = 0u; mine = 0u;
#pragma unroll
        for (unsigned j = 0; j < 16; ++j) { const unsigned c = xb_ld(&bar[XB_XCNT(j)]); sum += c; cnt += (c > 0u) ? 1u : 0u; mine = (j == x) ? c : mine; }
        if (sum == G) break;
        __builtin_amdgcn_s_sleep(1);
        if ((++sp & 255u) == 0u) { if (xb_ld(&bar[XB_TMO])) break; if (sp > XB_SPIN_CAP) { atomicAdd(&bar[XB_TMO], 1u); break; } }
    }
    nloc = mine > 0u ? mine : 1u; nx = cnt > 0u ? cnt : 1u;
}

__device__ __forceinline__ void xcd_barrier(const XcdBarrier& b) {
    asm volatile("s_waitcnt vmcnt(0)" ::: "memory");
    __syncthreads();
    if (threadIdx.x == 0) {
        unsigned* bar = b.bar;
        __builtin_amdgcn_s_waitcnt(0);
        unsigned nloc = b.st[0], nx = b.st[1];
        if (nloc == 0u) { xcd_barrier_complete(bar, b.x, nloc, nx); b.st[0] = nloc; b.st[1] = nx; }
        const unsigned old = xb_add(&bar[XB_XSUB(b.x)], 1u);
        const unsigned gen = old / nloc;
        if (old + 1u == (gen + 1u) * nloc) {
            __builtin_amdgcn_fence(__ATOMIC_RELEASE, "agent");
            asm volatile("s_waitcnt vmcnt(0)" ::: "memory");
            const unsigned og = xb_add(&bar[XB_TOP], 1u);
            const unsigned tg = og / nx;
            if (og + 1u == (tg + 1u) * nx) xb_add(&bar[XB_TOPGEN], 1u);
            else XB_SPIN(xb_ld(&bar[XB_TOPGEN]) == tg, bar);
            __builtin_amdgcn_fence(__ATOMIC_ACQUIRE, "agent");
            xb_add(&bar[XB_XGEN(b.x)], 1u);
            asm volatile("s_waitcnt vmcnt(0)" ::: "memory");
        } else {
            XB_SPIN(xb_ld(&bar[XB_XGEN(b.x)]) == gen, bar);
            __builtin_amdgcn_fence(__ATOMIC_ACQUIRE, "agent");
            asm volatile("s_waitcnt vmcnt(0)" ::: "memory");
        }
    }
    __syncthreads();
}


#define RUN_GEMM2(EpiT, epi, Aptr, Btptr, Mv, Nv, Kv, ldav, ldbv, cidx) do { const pg8::Gemm g_{(Aptr), (Btptr), (Mv), (Nv), (Kv), (ldav), (ldbv)}; pg8::StaticOrder so_; so_.init((Mv), (Nv), (int)gridDim.x, (cidx)); \
        pg8::gemm_phase<EpiT, pg8::StaticOrder, true, true>(lds, g_, so_, (epi)); } while (0)
#define RUN_GEMM(EpiT, epi, Aptr, Btptr, Mv, Nv, Kv, ldav, cidx) RUN_GEMM2(EpiT, epi, Aptr, Btptr, Mv, Nv, Kv, ldav, Kv, cidx)

__global__ void __launch_bounds__(512, 2) mega_fwd(Params p_unused) {
    extern __shared__ __attribute__((aligned(16))) unsigned char lds_raw[];
    LAS unsigned char* lds = (LAS unsigned char*)lds_raw;
    cg::grid_group grid = cg::this_grid();
    const size_t SD = (size_t)S_ * DM;
#define WSP(off) (KARGS()->ws + (off))
    LAS unsigned* bst = (LAS unsigned*)(lds + LDS_BYTES - 16);
    if (threadIdx.x < 4) bst[threadIdx.x] = 0u;
    __syncthreads();
    (void)xcd_barrier_post((unsigned*)(KARGS()->ws + WS_BAR), (volatile LAS unsigned*)bst);
#define GSYNC() do { XcdBarrier b_; b_.bar = (unsigned*)(KARGS()->ws + WS_BAR); b_.x = xb_xcc_id(); b_.st = (volatile LAS unsigned*)bst; xcd_barrier(b_); } while (0)
    prologue(KARGS(), lds);
    grid.sync();
#pragma nounroll
    for (int L = 0; L < 4; ++L) {
        const int bid = (int)blockIdx.x, G = (int)gridDim.x;
        if (L < 2) {
            { KP p = KARGS(); unsigned char* ws = p->ws; bf16_t* A0 = (bf16_t*)(ws + WS_A);
              EpiFoxQKV E{A0, (float*)(ws + WS_FLOG), p->in[I_FOXBF] + L * 16};
              RUN_GEMM(EpiFoxQKV, E, (const bf16_t*)(ws + WS_HBF), (const bf16_t*)(ws + WS_WFOXIN) + (size_t)L * NFOX * DM, S_, NFOX, DM, DM, bid); }
            GSYNC();
            scan_phase(KARGS(), lds, L == 0, L);
            GSYNC();
            fox_attn_phase(KARGS(), lds, L);
            GSYNC();
        } else {
            if (L == 2) {
                { KP p = KARGS(); unsigned char* ws = p->ws;
                  EpiKV E{(bf16_t*)(ws + WS_KV), (bf16_t*)(ws + WS_RAWK), (bf16_t*)(ws + WS_RAWV), (bf16_t*)(ws + WS_VT), (bf16_t*)(ws + WS_KF)};
                  RUN_GEMM(EpiKV, E, (const bf16_t*)(ws + WS_HBF), (const bf16_t*)(ws + WS_WKV), S_, NKV, DM, DM, bid); }
                GSYNC();
#pragma nounroll
                for (int idx = 0; idx < 16; ++idx) { KP p = KARGS(); unsigned char* ws = p->ws; const int mat = idx >> 3, ch = idx & 7;
                    EpiPart E{(float*)(ws + WS_CPART) + (size_t)idx * 4096 * 256};
                    RUN_GEMM2(EpiPart, E, (const bf16_t*)(ws + (mat ? WS_RAWV : WS_RAWK)) + ch * 512, (const bf16_t*)(ws + WS_WC1) + (size_t)mat * 256 * 4096 + ch * 512, 4096, 256, 512, 2048, 4096, (bid + G - 16 * idx) % G);
                }
                GSYNC();
                cmp2_phase(KARGS(), lds);
                GSYNC();
            }
            { KP p = KARGS(); unsigned char* ws = p->ws;
              EpiNsaQ E{(bf16_t*)(ws + WS_A), (float*)(ws + WS_GATE)};
              RUN_GEMM(EpiNsaQ, E, (const bf16_t*)(ws + WS_HBF), (const bf16_t*)(ws + WS_WNSAIN) + (size_t)(L - 2) * NNSA * DM, S_, NNSA, DM, DM, bid); }
            GSYNC();
            nsa_attn_phase(KARGS(), lds);
            GSYNC();
        }
        { KP p = KARGS(); unsigned char* ws = p->ws; bf16_t* A0 = (bf16_t*)(ws + WS_A);
          const float* hres = L == 0 ? p->in[I_X] : p->out;
          const bf16_t* attn = L < 2 ? A0 + 3 * SD : A0 + SD;
          const bf16_t* wo = L < 2 ? (const bf16_t*)(ws + WS_WFOXO) + (size_t)L * DM * DM : (const bf16_t*)(ws + WS_WNSAO) + (size_t)(L - 2) * DM * DM;
          EpiRes E{hres, (float*)(ws + WS_PRE)}; RUN_GEMM(EpiRes, E, attn, wo, S_, DM, DM, DM, bid); }
        GSYNC();
        { KP p = KARGS(); ln_phase((const float*)(p->ws + WS_PRE), p->in[I_LN1G] + L * DM, p->in[I_LN1B] + L * DM, p->out, (bf16_t*)(p->ws + WS_HBF)); }
        GSYNC();
        { KP p = KARGS(); unsigned char* ws = p->ws;
          EpiRelu2 E{(bf16_t*)(ws + WS_A)}; RUN_GEMM(EpiRelu2, E, (const bf16_t*)(ws + WS_HBF), (const bf16_t*)(ws + WS_W1) + (size_t)L * FF * DM, S_, FF, DM, DM, bid); }
        GSYNC();
        { KP p = KARGS(); unsigned char* ws = p->ws;
          EpiRes E{p->out, (float*)(ws + WS_PRE)}; RUN_GEMM(EpiRes, E, (const bf16_t*)(ws + WS_A), (const bf16_t*)(ws + WS_W2) + (size_t)L * DM * FF, S_, DM, FF, FF, bid); }
        GSYNC();
        { KP p = KARGS(); ln_phase((const float*)(p->ws + WS_PRE), p->in[I_LN2G] + L * DM, p->in[I_LN2B] + L * DM, p->out, (bf16_t*)(p->ws + WS_HBF)); }
        GSYNC();
    }
}

extern "C" void kernel_launch(void* const* d_in, const int* in_sizes, int n_in, void* d_out, int out_size, void* d_ws, size_t ws_size, hipStream_t stream) {
    static int grid = 0;
    if (grid == 0) {
        if (n_in != 20 || out_size != S_ * DM || ws_size < WS_END) { fprintf(stderr, "kernel_launch: unexpected shapes (n_in %d out %d ws %zu)\n", n_in, out_size, ws_size); grid = -1; return; }
        int dev = 0, cus = 0, per_cu = 0;
        (void)hipGetDevice(&dev); (void)hipDeviceGetAttribute(&cus, hipDeviceAttributeMultiprocessorCount, dev);
        if (hipFuncSetAttribute((const void*)mega_fwd, hipFuncAttributeMaxDynamicSharedMemorySize, LDS_BYTES) != hipSuccess) fprintf(stderr, "kernel_launch: hipFuncSetAttribute failed\n");
        if (hipOccupancyMaxActiveBlocksPerMultiprocessor(&per_cu, (const void*)mega_fwd, 512, LDS_BYTES) != hipSuccess || per_cu < 1) per_cu = 1;
        (void)hipGetLastError();
        if (cus <= 0) cus = 256;
        grid = cus * per_cu;
    }
    if (grid < 0) return;
    Params p{};
    for (int i = 0; i < 20; ++i) p.in[i] = (const float*)d_in[i];
    p.out = (float*)d_out; p.ws = (unsigned char*)d_ws;
    (void)hipMemsetAsync((unsigned char*)d_ws + WS_BAR, 0, 16384, stream);
    void* args[] = {&p};
    hipError_t e = hipLaunchCooperativeKernel((const void*)mega_fwd, dim3(grid), dim3(512), args, LDS_BYTES, stream);
    if (e != hipSuccess) fprintf(stderr, "kernel_launch: cooperative launch failed: %s (grid %d)\n", hipGetErrorString(e), grid);
}
```

```cpp
#include <hip/hip_runtime.h>
#include <hip/hip_cooperative_groups.h>
#include <hip/hip_fp16.h>
#include <cstdio>
#include <cstdint>
namespace cg = cooperative_groups;
namespace pg8 {
#define PG8_LAS __attribute__((address_space(3)))
typedef unsigned short bf16_t;
typedef short bf16x8 __attribute__((ext_vector_type(8)));
typedef float f32x4 __attribute__((ext_vector_type(4)));
typedef unsigned u32x4 __attribute__((ext_vector_type(4)));
constexpr int BM = 256, BK = 64, HALF = 128, HTB = HALF * BK * 2  , STAGE_BYTES = 8 * HTB, NXCD = 8, WGM = 8;

__host__ __device__ __forceinline__ int lds_byte(int r, int c) { const int st = (r >> 4) * 2 + (c >> 5), rr = r & 15, cc = c & 31, ob = rr * 64 + cc * 2; return st * 1024 + (ob ^ (((ob >> 9) & 1) << 5)); }
__host__ __device__ __forceinline__ void stage_rc(int b, int& R, int& C) { const int st = b / 1024, sb = b % 1024, swz = sb ^ (((sb >> 9) & 1) << 5); R = (st >> 1) * 16 + swz / 64; C = (st & 1) * 32 + (swz % 64) / 2; }
__host__ __device__ __forceinline__ int perm32(int rho) { const int n = rho >> 4, i = rho & 15; return 8 * (i >> 2) + 4 * n + (i & 3); }

struct Unit { int pm, pn; };
struct Gemm { const bf16_t* A; const bf16_t* Bt; int M, N, K, lda, ldb; };

struct StaticOrder {
    int nM, nN, nwg, G, c;
    __host__ __device__ void init(int M, int N, int G_, int c_) { nM = M / BM; nN = N / BM; nwg = nM * nN; G = G_; c = c_; }
    __host__ __device__ bool next(int i, Unit& u) const {
        const long L = (long)i * G + c; if (L >= nwg) return false;
        int wgid = (int)L; { const int q = nwg / NXCD, r = nwg % NXCD, xcd = wgid % NXCD, off = wgid / NXCD; wgid = (xcd < r ? xcd * (q + 1) : r * (q + 1) + (xcd - r) * q) + off; }
        const int nig = WGM * nN, gid = wgid / nig, fm = gid * WGM, gsz = (nM - fm) < WGM ? (nM - fm) : WGM;
        u.pm = fm + ((wgid % nig) % gsz); u.pn = (wgid % nig) / gsz; return true;
    }
    __device__ __forceinline__ void a_ready(const Unit&) const {}
    __device__ __forceinline__ void done(const Unit&) const {}
};


__device__ __forceinline__ unsigned cvt_pk_bf16(float lo, float hi) { unsigned r; asm volatile("v_cvt_pk_bf16_f32 %0, %1, %2" : "=v"(r) : "v"(lo), "v"(hi)); return r; }
typedef float f32x2 __attribute__((ext_vector_type(2)));
template <class Epi, class Sched, bool ALIGN_EPI = false, bool SP2 = false>
__device__ __forceinline__ void gemm_phase(PG8_LAS unsigned char* lds, const Gemm g, const Sched& S, const Epi& E) {
    int tid_ = threadIdx.x; asm volatile("" : "+v"(tid_));
    const int tid = tid_, wid = __builtin_amdgcn_readfirstlane(tid >> 6), lane = tid & 63, wr = wid >> 2, wc = wid & 3, fr = lane & 15, fq = lane >> 4;
    const int K = g.K, nt = K / BK;
    unsigned voffA[2], voffB[2];
#pragma unroll
    for (int i = 0; i < 2; ++i) { int R, C; stage_rc(tid * 16 + i * 8192, R, C); const int Rb = Epi::PERM ? ((R & ~31) + perm32(R & 31)) : R;
        voffA[i] = (unsigned)(R * g.lda + C) * 2u; voffB[i] = (unsigned)(Rb * g.ldb + C) * 2u; }
    const size_t kstep = (size_t)(BK * 2);
    const size_t hstepB = (size_t)HALF * g.ldb * 2, hstepA = (size_t)HALF * g.lda * 2;
    const size_t tstepB = 2 * hstepB, tstepA = 2 * hstepA;
    const unsigned ldsw = (unsigned)wid * 1024u;
    const int aoff = lds_byte(wr * 64 + fr, fq * 8), boff = lds_byte(wc * 32 + fr, fq * 8);
#define PG8_SA(b, h) (((b) * 2 + (h)) * HTB)
#define PG8_SB(b, h) ((4 + (b) * 2 + (h)) * HTB)
#define PG8_STAGE(bufoff, gbase, voff) do { _Pragma("unroll") for (int _i = 0; _i < 2; ++_i) \
        __builtin_amdgcn_global_load_lds((const unsigned*)((const char*)(gbase) + (voff)[_i]), (PG8_LAS unsigned*)(lds + (bufoff) + ldsw + _i * 8192), 16, 0, 0); } while (0)
#define PG8_LDA(dst, b, h) do { _Pragma("unroll") for (int m = 0; m < 4; ++m) _Pragma("unroll") for (int k = 0; k < 2; ++k) dst[m][k] = *(const PG8_LAS bf16x8*)(lds + PG8_SA(b, h) + aoff + m * 2048 + k * 1024); } while (0)
#define PG8_LDB(dst, b, h) do { _Pragma("unroll") for (int n = 0; n < 2; ++n) _Pragma("unroll") for (int k = 0; k < 2; ++k) dst[n][k] = *(const PG8_LAS bf16x8*)(lds + PG8_SB(b, h) + boff + n * 2048 + k * 1024); } while (0)
#define PG8_MMA(ai, bj, At, Bt) do { __builtin_amdgcn_s_setprio(1); _Pragma("unroll") for (int m = 0; m < 4; ++m) _Pragma("unroll") for (int n = 0; n < 2; ++n) _Pragma("unroll") for (int k = 0; k < 2; ++k) \
        acc[ai][bj][m][n] = __builtin_amdgcn_mfma_f32_16x16x32_bf16(Bt[n][k], At[m][k], acc[ai][bj][m][n], 0, 0, 0); __builtin_amdgcn_s_setprio(0); } while (0)
#define PG8_WAIT_V(n) asm volatile("s_waitcnt vmcnt(" #n ")" ::: "memory")
#define PG8_WAIT_L(n) asm volatile("s_waitcnt lgkmcnt(" #n ")" ::: "memory")
#define PG8_BAR __builtin_amdgcn_s_barrier()
#define PG8_SCHED __builtin_amdgcn_sched_barrier(0)
    Unit cur, nxt; int ui = 0;
    if (!S.next(0, cur)) return;
    f32x4 acc[2][2][4][2];
#pragma unroll
    for (int a = 0; a < 2; ++a)
#pragma unroll
        for (int b = 0; b < 2; ++b)
#pragma unroll
            for (int m = 0; m < 4; ++m)
#pragma unroll
                for (int n = 0; n < 2; ++n) acc[a][b][m][n] = (f32x4){0.f, 0.f, 0.f, 0.f};
    bf16x8 At[4][2], B0[2][2], B1[2][2];
    const char* cA = (const char*)g.A + (size_t)cur.pm * tstepA; const char* cB = (const char*)g.Bt + (size_t)cur.pn * tstepB;
    S.a_ready(cur);
    if constexpr (SP2) {
        PG8_STAGE(PG8_SB(0, 0), cB, voffB); PG8_STAGE(PG8_SB(0, 1), cB + hstepB, voffB); PG8_STAGE(PG8_SA(0, 0), cA, voffA); PG8_STAGE(PG8_SA(0, 1), cA + hstepA, voffA);
        if (wr == 1) PG8_BAR;
        PG8_WAIT_V(2); PG8_BAR;
        PG8_STAGE(PG8_SB(1, 0), cB + kstep, voffB); PG8_STAGE(PG8_SA(1, 0), cA + kstep, voffA); PG8_STAGE(PG8_SB(1, 1), cB + hstepB + kstep, voffB);
        PG8_WAIT_V(6); PG8_BAR;
    } else {
        PG8_STAGE(PG8_SB(0, 0), cB, voffB); PG8_STAGE(PG8_SA(0, 0), cA, voffA); PG8_STAGE(PG8_SB(0, 1), cB + hstepB, voffB); PG8_STAGE(PG8_SA(0, 1), cA + hstepA, voffA);
        if (wr == 1) PG8_BAR;
        PG8_WAIT_V(4); PG8_BAR;
        PG8_STAGE(PG8_SB(1, 0), cB + kstep, voffB); PG8_STAGE(PG8_SA(1, 0), cA + kstep, voffA); PG8_STAGE(PG8_SB(1, 1), cB + hstepB + kstep, voffB);
        PG8_WAIT_V(6); PG8_BAR;
    }
    for (;;) {
        const bool has_next = S.next(ui + 1, nxt);
        const char* nA = has_next ? (const char*)g.A + (size_t)nxt.pm * tstepA : cA; const char* nB = has_next ? (const char*)g.Bt + (size_t)nxt.pn * tstepB : cB;
        for (int t = 0; t < nt; t += 2) {
            const bool last = (t == nt - 2);
            const char* a1 = cA + (size_t)(t + 1) * kstep;
            const char* a2 = last ? nA : cA + (size_t)(t + 2) * kstep; const char* b2 = last ? nB : cB + (size_t)(t + 2) * kstep;
            const char* a3 = a2 + kstep; const char* b3 = b2 + kstep;
            if (last && has_next) S.a_ready(nxt);
            if constexpr (SP2) {
            PG8_LDB(B0, 0, 0); PG8_LDB(B1, 0, 1); PG8_SCHED; PG8_LDA(At, 0, 0); PG8_STAGE(PG8_SA(1, 1), a1 + hstepA, voffA);
            PG8_WAIT_V(8); PG8_WAIT_L(0); PG8_BAR; PG8_MMA(0, 0, At, B0); PG8_MMA(0, 1, At, B1); PG8_BAR; PG8_SCHED;
            PG8_LDA(At, 0, 1); PG8_STAGE(PG8_SB(0, 0), b2, voffB); PG8_STAGE(PG8_SB(0, 1), b2 + hstepB, voffB); PG8_STAGE(PG8_SA(0, 0), a2, voffA);
            PG8_WAIT_V(8); PG8_WAIT_L(0); PG8_BAR; PG8_MMA(1, 0, At, B0); PG8_MMA(1, 1, At, B1); PG8_BAR; PG8_SCHED;
            PG8_LDB(B0, 1, 0); PG8_LDB(B1, 1, 1); PG8_SCHED; PG8_LDA(At, 1, 0); PG8_STAGE(PG8_SA(0, 1), a2 + hstepA, voffA);
            PG8_WAIT_V(8); PG8_WAIT_L(0); PG8_BAR; PG8_MMA(0, 0, At, B0); PG8_MMA(0, 1, At, B1); PG8_BAR; PG8_SCHED;
            PG8_LDA(At, 1, 1); PG8_STAGE(PG8_SB(1, 0), b3, voffB); PG8_STAGE(PG8_SB(1, 1), b3 + hstepB, voffB); PG8_STAGE(PG8_SA(1, 0), a3, voffA);
            PG8_WAIT_V(8); PG8_WAIT_L(0); PG8_BAR; PG8_MMA(1, 0, At, B0); PG8_MMA(1, 1, At, B1); PG8_BAR; PG8_SCHED;
            }
        }
        if constexpr (ALIGN_EPI) { if (wr == 0) PG8_BAR; }
        if constexpr (!Epi::AFTER_DRAIN) { E(acc, cur, wr, wc, fr, fq); S.done(cur); }
        if (!has_next) break;
#pragma unroll
        for (int a = 0; a < 2; ++a)
#pragma unroll
            for (int b = 0; b < 2; ++b)
#pragma unroll
                for (int m = 0; m < 4; ++m)
#pragma unroll
                    for (int n = 0; n < 2; ++n) acc[a][b][m][n] = (f32x4){0.f, 0.f, 0.f, 0.f};
        cur = nxt; cA = nA; cB = nB; ++ui;
        if constexpr (ALIGN_EPI) { if (wr == 1) PG8_BAR; }
    }
    PG8_WAIT_V(0);
    if constexpr (!ALIGN_EPI) { if (wr == 0) PG8_BAR; }
    PG8_BAR;
    if constexpr (Epi::AFTER_DRAIN) { E.fused(acc, cur, wr, wc, fr, fq, lds, wid, lane); S.done(cur); }
#undef PG8_SA
#undef PG8_SB
#undef PG8_STAGE
#undef PG8_LDA
#undef PG8_LDB
#undef PG8_MMA
#undef PG8_WAIT_V
#undef PG8_WAIT_L
#undef PG8_BAR
#undef PG8_SCHED
}
}

#define LAS __attribute__((address_space(3)))
using pg8::bf16_t; using pg8::bf16x8; using pg8::f32x4; using pg8::u32x4; using pg8::Unit; using pg8::cvt_pk_bf16;
typedef short s16x4 __attribute__((ext_vector_type(4)));
typedef float f32x16 __attribute__((ext_vector_type(16)));
typedef unsigned u32x2 __attribute__((ext_vector_type(2)));

constexpr int S_ = 16384, DM = 2048, FF = 8192, NH = 16, DH = 128, NG = 4;
constexpr int NFOX = 6400, NNSA = 2304, NKV = 3072;
constexpr float ALPHA_ = 1.6817928305074292f;
constexpr float QSCALE = 0.08838834764831845f;
constexpr float L2E = 1.4426950408889634f;
constexpr float LN_EPS_ = 1e-5f;

constexpr size_t MiB = 1u << 20;
constexpr size_t WS_WFOXIN = 0;
constexpr size_t WS_WFOXO  = 50 * MiB;
constexpr size_t WS_WNSAIN = 66 * MiB;
constexpr size_t WS_WNSAO  = 84 * MiB;
constexpr size_t WS_WKV    = 100 * MiB;
constexpr size_t WS_W1     = 112 * MiB;
constexpr size_t WS_W2     = 240 * MiB;
constexpr size_t WS_WC1    = 368 * MiB;
constexpr size_t WS_HBF    = 372 * MiB;
constexpr size_t WS_PRE    = 436 * MiB;
constexpr size_t WS_A      = 564 * MiB;
constexpr size_t WS_KV     = 820 * MiB;
constexpr size_t WS_RAWK   = 916 * MiB;
constexpr size_t WS_RAWV   = 933 * MiB;
constexpr size_t WS_VT     = 950 * MiB;
constexpr size_t WS_CH     = 966 * MiB;
constexpr size_t WS_KC     = 970 * MiB;
constexpr size_t WS_VC     = 971 * MiB;
constexpr size_t WS_CUM    = 972 * MiB;
constexpr size_t WS_FLOG   = 973 * MiB;
constexpr size_t WS_GATE   = 974 * MiB;
constexpr size_t WS_LUT    = 977 * MiB;
constexpr size_t WS_CBP    = 977 * MiB + 256 * 1024;
constexpr size_t WS_CB     = 977 * MiB + 512 * 1024;
constexpr size_t WS_NRM    = 977 * MiB + 768 * 1024;
constexpr size_t WS_KF     = 978 * MiB;
constexpr size_t WS_BAR    = 994 * MiB;
constexpr size_t WS_CPART  = 436 * MiB;
constexpr size_t WS_END    = 995 * MiB;

constexpr int SHM_K = 16384, SHM_V = 16384;
constexpr int L_V = 0, L_K = 32768, L_WS = 65536, L_CK = 65536 + 2048, L_LUT = 69632, L_END = 69632 + 32768;
constexpr int LDS_BYTES = 147456;

__device__ __forceinline__ u32x4 pack8bf(f32x4 a, f32x4 b) { u32x4 w; w.x = cvt_pk_bf16(a[0], a[1]); w.y = cvt_pk_bf16(a[2], a[3]); w.z = cvt_pk_bf16(b[0], b[1]); w.w = cvt_pk_bf16(b[2], b[3]); return w; }
__device__ __forceinline__ float log_sigmoid_f(float x) { return fminf(x, 0.f) - log1pf(__expf(-fabsf(x))); }
__device__ __forceinline__ float sigmoid_f(float x) { return 1.f / (1.f + __expf(-x)); }
__device__ __forceinline__ float gelu_tanh_f(float x) { const float u = 0.7978845608028654f * (x + 0.044715f * x * x * x); const float t = 1.f - 2.f / (__expf(2.f * u) + 1.f); return 0.5f * x * (1.f + t); }

struct EpiFoxQKV {
    static constexpr bool PERM = true, AFTER_DRAIN = false;
    bf16_t* q; float* flog; const float* bfg;
    __device__ __forceinline__ void operator()(const f32x4 (&acc)[2][2][4][2], const Unit& u, int wr, int wc, int fr, int fq) const {
        const int row0 = u.pm * 256 + wr * 64 + fr; const int colt = u.pn * 256;
        if (colt < 6144) {
            const int t = colt >> 11; bf16_t* base = q + (size_t)t * ((size_t)S_ * DM); const float sc = t == 0 ? QSCALE : 1.f;
            const int c0 = colt - t * 2048 + wc * 32 + 8 * fq;
#pragma unroll
            for (int ai = 0; ai < 2; ++ai)
#pragma unroll
                for (int m = 0; m < 4; ++m) { bf16_t* rowp = base + (size_t)(row0 + ai * 128 + m * 16) * DM + c0;
#pragma unroll
                    for (int bj = 0; bj < 2; ++bj) *(u32x4*)(rowp + bj * 128) = pack8bf(acc[ai][bj][m][0] * sc, acc[ai][bj][m][1] * sc); }
        } else if (wc == 0 && fq < 2) {
            float bb[8];
#pragma unroll
            for (int e = 0; e < 8; ++e) bb[e] = bfg[8 * fq + e];
#pragma unroll
            for (int ai = 0; ai < 2; ++ai)
#pragma unroll
                for (int m = 0; m < 4; ++m) { float* rowp = flog + (size_t)(row0 + ai * 128 + m * 16) * 16 + 8 * fq;
                    f32x4 a = acc[ai][0][m][0], b = acc[ai][0][m][1], oa, ob;
#pragma unroll
                    for (int e = 0; e < 4; ++e) { oa[e] = log_sigmoid_f(a[e] + bb[e]); ob[e] = log_sigmoid_f(b[e] + bb[4 + e]); }
                    *(f32x4*)rowp = oa; *(f32x4*)(rowp + 4) = ob; }
        }
    }
};
struct EpiNsaQ {
    static constexpr bool PERM = true, AFTER_DRAIN = false;
    bf16_t* q; float* gates;
    __device__ __forceinline__ void operator()(const f32x4 (&acc)[2][2][4][2], const Unit& u, int wr, int wc, int fr, int fq) const {
        const int row0 = u.pm * 256 + wr * 64 + fr; const int colt = u.pn * 256;
        if (colt < 2048) {
            const int c0 = colt + wc * 32 + 8 * fq;
#pragma unroll
            for (int ai = 0; ai < 2; ++ai)
#pragma unroll
                for (int m = 0; m < 4; ++m) { bf16_t* rowp = q + (size_t)(row0 + ai * 128 + m * 16) * DM + c0;
#pragma unroll
                    for (int bj = 0; bj < 2; ++bj) *(u32x4*)(rowp + bj * 128) = pack8bf(acc[ai][bj][m][0] * QSCALE, acc[ai][bj][m][1] * QSCALE); }
        } else { const int c0 = wc * 32 + 8 * fq;
            if (c0 < 48) {
#pragma unroll
            for (int ai = 0; ai < 2; ++ai)
#pragma unroll
                for (int m = 0; m < 4; ++m) { float* rowp = gates + (size_t)(row0 + ai * 128 + m * 16) * 48 + c0;
                    f32x4 a = acc[ai][0][m][0], b = acc[ai][0][m][1], oa, ob;
#pragma unroll
                    for (int e = 0; e < 4; ++e) { oa[e] = sigmoid_f(a[e]); ob[e] = sigmoid_f(b[e]); }
                    *(f32x4*)rowp = oa; *(f32x4*)(rowp + 4) = ob; } }
        }
    }
};
struct EpiRes {
    static constexpr bool PERM = true, AFTER_DRAIN = false;
    const float* res; float* out;
    __device__ __forceinline__ void operator()(const f32x4 (&acc)[2][2][4][2], const Unit& u, int wr, int wc, int fr, int fq) const {
        const int row0 = u.pm * 256 + wr * 64 + fr; const int c0 = u.pn * 256 + wc * 32 + 8 * fq;
#pragma unroll
        for (int ai = 0; ai < 2; ++ai)
#pragma unroll
            for (int m = 0; m < 4; ++m) { const size_t off = (size_t)(row0 + ai * 128 + m * 16) * DM + c0;
#pragma unroll
                for (int bj = 0; bj < 2; ++bj) { const f32x4 r0 = *(const f32x4*)(res + off + bj * 128), r1 = *(const f32x4*)(res + off + bj * 128 + 4);
                    *(f32x4*)(out + off + bj * 128) = r0 * ALPHA_ + acc[ai][bj][m][0]; *(f32x4*)(out + off + bj * 128 + 4) = r1 * ALPHA_ + acc[ai][bj][m][1]; } }
    }
};
struct EpiRelu2 {
    static constexpr bool PERM = true, AFTER_DRAIN = false;
    bf16_t* O;
    __device__ __forceinline__ void operator()(const f32x4 (&acc)[2][2][4][2], const Unit& u, int wr, int wc, int fr, int fq) const {
        const int row0 = u.pm * 256 + wr * 64 + fr; const int c0 = u.pn * 256 + wc * 32 + 8 * fq;
#pragma unroll
        for (int ai = 0; ai < 2; ++ai)
#pragma unroll
            for (int m = 0; m < 4; ++m) { bf16_t* rowp = O + (size_t)(row0 + ai * 128 + m * 16) * FF + c0;
#pragma unroll
                for (int bj = 0; bj < 2; ++bj) { f32x4 a = acc[ai][bj][m][0], b = acc[ai][bj][m][1];
#pragma unroll
                    for (int e = 0; e < 4; ++e) { a[e] = fmaxf(a[e], 0.f); a[e] *= a[e]; b[e] = fmaxf(b[e], 0.f); b[e] *= b[e]; }
                    *(u32x4*)(rowp + bj * 128) = pack8bf(a, b); } }
    }
};
__device__ __forceinline__ int vt_pos(int ko) { return ((ko & 15) >> 2) * 8 + ((ko >> 4) << 2) + (ko & 3); }
struct EpiKV {
    static constexpr bool PERM = true, AFTER_DRAIN = false;
    bf16_t* kv; bf16_t* rawk; bf16_t* rawv; bf16_t* vt; bf16_t* kf;
    __device__ __forceinline__ void operator()(const f32x4 (&acc)[2][2][4][2], const Unit& u, int wr, int wc, int fr, int fq) const {
        const int row0 = u.pm * 256 + wr * 64 + fr;
#pragma unroll
        for (int bj = 0; bj < 2; ++bj) {
            const int cg_ = u.pn * 256 + bj * 128; const int slot = cg_ >> 9, g = (cg_ & 511) >> 7; const int d0 = wc * 32 + 8 * fq;
#pragma unroll
            for (int ai = 0; ai < 2; ++ai)
#pragma unroll
                for (int m = 0; m < 4; ++m) { const int row = row0 + ai * 128 + m * 16; const f32x4 a = acc[ai][bj][m][0], b = acc[ai][bj][m][1];
                    if (slot < 2) { bf16_t* dst = (slot == 0 ? rawk : rawv) + ((size_t)g * S_ + row) * 128 + d0; *(u32x4*)dst = pack8bf(a, b); }
                    else if (slot == 2) { const int blk = row >> 6, kin = row & 63;
                        *(u32x4*)(kf + ((size_t)((g * 256 + blk) * 16 + (kin >> 4) * 4 + wc)) * 512 + (fq * 16 + (kin & 15)) * 8) = pack8bf(a, b); }
                    else if (slot == 3) { const u32x4 w = pack8bf(a, b); const int blk = row >> 6, kin = row & 63, pos = vt_pos(kin & 31);
                        bf16_t* dst = vt + ((size_t)((g * 256 + blk) * 16 + (wc * 2 + (fq >> 1)) * 2 + (kin >> 5))) * 512 + ((pos >> 3) * 16 + (fq & 1) * 8) * 8 + (pos & 7);
                        dst[0] = (bf16_t)(w.x & 0xffffu); dst[8] = (bf16_t)(w.x >> 16); dst[16] = (bf16_t)(w.y & 0xffffu); dst[24] = (bf16_t)(w.y >> 16);
                        dst[32] = (bf16_t)(w.z & 0xffffu); dst[40] = (bf16_t)(w.z >> 16); dst[48] = (bf16_t)(w.w & 0xffffu); dst[56] = (bf16_t)(w.w >> 16); }
                    else { *(u32x4*)(kv + (size_t)row * NKV + cg_ + d0) = pack8bf(a, b); } }
        }
    }
};
struct EpiPart {
    static constexpr bool PERM = true, AFTER_DRAIN = false;
    float* P;
    __device__ __forceinline__ void operator()(const f32x4 (&acc)[2][2][4][2], const Unit& u, int wr, int wc, int fr, int fq) const {
        const int row0 = u.pm * 256 + wr * 64 + fr; const int c0 = wc * 32 + 8 * fq;
#pragma unroll
        for (int ai = 0; ai < 2; ++ai)
#pragma unroll
            for (int m = 0; m < 4; ++m) { float* rowp = P + (size_t)(row0 + ai * 128 + m * 16) * 256 + c0;
#pragma unroll
                for (int bj = 0; bj < 2; ++bj) { *(f32x4*)(rowp + bj * 128) = acc[ai][bj][m][0]; *(f32x4*)(rowp + bj * 128 + 4) = acc[ai][bj][m][1]; } }
    }
};

__device__ __forceinline__ unsigned f2bf(float f) { unsigned u = __builtin_bit_cast(unsigned, f); return (u + 0x7fffu + ((u >> 16) & 1u)) >> 16; }
__device__ __forceinline__ unsigned pk2(float lo, float hi) { return f2bf(lo) | (f2bf(hi) << 16); }
__device__ __forceinline__ float wave_sum(float v) {
#pragma unroll
    for (int o = 1; o < 64; o <<= 1) v += __shfl_xor(v, o);
    return v;
}
template <int CTRL> __device__ __forceinline__ float dppf(float v) { return __uint_as_float((unsigned)__builtin_amdgcn_update_dpp(0, (int)__float_as_uint(v), CTRL, 0xF, 0xF, true)); }
__device__ __forceinline__ float wave_max_fast(float v) {
    v = fmaxf(v, dppf<0xB1>(v)); v = fmaxf(v, dppf<0x4E>(v)); v = fmaxf(v, dppf<0x141>(v)); v = fmaxf(v, dppf<0x140>(v));
    const float a = __uint_as_float((unsigned)__builtin_amdgcn_readlane((int)__float_as_uint(v), 0)), b = __uint_as_float((unsigned)__builtin_amdgcn_readlane((int)__float_as_uint(v), 16));
    const float c = __uint_as_float((unsigned)__builtin_amdgcn_readlane((int)__float_as_uint(v), 32)), d = __uint_as_float((unsigned)__builtin_amdgcn_readlane((int)__float_as_uint(v), 48));
    return fmaxf(fmaxf(a, b), fmaxf(c, d));
}
__device__ __forceinline__ float wave_sum_fast(float v) {
    v += dppf<0xB1>(v); v += dppf<0x4E>(v); v += dppf<0x141>(v); v += dppf<0x140>(v);
    const float a = __uint_as_float((unsigned)__builtin_amdgcn_readlane((int)__float_as_uint(v), 0)), b = __uint_as_float((unsigned)__builtin_amdgcn_readlane((int)__float_as_uint(v), 16));
    const float c = __uint_as_float((unsigned)__builtin_amdgcn_readlane((int)__float_as_uint(v), 32)), d = __uint_as_float((unsigned)__builtin_amdgcn_readlane((int)__float_as_uint(v), 48));
    return (a + b) + (c + d);
}
__device__ __forceinline__ float wave_max(float v) {
#pragma unroll
    for (int o = 1; o < 64; o <<= 1) v = fmaxf(v, __shfl_xor(v, o));
    return v;
}
__device__ __forceinline__ void transpose_item(const float* W, int K, int ld, int ncols, bf16_t* WT, LAS float* scr, int item, int lane) {
    const int nblk = ncols / 64, kb = item / nblk, nb = item % nblk, k0 = 64 * kb, n0 = 64 * nb;
    f32x4 v[16];
#pragma unroll
    for (int i = 0; i < 16; ++i) v[i] = *(const f32x4*)(W + (size_t)(k0 + 4 * i + (lane >> 4)) * ld + n0 + (lane & 15) * 4);
#pragma unroll
    for (int i = 0; i < 16; ++i) { LAS float* d = scr + (4 * i + (lane >> 4)) * 65 + (lane & 15) * 4; d[0] = v[i][0]; d[1] = v[i][1]; d[2] = v[i][2]; d[3] = v[i][3]; }
    asm volatile("s_waitcnt lgkmcnt(0)" ::: "memory");
    const int c = lane & 7;
#pragma unroll
    for (int j = 0; j < 8; ++j) { const int n = (lane >> 3) + 8 * j; const LAS float* s = scr + (8 * c) * 65 + n;
        u32x4 o; o.x = pk2(s[0 * 65], s[1 * 65]); o.y = pk2(s[2 * 65], s[3 * 65]); o.z = pk2(s[4 * 65], s[5 * 65]); o.w = pk2(s[6 * 65], s[7 * 65]);
        *(u32x4*)(WT + (size_t)(n0 + n) * K + k0 + 8 * c) = o; }
    asm volatile("s_waitcnt lgkmcnt(0)" ::: "memory");
}
__device__ __forceinline__ int rel_bucket_dev(int n) {
    if (n < 16) return n;
    int lg = 16 + (int)(__logf((float)n / 16.0f) / 4.852030263919617f * 16.0f);
    return lg > 31 ? 31 : lg;
}

struct Params { const float* in[20]; float* out; unsigned char* ws; };
typedef const Params __attribute__((address_space(4)))* KP;
#define KARGS() ({ KP q_ = (KP)__builtin_amdgcn_kernarg_segment_ptr(); asm volatile("" : "+s"(q_)); q_; })
enum { I_X = 0, I_FOXWIN, I_FOXBF, I_FOXWO, I_NSAWIN, I_NSAWO, I_KVW, I_POSK, I_POSV, I_CK1, I_CK2, I_CV1, I_CV2, I_RELB, I_W1, I_W2, I_LN1G, I_LN1B, I_LN2G, I_LN2B };

constexpr int NCV_ITEMS = 44032, NCV_CHUNKS = NCV_ITEMS / 8;
__device__ __forceinline__ void convert_item(KP p, LAS float* scr, int r, int lane) {
    unsigned char* ws = p->ws; const float* src = nullptr; bf16_t* dst = nullptr; int K = DM, ld = DM, nc = DM; bool hit = false;
#define CV(n_, s_, K_, ld_, nc_, d_) if (!hit) { if (r < (n_)) { src = (s_); K = (K_); ld = (ld_); nc = (nc_); dst = (d_); hit = true; } else r -= (n_); }
    CV(1024, p->in[I_FOXWO], DM, DM, DM, (bf16_t*)(ws + WS_WFOXO))
    CV(4096, p->in[I_W1], DM, FF, FF, (bf16_t*)(ws + WS_W1))
    CV(4096, p->in[I_W2], FF, DM, DM, (bf16_t*)(ws + WS_W2))
    CV(3072, p->in[I_FOXWIN] + (size_t)DM * 6160, DM, 6160, 6144, (bf16_t*)(ws + WS_WFOXIN) + (size_t)NFOX * DM)
    CV(1024, p->in[I_FOXWO] + (size_t)DM * DM, DM, DM, DM, (bf16_t*)(ws + WS_WFOXO) + (size_t)DM * DM)
    CV(4096, p->in[I_W1] + (size_t)DM * FF, DM, FF, FF, (bf16_t*)(ws + WS_W1) + (size_t)FF * DM)
    CV(4096, p->in[I_W2] + (size_t)FF * DM, FF, DM, DM, (bf16_t*)(ws + WS_W2) + (size_t)DM * FF)
    CV(1536, p->in[I_KVW], DM, NKV, NKV, (bf16_t*)(ws + WS_WKV))
    CV(256, p->in[I_CK1], 4096, 256, 256, (bf16_t*)(ws + WS_WC1))
    CV(256, p->in[I_CV1], 4096, 256, 256, (bf16_t*)(ws + WS_WC1) + (size_t)256 * 4096)
    CV(1024, p->in[I_NSAWIN], DM, 2096, 2048, (bf16_t*)(ws + WS_WNSAIN))
    CV(1024, p->in[I_NSAWO], DM, DM, DM, (bf16_t*)(ws + WS_WNSAO))
    CV(4096, p->in[I_W1] + (size_t)2 * DM * FF, DM, FF, FF, (bf16_t*)(ws + WS_W1) + (size_t)2 * FF * DM)
    CV(4096, p->in[I_W2] + (size_t)2 * FF * DM, FF, DM, DM, (bf16_t*)(ws + WS_W2) + (size_t)2 * DM * FF)
    CV(1024, p->in[I_NSAWIN] + (size_t)DM * 2096, DM, 2096, 2048, (bf16_t*)(ws + WS_WNSAIN) + (size_t)NNSA * DM)
    CV(1024, p->in[I_NSAWO] + (size_t)DM * DM, DM, DM, DM, (bf16_t*)(ws + WS_WNSAO) + (size_t)DM * DM)
    CV(4096, p->in[I_W1] + (size_t)3 * DM * FF, DM, FF, FF, (bf16_t*)(ws + WS_W1) + (size_t)3 * FF * DM)
    CV(4096, p->in[I_W2] + (size_t)3 * FF * DM, FF, DM, DM, (bf16_t*)(ws + WS_W2) + (size_t)3 * DM * FF)
#undef CV
    if (hit) transpose_item(src, K, ld, nc, dst, scr, r, lane);
}
__device__ __forceinline__ void pull_convert(KP p, LAS unsigned char* lds, int quota) {
    int tid_ = threadIdx.x; asm volatile("" : "+v"(tid_));
    const int lane = tid_ & 63, wave = tid_ >> 6;
    LAS float* scr = (LAS float*)(lds + wave * 16896); LAS int* slot = (LAS int*)(lds + 135168 + 64);
    unsigned* qh = (unsigned*)(p->ws + WS_NRM) + 66;
    for (int n = 0; quota < 0 || n < quota; ++n) {
        __syncthreads();
        if (tid_ == 0) *slot = (int)atomicAdd(qh, 1u);
        __syncthreads();
        const int c = __builtin_amdgcn_readfirstlane(*slot);
        if (c >= NCV_CHUNKS) break;
        convert_item(p, scr, c * 8 + wave, lane);
    }
    __syncthreads();
}

__device__ __forceinline__ void prologue(KP p, LAS unsigned char* lds) {
    int tid_ = threadIdx.x; asm volatile("" : "+v"(tid_));
    const int tid = tid_, lane = tid & 63, wave = tid >> 6;
    const int gw = blockIdx.x * 8 + wave, NGW = gridDim.x * 8;
    LAS float* scr = (LAS float*)(lds + wave * 16896);
    unsigned char* ws = p->ws;
#define TR(src, K, ld, ncols, dst) do { const long n_ = (long)((K) / 64) * ((ncols) / 64); \
        for (long it = gw; it < n_; it += NGW) transpose_item((src), (K), (ld), (ncols), (dst), scr, (int)it, lane); } while (0)
    TR(p->in[I_FOXWIN], DM, 6160, 6144, (bf16_t*)(ws + WS_WFOXIN));
#undef TR
    const int gt = blockIdx.x * 512 + tid, NGT = gridDim.x * 512;
    for (int i = gt; i < 2 * 256 * DM; i += NGT) { const int L = i / (256 * DM), r = (i / DM) % 256, k = i % DM;
        const float v = r < 16 ? p->in[I_FOXWIN][(size_t)L * DM * 6160 + (size_t)k * 6160 + 6144 + r] : 0.f;
        ((bf16_t*)(ws + WS_WFOXIN))[(size_t)L * NFOX * DM + (size_t)(6144 + r) * DM + k] = (bf16_t)f2bf(v); }
    for (int i = gt; i < 2 * 256 * DM; i += NGT) { const int L = i / (256 * DM), r = (i / DM) % 256, k = i % DM;
        const float v = r < 48 ? p->in[I_NSAWIN][(size_t)L * DM * 2096 + (size_t)k * 2096 + 2048 + r] : 0.f;
        ((bf16_t*)(ws + WS_WNSAIN))[(size_t)L * NNSA * DM + (size_t)(2048 + r) * DM + k] = (bf16_t)f2bf(v); }
    { const f32x4* x4 = (const f32x4*)p->in[I_X]; u32x2* o = (u32x2*)(ws + WS_HBF);
      for (int i = gt; i < S_ * DM / 4; i += NGT) { const f32x4 v = x4[i]; u32x2 w; w.x = pk2(v[0], v[1]); w.y = pk2(v[2], v[3]); o[i] = w; } }
    { float* lut = (float*)(ws + WS_LUT);
      for (int i = gt; i < 16 * 2048; i += NGT) { const int h = i >> 11, d = i & 2047; lut[i] = p->in[I_RELB][rel_bucket_dev(d) * 16 + h]; } }
    { float* part = (float*)(ws + WS_CBP);
      for (int i = gt; i < 2 * 64 * 256; i += NGT) { const int mat = i / (64 * 256), ch = (i / 256) % 64, c = i % 256;
          const float* pos = p->in[mat ? I_POSV : I_POSK]; const float* w1 = p->in[mat ? I_CV1 : I_CK1]; float s = 0.f;
          for (int j = ch * 64; j < ch * 64 + 64; ++j) s += pos[j] * w1[(size_t)j * 256 + c];
          part[i] = s; } }
    if (gt < 128) ((unsigned*)(ws + WS_NRM))[gt] = 0u;
    { bf16_t* rk = (bf16_t*)(ws + WS_RAWK) + (size_t)4 * S_ * 128; bf16_t* rv = (bf16_t*)(ws + WS_RAWV) + (size_t)4 * S_ * 128;
      for (int i = gt; i < 32 * 128; i += NGT) { rk[i] = 0; rv[i] = 0; } }
}

__device__ __forceinline__ void ln_phase(const float* pre, const float* gam, const float* bet, float* h32, bf16_t* hbf) {
    int tid_ = threadIdx.x; asm volatile("" : "+v"(tid_));
    const int tid = tid_, lane = tid & 63, wave = tid >> 6;
    const int gw = blockIdx.x * 8 + wave, NGW = gridDim.x * 8;
    f32x4 nx[8];
    if (gw < S_) { const f32x4* xr = (const f32x4*)(pre + (size_t)gw * DM) + lane;
#pragma unroll
        for (int j = 0; j < 8; ++j) nx[j] = xr[64 * j]; }
#pragma nounroll
    for (int row = gw; row < S_; row += NGW) {
        f32x4 v[8]; float s = 0.f;
#pragma unroll
        for (int j = 0; j < 8; ++j) { v[j] = nx[j]; s += (v[j][0] + v[j][1]) + (v[j][2] + v[j][3]); }
        if (row + NGW < S_) { const f32x4* xr = (const f32x4*)(pre + (size_t)(row + NGW) * DM) + lane;
#pragma unroll
            for (int j = 0; j < 8; ++j) nx[j] = xr[64 * j]; }
        const float mean = wave_sum_fast(s) * (1.f / DM); float s2 = 0.f;
#pragma unroll
        for (int j = 0; j < 8; ++j) { v[j] = v[j] - mean; s2 += (v[j][0] * v[j][0] + v[j][1] * v[j][1]) + (v[j][2] * v[j][2] + v[j][3] * v[j][3]); }
        const float rstd = 1.f / sqrtf(wave_sum_fast(s2) * (1.f / DM) + LN_EPS_);
        f32x4* o4 = (f32x4*)(h32 + (size_t)row * DM) + lane; u32x2* o2 = (u32x2*)(hbf + (size_t)row * DM) + lane;
#pragma unroll
        for (int j = 0; j < 8; ++j) { const f32x4 g4 = ((const f32x4*)gam)[lane + 64 * j], b4 = ((const f32x4*)bet)[lane + 64 * j];
            const f32x4 y = v[j] * rstd * g4 + b4; o4[64 * j] = y; u32x2 w; w.x = pk2(y[0], y[1]); w.y = pk2(y[2], y[3]); o2[64 * j] = w; }
    }
}

__device__ __forceinline__ void scan_phase(KP p, LAS unsigned char* lds, bool do_cbias, int layer) {
    int tid_ = threadIdx.x; asm volatile("" : "+v"(tid_));
    const int tid = tid_; unsigned char* ws = p->ws;
    if (blockIdx.x < 16) {
        const int h = blockIdx.x; const float* fl = (const float*)(ws + WS_FLOG); float* cum = (float*)(ws + WS_CUM) + (size_t)h * S_;
        LAS float* sh = (LAS float*)lds;
        float loc[32]; float tot = 0.f;
#pragma unroll
        for (int i = 0; i < 32; ++i) { loc[i] = fl[(size_t)(tid * 32 + i) * 16 + h]; }
#pragma unroll
        for (int i = 0; i < 32; ++i) { tot += loc[i]; loc[i] = tot; }
        sh[tid] = tot; __syncthreads();
        for (int off = 1; off < 512; off <<= 1) { const float v = tid >= off ? sh[tid - off] : 0.f; __syncthreads(); sh[tid] += v; __syncthreads(); }
        const float excl = sh[tid] - tot;
#pragma unroll
        for (int i = 0; i < 32; ++i) cum[tid * 32 + i] = excl + loc[i];
        __syncthreads();
    } else if (blockIdx.x == 16) {
        if (do_cbias) {
        const float* part = (const float*)(ws + WS_CBP); float* cb = (float*)(ws + WS_CB);
        const int mat = tid >> 8, c = tid & 255; float s = 0.f;
        for (int ch = 0; ch < 64; ++ch) s += part[(mat * 64 + ch) * 256 + c];
        cb[tid] = s; }
    } else {
        const int nb = (int)gridDim.x - 17, b = (int)blockIdx.x - 17;
        const int h = tid & 15; float mq = 0.f, mk = 0.f;
        const bf16_t* Q = (const bf16_t*)(ws + WS_A); const bf16_t* K = Q + (size_t)S_ * DM;
        for (int t = b * 32 + (tid >> 4); t < S_; t += nb * 32) {
            const u32x4* qp = (const u32x4*)(Q + (size_t)t * DM + h * 128); const u32x4* kp = (const u32x4*)(K + (size_t)t * DM + h * 128);
            float sq = 0.f, sk = 0.f;
#pragma unroll 4
            for (int i = 0; i < 16; ++i) { const u32x4 a = qp[i], c = kp[i];
#pragma unroll
                for (int e = 0; e < 4; ++e) { const float q0 = __uint_as_float(a[e] << 16), q1 = __uint_as_float(a[e] & 0xffff0000u), k0 = __uint_as_float(c[e] << 16), k1 = __uint_as_float(c[e] & 0xffff0000u);
                    sq += q0 * q0 + q1 * q1; sk += k0 * k0 + k1 * k1; } }
            mq = fmaxf(mq, sq); mk = fmaxf(mk, sk);
        }
        mq = fmaxf(mq, __shfl_xor(mq, 16)); mq = fmaxf(mq, __shfl_xor(mq, 32)); mk = fmaxf(mk, __shfl_xor(mk, 16)); mk = fmaxf(mk, __shfl_xor(mk, 32));
        if ((tid & 63) < 16) { unsigned* nr = (unsigned*)(ws + WS_NRM) + (layer * 16 + h) * 2; atomicMax(nr, __float_as_uint(mq)); atomicMax(nr + 1, __float_as_uint(mk)); }
    }
}

__device__ __forceinline__ void cmp2_phase(KP p, LAS unsigned char* lds) {
    int tid_ = threadIdx.x; asm volatile("" : "+v"(tid_));
    const int tid = tid_; unsigned char* ws = p->ws;
    const int rr = tid >> 7, d = tid & 127;
    LAS float* hid = (LAS float*)lds;
    for (int it = blockIdx.x; it < 2 * 1024; it += gridDim.x) {
        const int mat = it >> 10, row0 = (it & 1023) * 4;
        const float* part = (const float*)(ws + WS_CPART) + (size_t)mat * 8 * 4096 * 256; const float* cb = (const float*)(ws + WS_CB) + mat * 256;
        __syncthreads();
#pragma unroll
        for (int i = 0; i < 2; ++i) { const int e = tid + 512 * i, r_ = e >> 8, k = e & 255; float s = cb[k];
#pragma unroll
            for (int c = 0; c < 8; ++c) s += part[((size_t)c * 4096 + row0 + r_) * 256 + k];
            hid[e] = gelu_tanh_f(s); }
        __syncthreads();
        const int row = row0 + rr;
        const float* w2 = p->in[mat ? I_CV2 : I_CK2];
        float s = 0.f;
#pragma unroll 8
        for (int k = 0; k < 256; ++k) s += hid[rr * 256 + k] * w2[k * 128 + d];
        if ((row & 1023) == 1023) s = 0.f;
        ((bf16_t*)(ws + (mat ? WS_VC : WS_KC)))[(size_t)row * 128 + d] = (bf16_t)f2bf(s);
    }
}

#define KSWZ(row, colB) ((row) * 256 + ((colB) ^ (((row) & 7) << 4)))
#define SBAR() __builtin_amdgcn_sched_barrier(0)
__device__ __forceinline__ int v_st(int k, int c) { const int kk = (k & ~0xC) | ((k & 4) << 1) | ((k & 8) >> 1); return ((kk >> 3) * 4 + (c >> 5)) * 512 + ((kk & 7) * 32 + (c & 31)) * 2; }
__device__ __forceinline__ int v_rd_base(int lane) { return ((lane & 3) << 3) | (((lane >> 2) & 3) << 6) | (((lane >> 4) & 1) << 5) | (((lane >> 5) & 1) << 8); }
constexpr int v_rd_off(int d0, int ks, int half) { return d0 * 512 + ks * 4096 + half * 2048; }
__device__ __forceinline__ int crow(int r, int hi) { return (r & 3) + 8 * (r >> 2) + 4 * hi; }

__device__ __forceinline__ void qkt(f32x16& p0, f32x16& p1, const LAS unsigned char* Kb, int r32, int hi, const bf16x8* qr) {
#pragma unroll
    for (int r = 0; r < 16; ++r) { p0[r] = 0.f; p1[r] = 0.f; }
    const LAS unsigned char* kb[4];
#pragma unroll
    for (int dd = 0; dd < 4; ++dd) kb[dd] = Kb + KSWZ(r32, (dd * 16 + hi * 8) * 2);
#pragma unroll
    for (int d0 = 0; d0 < 8; ++d0) { const LAS unsigned char* a = kb[d0 & 3] + (d0 >> 2) * 128;
        const bf16x8 b0 = *(const LAS bf16x8*)a;
        const bf16x8 b1 = *(const LAS bf16x8*)(a + 32 * 256);
        p0 = __builtin_amdgcn_mfma_f32_32x32x16_bf16(b0, qr[d0], p0, 0, 0, 0);
        p1 = __builtin_amdgcn_mfma_f32_32x32x16_bf16(b1, qr[d0], p1, 0, 0, 0); }
}
__device__ __forceinline__ void pv_tile(f32x16* o, int vb, bf16x8 pa0, bf16x8 pa1, bf16x8 pa2, bf16x8 pa3) {
#define TRRD(dst, off) asm volatile("ds_read_b64_tr_b16 %0, %1 offset:%2" : "=&v"(dst) : "v"(vb), "i"(off) : "memory")
#define PV_D0(d0) do { s16x4 l0, l1, l2, l3, h0, h1, h2, h3; constexpr int b_ = v_rd_off(d0, 0, 0); \
        TRRD(l0, b_); TRRD(h0, b_ + 2048); TRRD(l1, b_ + 4096); TRRD(h1, b_ + 6144); TRRD(l2, b_ + 8192); TRRD(h2, b_ + 10240); TRRD(l3, b_ + 12288); TRRD(h3, b_ + 14336); \
        asm volatile("s_waitcnt lgkmcnt(0)" ::: "memory"); SBAR(); \
        o[d0] = __builtin_amdgcn_mfma_f32_32x32x16_bf16(pa0, (bf16x8){l0[0], l0[1], l0[2], l0[3], h0[0], h0[1], h0[2], h0[3]}, o[d0], 0, 0, 0);   \
        o[d0] = __builtin_amdgcn_mfma_f32_32x32x16_bf16(pa1, (bf16x8){l1[0], l1[1], l1[2], l1[3], h1[0], h1[1], h1[2], h1[3]}, o[d0], 0, 0, 0);   \
        o[d0] = __builtin_amdgcn_mfma_f32_32x32x16_bf16(pa2, (bf16x8){l2[0], l2[1], l2[2], l2[3], h2[0], h2[1], h2[2], h2[3]}, o[d0], 0, 0, 0);   \
        o[d0] = __builtin_amdgcn_mfma_f32_32x32x16_bf16(pa3, (bf16x8){l3[0], l3[1], l3[2], l3[3], h3[0], h3[1], h3[2], h3[3]}, o[d0], 0, 0, 0); } while (0)
    PV_D0(0); PV_D0(1); PV_D0(2); PV_D0(3);
#undef PV_D0
#undef TRRD
}
__device__ __forceinline__ void p_to_frags(const f32x16& p0, const f32x16& p1, bf16x8& pa0, bf16x8& pa1, bf16x8& pa2, bf16x8& pa3) {
#define PK4(P, B_, OUT) do { unsigned a0 = cvt_pk_bf16(P[B_+0], P[B_+1]), a1 = cvt_pk_bf16(P[B_+2], P[B_+3]);                          \
        unsigned b0 = cvt_pk_bf16(P[B_+4], P[B_+5]), b1 = cvt_pk_bf16(P[B_+6], P[B_+7]);                                             \
        auto r0 = __builtin_amdgcn_permlane32_swap(a0, b0, false, false); auto r1 = __builtin_amdgcn_permlane32_swap(a1, b1, false, false); \
        u32x4 w = {r0[0], r1[0], r0[1], r1[1]}; OUT = *reinterpret_cast<bf16x8*>(&w); } while (0)
    PK4(p0, 0, pa0); PK4(p0, 8, pa1); PK4(p1, 0, pa2); PK4(p1, 8, pa3);
#undef PK4
}
__device__ __forceinline__ float half_swap_max(float v) { auto rr = __builtin_amdgcn_permlane32_swap(__float_as_uint(v), __float_as_uint(v), false, false); return fmaxf(__uint_as_float(rr[0]), __uint_as_float(rr[1])); }
__device__ __forceinline__ float half_swap_sum(float v) { auto rr = __builtin_amdgcn_permlane32_swap(__float_as_uint(v), __float_as_uint(v), false, false); return __uint_as_float(rr[0]) + __uint_as_float(rr[1]); }
__device__ __forceinline__ float online_sm(f32x16& p0, f32x16& p1, float& m, float& l) {
    float pmax = p0[0];
#pragma unroll
    for (int r = 1; r < 16; ++r) pmax = fmaxf(pmax, p0[r]);
#pragma unroll
    for (int r = 0; r < 16; ++r) pmax = fmaxf(pmax, p1[r]);
    pmax = half_swap_max(pmax);
    float mn = m, alpha = 1.f;
    if (!__all(pmax <= m + 8.f)) { mn = fmaxf(m, pmax); alpha = __builtin_amdgcn_exp2f((m - mn) * L2E); m = mn; }
    const float mnL = -mn * L2E; float ps = 0.f;
#pragma unroll
    for (int r = 0; r < 16; ++r) { p0[r] = __builtin_amdgcn_exp2f(fmaf(p0[r], L2E, mnL)); p1[r] = __builtin_amdgcn_exp2f(fmaf(p1[r], L2E, mnL)); ps += p0[r] + p1[r]; }
    ps = half_swap_sum(ps);
    l = l * alpha + ps;
    return alpha;
}

struct FL {
    const bf16_t* K; const bf16_t* V; int kstride, vstride;
    int j_lo, j_hi;
    const float* cum; float cq;
    int t_lane, t_w0;
    const LAS float* lut;
    __half* imp;
};
template <int MODE>
__device__ __forceinline__ void flash_loop(LAS unsigned char* lds, const FL& a, const bf16x8* qr, float& m, float& l, f32x16* o, float inv_l) {
    int tid_ = threadIdx.x; asm volatile("" : "+v"(tid_));
    const int tid = tid_, wid = __builtin_amdgcn_readfirstlane(tid >> 6), lane = tid & 63, r32 = lane & 31, hi = lane >> 5;
    LAS unsigned char* V_lds = lds + L_V; LAS unsigned char* K_lds = lds + L_K;
    LAS float* al_l = (LAS float*)(lds + L_WS) + wid * 64 + 32;
    LAS float* ckb = (LAS float*)(lds + L_CK);
    const int sr = tid >> 4, sc = (tid & 15) * 8, vst0 = v_st(sr, sc), vst1 = v_st(32 + sr, sc), kws = KSWZ(sr, sc * 2);
    const int vb0 = (int)(size_t)V_lds + v_rd_base(lane);
    constexpr bool HASV = (MODE != 1);
    bf16x8 sk0, sk1, sv0, sv1; float sck = 0.f;
    const float NEG = -__builtin_inff();
    float carry = 0.f;
#define FL_LOAD(j) do { const int kb_ = (j) * 64; \
        sk0 = *(const bf16x8*)(a.K + (size_t)(kb_ + sr) * a.kstride + sc); sk1 = *(const bf16x8*)(a.K + (size_t)(kb_ + 32 + sr) * a.kstride + sc); \
        if (HASV) { sv0 = *(const bf16x8*)(a.V + (size_t)(kb_ + sr) * a.vstride + sc); sv1 = *(const bf16x8*)(a.V + (size_t)(kb_ + 32 + sr) * a.vstride + sc); } \
        if (MODE == 0) { if (tid < 64) sck = a.cum[kb_ + tid]; } } while (0)
#define FL_WRITE(buf) do { *(LAS bf16x8*)(K_lds + (buf) * SHM_K + kws) = sk0; *(LAS bf16x8*)(K_lds + (buf) * SHM_K + kws + 32 * 256) = sk1; \
        if (HASV) { *(LAS bf16x8*)(V_lds + (buf) * SHM_V + vst0) = sv0; *(LAS bf16x8*)(V_lds + (buf) * SHM_V + vst1) = sv1; } \
        if (MODE == 0) { if (tid < 64) ckb[(buf) * 64 + tid] = sck; } } while (0)
    __syncthreads();
    FL_LOAD(a.j_lo); FL_WRITE(0); __syncthreads();
#pragma nounroll
    for (int j = a.j_lo; j < a.j_hi; ++j) {
        const int buf = (j - a.j_lo) & 1; const int kb = j * 64;
        if (j + 1 < a.j_hi) FL_LOAD(j + 1);
        const bool act = (MODE != 0) || (kb <= a.t_w0 + 31);
        if (act) {
            f32x16 p0, p1;
            qkt(p0, p1, K_lds + buf * SHM_K, r32, hi, qr);
            if (MODE == 0) {
#pragma unroll
                for (int i = 0; i < 4; ++i) { const f32x4 c0 = *(const LAS f32x4*)(ckb + buf * 64 + 4 * hi + 8 * i), c1 = *(const LAS f32x4*)(ckb + buf * 64 + 32 + 4 * hi + 8 * i);
#pragma unroll
                    for (int e = 0; e < 4; ++e) { p0[4 * i + e] += a.cq - c0[e]; p1[4 * i + e] += a.cq - c1[e]; } }
                if (kb + 63 > a.t_w0) { const int dq = a.t_lane - kb - 4 * hi;
#pragma unroll
                    for (int r = 0; r < 16; ++r) { const int c = (r & 3) + 8 * (r >> 2); if (dq - c < 0) p0[r] = NEG; if (dq - c - 32 < 0) p1[r] = NEG; } }
            } else if (MODE == 1 || MODE == 2) {
                const int dq = a.t_lane - 16 * kb - 31 - 64 * hi;
#pragma unroll
                for (int r = 0; r < 16; ++r) { const int d0_ = dq - 16 * (r & 3) - 128 * (r >> 2), d1_ = d0_ - 512;
                    const unsigned i0 = (unsigned)d0_ < 2047u ? (unsigned)d0_ : 2047u, i1 = (unsigned)d1_ < 2047u ? (unsigned)d1_ : 2047u;
                    const float b0 = a.lut[i0], b1 = a.lut[i1];
                    p0[r] = d0_ >= 0 ? p0[r] + b0 : NEG; p1[r] = d1_ >= 0 ? p1[r] + b1 : NEG; }
            } else {
                const int dq = a.t_lane - kb - 4 * hi;
#pragma unroll
                for (int r = 0; r < 16; ++r) { const int d0_ = dq - ((r & 3) + 8 * (r >> 2)), d1_ = d0_ - 32;
                    const unsigned i0 = (unsigned)d0_ < 2047u ? (unsigned)d0_ : 2047u, i1 = (unsigned)d1_ < 2047u ? (unsigned)d1_ : 2047u;
                    const float b0 = a.lut[i0], b1 = a.lut[i1];
                    p0[r] = (unsigned)d0_ < 512u ? p0[r] + b0 : NEG; p1[r] = (unsigned)d1_ < 512u ? p1[r] + b1 : NEG; }
            }
            if (MODE == 1) { (void)online_sm(p0, p1, m, l); }
            else if (MODE == 2) {
                const float mnL = -m * L2E;
#pragma unroll
                for (int r = 0; r < 16; ++r) { p0[r] = __builtin_amdgcn_exp2f(fmaf(p0[r], L2E, mnL)) * inv_l; p1[r] = __builtin_amdgcn_exp2f(fmaf(p1[r], L2E, mnL)) * inv_l; }
                float a0[4], a1[4], x0[4], x1[4];
#pragma unroll
                for (int i = 0; i < 4; ++i) { a0[i] = (p0[4 * i] + p0[4 * i + 1]) + (p0[4 * i + 2] + p0[4 * i + 3]); a1[i] = (p1[4 * i] + p1[4 * i + 1]) + (p1[4 * i + 2] + p1[4 * i + 3]);
                    x0[i] = __shfl_xor(p0[4 * i + 3], 32); x1[i] = __shfl_xor(p1[4 * i + 3], 32); }
                __half* ip = a.imp + 16 * j + hi;
#pragma unroll
                for (int i = 0; i < 4; ++i) { const float e0 = hi ? x0[i] : (i ? x0[i > 0 ? i - 1 : 0] : carry); const float e1 = hi ? x1[i] : (i ? x1[i > 0 ? i - 1 : 0] : x0[3]);
                    ip[2 * i] = __float2half(a0[i] + e0); ip[8 + 2 * i] = __float2half(a1[i] + e1); }
                carry = x1[3];
                bf16x8 pa0, pa1, pa2, pa3; p_to_frags(p0, p1, pa0, pa1, pa2, pa3);
                pv_tile(o, vb0 + buf * SHM_V, pa0, pa1, pa2, pa3);
            } else {
                const float alpha = online_sm(p0, p1, m, l);
                if (__any(alpha < 1.f)) { if (hi == 0) al_l[r32] = alpha; asm volatile("s_waitcnt lgkmcnt(0)" ::: "memory");
#pragma unroll
                    for (int d_ = 0; d_ < 4; ++d_)
#pragma unroll
                        for (int r = 0; r < 16; ++r) o[d_][r] *= al_l[crow(r, hi)]; }
                bf16x8 pa0, pa1, pa2, pa3; p_to_frags(p0, p1, pa0, pa1, pa2, pa3);
                pv_tile(o, vb0 + buf * SHM_V, pa0, pa1, pa2, pa3);
            }
        }
        if (j + 1 < a.j_hi) FL_WRITE(buf ^ 1);
        __syncthreads();
    }
#undef FL_LOAD
#undef FL_WRITE
}

__device__ __forceinline__ void fox_attn_phase(KP p, LAS unsigned char* lds, int layer) {
    const int wid = __builtin_amdgcn_readfirstlane(threadIdx.x >> 6);
    unsigned char* ws = p->ws;
    const bf16_t* Q = (const bf16_t*)(ws + WS_A); const bf16_t* K = Q + (size_t)S_ * DM; const bf16_t* V = K + (size_t)S_ * DM; bf16_t* O = (bf16_t*)(V + (size_t)S_ * DM);
    const float* cumall = (const float*)(ws + WS_CUM);
    const unsigned* nrm = (const unsigned*)(ws + WS_NRM) + layer * 32;
    LAS float* li_l = (LAS float*)(lds + L_WS) + wid * 64;
    LAS int* jl = (LAS int*)(lds + L_CK + 1024);
    unsigned* qhead = (unsigned*)(ws + WS_NRM) + 64 + layer;
    LAS int* islot = (LAS int*)(lds + 135168 + 96);
    int nit = 0;
    for (;;) {
        __syncthreads();
        if (threadIdx.x == 0) *islot = (int)atomicAdd(qhead, 1u);
        __syncthreads();
        const int I = __builtin_amdgcn_readfirstlane(*islot);
        if (I >= 1024) break;
        if (layer == 0 && nit > 0) pull_convert(p, lds, 7);
        ++nit;
        const int qb = 63 - (I >> 4), h = I & 15;
        {
            int tid_ = threadIdx.x; asm volatile("" : "+v"(tid_));
            const int lane = tid_ & 63, r32 = lane & 31, hi = lane >> 5;
            const int t_w0 = qb * 256 + wid * 32, t_lane = t_w0 + r32;
            const float* cum = cumall + (size_t)h * S_;
            const float B2 = 2.f * sqrtf(__uint_as_float(nrm[h * 2]) * __uint_as_float(nrm[h * 2 + 1])) * 1.01f;
            const float T = cum[qb * 256] + 110.f + B2;
            __syncthreads();
            { const bool ok = (tid_ < qb * 4 + 4) && (cum[64 * (tid_ < 256 ? tid_ : 0) + 63] <= T);
              const unsigned long long bm = __ballot(ok);
              if (lane == 0) jl[wid] = bm ? wid * 64 + (__ffsll((long long)bm) - 1) : (1 << 30); }
            __syncthreads();
            int j_lo = jl[0];
#pragma unroll
            for (int w = 1; w < 8; ++w) j_lo = min(j_lo, jl[w]);
            j_lo = __builtin_amdgcn_readfirstlane(j_lo);
            if (j_lo > qb * 4) j_lo = qb * 4;
            bf16x8 qr[8];
#pragma unroll
            for (int d0 = 0; d0 < 8; ++d0) qr[d0] = *(const bf16x8*)(Q + (size_t)t_lane * DM + h * 128 + d0 * 16 + hi * 8);
            FL a; a.K = K + h * 128; a.V = V + h * 128; a.kstride = DM; a.vstride = DM; a.j_lo = j_lo; a.j_hi = qb * 4 + 4;
            a.cum = cum; a.cq = cum[t_lane]; a.t_lane = t_lane; a.t_w0 = t_w0; a.lut = nullptr; a.imp = nullptr;
            float m = -1e30f, l = 0.f; f32x16 o[4];
#pragma unroll
            for (int d_ = 0; d_ < 4; ++d_)
#pragma unroll
                for (int r = 0; r < 16; ++r) o[d_][r] = 0.f;
            flash_loop<0>(lds, a, qr, m, l, o, 0.f);
            if (hi == 0) li_l[r32] = l; asm volatile("s_waitcnt lgkmcnt(0)" ::: "memory");
            bf16_t* Ow = O + (size_t)t_w0 * DM + h * 128;
            int lo_ = 4 * hi * DM + r32; asm volatile("" : "+v"(lo_));
#pragma unroll
            for (int r = 0; r < 16; ++r) { const int orow = crow(r, hi); const float rli = __builtin_amdgcn_rcpf(li_l[orow]);
#pragma unroll
                for (int d0 = 0; d0 < 4; ++d0) { const float v = o[d0][r] * rli; const float vn = __shfl_xor(v, 1);
                    if ((r32 & 1) == 0) *(unsigned*)(Ow + (lo_ + ((r & 3) + 8 * (r >> 2)) * DM + d0 * 32)) = cvt_pk_bf16(v, vn); } }
        }
    }
    if (layer == 0) pull_convert(p, lds, -1);
}

__device__ __forceinline__ void nsa_attn_phase(KP p, LAS unsigned char* lds) {
    const int tid = threadIdx.x, wid = __builtin_amdgcn_readfirstlane(tid >> 6);
    unsigned char* ws = p->ws;
    const bf16_t* Q = (const bf16_t*)(ws + WS_A); bf16_t* attn = (bf16_t*)(ws + WS_A) + (size_t)S_ * DM; __half* imp = (__half*)(ws + WS_A + 128 * MiB);
    float* partial = (float*)(ws + WS_PRE); const float* gates = (const float*)(ws + WS_GATE);
    const bf16_t* kv = (const bf16_t*)(ws + WS_KV); const bf16_t* kc = (const bf16_t*)(ws + WS_KC); const bf16_t* vc = (const bf16_t*)(ws + WS_VC);
    const bf16_t* vt = (const bf16_t*)(ws + WS_VT); const bf16_t* kfr = (const bf16_t*)(ws + WS_KF); const float* lutg = (const float*)(ws + WS_LUT);
    LAS float* lut = (LAS float*)(lds + L_LUT);
    LAS float* li_l = (LAS float*)(lds + L_WS) + wid * 64;
    const float NEG = -__builtin_inff();
    int g_loaded = -1;
    for (int it = blockIdx.x; it < 1024; it += gridDim.x) {
        const int g = it & 3, tile = 2 * (it >> 3) + ((it >> 2) & 1);
        if (g != g_loaded) {
            __syncthreads();
            for (int i = tid; i < 4 * 2048; i += 512) lut[i] = lutg[g * 4 * 2048 + i];
            __syncthreads();
            g_loaded = g;
        }
        {
            const int t0 = tile * 64;
            {
                const int r = wid & 3, th = wid >> 2, h = g * 4 + r;
                int tid_ = threadIdx.x; asm volatile("" : "+v"(tid_));
                const int lane = tid_ & 63, r32 = lane & 31, hi = lane >> 5;
                const int t_w0 = t0 + 32 * th, t_lane = t_w0 + r32;
                bf16x8 qr[8];
#pragma unroll
                for (int d0 = 0; d0 < 8; ++d0) qr[d0] = *(const bf16x8*)(Q + (size_t)t_lane * DM + h * 128 + d0 * 16 + hi * 8);
                const float g0 = gates[(size_t)t_lane * 48 + h * 3 + 0], g2 = gates[(size_t)t_lane * 48 + h * 3 + 2];
                FL a; a.K = kc + (size_t)g * 1024 * 128; a.V = vc + (size_t)g * 1024 * 128; a.kstride = 128; a.vstride = 128; a.j_lo = 0; a.j_hi = (t0 / 16 + 2) / 64 + 1;
                a.cum = nullptr; a.cq = 0.f; a.t_lane = t_lane; a.t_w0 = t_w0; a.lut = lut + r * 2048; a.imp = imp + ((size_t)h * S_ + t_lane) * 256;
                float m = -1e30f, l = 0.f; f32x16 o[4];
#pragma unroll
                for (int d_ = 0; d_ < 4; ++d_)
#pragma unroll
                    for (int rr = 0; rr < 16; ++rr) o[d_][rr] = 0.f;
                flash_loop<1>(lds, a, qr, m, l, o, 0.f);
                const float inv_l = l > 0.f ? 1.f / l : 0.f;
                flash_loop<2>(lds, a, qr, m, l, o, inv_l);
                float* Pw = partial + (size_t)t_w0 * DM + h * 128;
                int lo_ = 4 * hi * DM + r32; asm volatile("" : "+v"(lo_));
                if (hi == 0) li_l[r32] = g0; asm volatile("s_waitcnt lgkmcnt(0)" ::: "memory");
#pragma unroll
                for (int rr = 0; rr < 16; ++rr) { const int orow = crow(rr, hi); const float f = li_l[orow];
#pragma unroll
                    for (int d0 = 0; d0 < 4; ++d0) Pw[lo_ + ((rr & 3) + 8 * (rr >> 2)) * DM + d0 * 32] = o[d0][rr] * f; }
                a.K = kv + 4 * 512 + g * 128; a.V = kv + 5 * 512 + g * 128; a.kstride = NKV; a.vstride = NKV; a.j_lo = tile >= 8 ? tile - 8 : 0; a.j_hi = tile + 1;
                m = -1e30f; l = 0.f;
#pragma unroll
                for (int d_ = 0; d_ < 4; ++d_)
#pragma unroll
                    for (int rr = 0; rr < 16; ++rr) o[d_][rr] = 0.f;
                flash_loop<3>(lds, a, qr, m, l, o, 0.f);
                asm volatile("s_waitcnt lgkmcnt(0)" ::: "memory");
                int lo2_ = 4 * hi * DM + r32; asm volatile("" : "+v"(lo2_));
                if (hi == 0) li_l[r32] = g2 * (l > 0.f ? 1.f / l : 0.f); asm volatile("s_waitcnt lgkmcnt(0)" ::: "memory");
#pragma unroll
                for (int rr = 0; rr < 16; ++rr) { const int orow = crow(rr, hi); const float f = li_l[orow];
#pragma unroll
                    for (int d0 = 0; d0 < 4; ++d0) { float* pp = Pw + (lo2_ + ((rr & 3) + 8 * (rr >> 2)) * DM + d0 * 32); *pp = *pp + o[d0][rr] * f; } }
            }
            __syncthreads();
            LAS int* selbuf = (LAS int*)(lds + L_END);
            LAS unsigned* bmw = (LAS unsigned*)(lds + L_END + 4096) + wid * 8;
            LAS unsigned char* listw = (LAS unsigned char*)(lds + L_END + 4096 + 256) + wid * 256;
#pragma nounroll
            for (int tt = 0; tt < 8; ++tt) {
                int tid_ = threadIdx.x; asm volatile("" : "+v"(tid_));
                const int lane = tid_ & 63;
                const int t = t0 + 8 * wid + tt; const int blk = tile;
                float sc[4] = {0.f, 0.f, 0.f, 0.f};
#pragma unroll
                for (int r = 0; r < 4; ++r) { const u32x2 raw = *(const u32x2*)(imp + ((size_t)(g * 4 + r) * S_ + t) * 256 + lane * 4);
                    sc[0] += __half2float(__ushort_as_half((unsigned short)(raw.x & 0xffffu))); sc[1] += __half2float(__ushort_as_half((unsigned short)(raw.x >> 16)));
                    sc[2] += __half2float(__ushort_as_half((unsigned short)(raw.y & 0xffffu))); sc[3] += __half2float(__ushort_as_half((unsigned short)(raw.y >> 16))); }
#pragma unroll
                for (int e = 0; e < 4; ++e) { const int j = lane * 4 + e; const bool forced = (j == 0) | (j == blk) | (j == blk - 1);
                    sc[e] = forced ? 1e4f : (j <= blk ? sc[e] : -1.f); }
                int mysel = -1;
#pragma nounroll
                for (int k = 0; k < 16; ++k) {
                    float bv = sc[0]; int be = 0;
#pragma unroll
                    for (int e = 1; e < 4; ++e) if (sc[e] > bv) { bv = sc[e]; be = e; }
                    const float wmax = wave_max_fast(bv);
                    if (wmax < 0.f) break;
                    const unsigned long long msk = __ballot(bv == wmax);
                    const int src = __ffsll((long long)msk) - 1;
                    const int jw = __builtin_amdgcn_readlane(lane * 4 + be, src);
                    if (lane == k) mysel = jw;
                    if (lane == src) {
#pragma unroll
                        for (int e = 0; e < 4; ++e) if (be == e) sc[e] = -2.f; }
                }
                if (lane < 16) selbuf[(8 * wid + tt) * 16 + lane] = mysel;
            }
            asm volatile("s_waitcnt lgkmcnt(0)" ::: "memory");
#pragma nounroll
            for (int cgi = 0; cgi < 2; ++cgi) {
                int tid_ = threadIdx.x; asm volatile("" : "+v"(tid_));
                const int lane = tid_ & 63, n = lane & 15, kq = lane >> 4, hn = n & 3, tq = n >> 2;
                const LAS float* lutn = lut + hn * 2048;
                const int pk = selbuf[(8 * wid + cgi * 4 + (lane >> 4)) * 16 + (lane & 15)];
                if (lane < 8) bmw[lane] = 0u;
                asm volatile("s_waitcnt lgkmcnt(0)" ::: "memory");
                if (pk >= 0) atomicOr((unsigned*)(bmw + (pk >> 5)), 1u << (pk & 31));
                asm volatile("s_waitcnt vmcnt(0) lgkmcnt(0)" ::: "memory");
                int nl = 0;
#pragma unroll
                for (int c = 0; c < 4; ++c) { const unsigned long long mc = (unsigned long long)bmw[2 * c] | ((unsigned long long)bmw[2 * c + 1] << 32);
                    if ((mc >> lane) & 1ull) listw[nl + __builtin_popcountll(mc & ((1ull << lane) - 1ull))] = (unsigned char)(64 * c + lane);
                    nl += __builtin_popcountll(mc); }
                nl = __builtin_amdgcn_readfirstlane(nl);
                asm volatile("s_waitcnt lgkmcnt(0)" ::: "memory");
                const int tcol = t0 + 8 * wid + cgi * 4 + tq;
                bf16x8 qb[4];
#pragma unroll
                for (int ks = 0; ks < 4; ++ks) qb[ks] = *(const bf16x8*)(Q + (size_t)tcol * DM + (g * 4 + hn) * 128 + 32 * ks + kq * 8);
                const float g1 = gates[(size_t)tcol * 48 + (g * 4 + hn) * 3 + 1];
                float m = -1e30f, l = 0.f; f32x4 o[8];
#pragma unroll
                for (int d_ = 0; d_ < 8; ++d_) o[d_] = (f32x4){0.f, 0.f, 0.f, 0.f};
                bf16x8 kf[16], vf[16];
                const bf16_t* Kg = kfr + (size_t)g * 256 * 8192 + lane * 8;
                const bf16_t* Vg = vt + (size_t)g * 256 * 8192 + lane * 8;
                int sb = __builtin_amdgcn_readfirstlane((int)listw[0]);
                { const bf16_t* Kp = Kg + (size_t)sb * 8192;
#pragma unroll
                  for (int f = 0; f < 16; ++f) kf[f] = *(const bf16x8*)(Kp + f * 512); }
#pragma nounroll
                for (int b = 0; b < nl; ++b) {
                    const int sbn = __builtin_amdgcn_readfirstlane((int)listw[b + 1 < nl ? b + 1 : b]);
                    { const bf16_t* Vp = Vg + (size_t)sb * 8192;
#pragma unroll
                      for (int f = 0; f < 16; ++f) vf[f] = *(const bf16x8*)(Vp + f * 512); }
                    const unsigned long long bal = __ballot(pk == sb);
                    const bool colpick = ((bal >> (16 * tq)) & 0xFFFFull) != 0ull;
                    SBAR();
                    f32x4 s[4];
#pragma unroll
                    for (int sub = 0; sub < 4; ++sub) { s[sub] = (f32x4){0.f, 0.f, 0.f, 0.f};
#pragma unroll
                        for (int ks = 0; ks < 4; ++ks) s[sub] = __builtin_amdgcn_mfma_f32_16x16x32_bf16(kf[sub * 4 + ks], qb[ks], s[sub], 0, 0, 0); }
                    SBAR();
                    { const bf16_t* Kp = Kg + (size_t)sbn * 8192;
#pragma unroll
                      for (int f = 0; f < 16; ++f) kf[f] = *(const bf16x8*)(Kp + f * 512); }
                    SBAR();
                    const int dq = tcol - sb * 64 - 4 * kq; float pmax = NEG;
#pragma unroll
                    for (int sub = 0; sub < 4; ++sub)
#pragma unroll
                        for (int i = 0; i < 4; ++i) { const int d = dq - 16 * sub - i; const unsigned idx = (unsigned)d < 2047u ? (unsigned)d : 2047u;
                            const float v = (colpick && d >= 0) ? s[sub][i] + lutn[idx] : NEG; s[sub][i] = v; pmax = fmaxf(pmax, v); }
                    if (!__all(pmax <= m + 8.f)) {
                        pmax = fmaxf(pmax, __shfl_xor(pmax, 16)); pmax = fmaxf(pmax, __shfl_xor(pmax, 32));
                        const float mn = fmaxf(m, pmax); const float alpha = __builtin_amdgcn_exp2f((m - mn) * L2E); m = mn; l *= alpha;
#pragma unroll
                        for (int d_ = 0; d_ < 8; ++d_) o[d_] = o[d_] * alpha; }
                    const float mnL = -m * L2E; float ps = 0.f;
#pragma unroll
                    for (int sub = 0; sub < 4; ++sub)
#pragma unroll
                        for (int i = 0; i < 4; ++i) { s[sub][i] = __builtin_amdgcn_exp2f(fmaf(s[sub][i], L2E, mnL)); ps += s[sub][i]; }
                    l += ps;
                    bf16x8 pb[2];
                    { const u32x4 w0 = pack8bf(s[0], s[1]), w1 = pack8bf(s[2], s[3]); pb[0] = *reinterpret_cast<const bf16x8*>(&w0); pb[1] = *reinterpret_cast<const bf16x8*>(&w1); }
                    SBAR();
#pragma unroll
                    for (int d_ = 0; d_ < 8; ++d_)
#pragma unroll
                        for (int s2 = 0; s2 < 2; ++s2) o[d_] = __builtin_amdgcn_mfma_f32_16x16x32_bf16(vf[d_ * 2 + s2], pb[s2], o[d_], 0, 0, 0);
                    sb = sbn;
                }
                l += __shfl_xor(l, 16); l += __shfl_xor(l, 32);
                const float f = g1 * (l > 0.f ? 1.f / l : 0.f);
#pragma unroll
                for (int d_ = 0; d_ < 8; ++d_) { const size_t off = (size_t)tcol * DM + (g * 4 + hn) * 128 + 16 * d_ + 4 * kq;
                    const f32x4 pp = *(const f32x4*)(partial + off); const f32x4 r4 = pp + o[d_] * f;
                    u32x2 w; w.x = cvt_pk_bf16(r4[0], r4[1]); w.y = cvt_pk_bf16(r4[2], r4[3]); *(u32x2*)(attn + off) = w; }
            }
        }
    }
}


#define XB_TMO      128
#define XB_XCNT(j)  (256  + 64 * (j))
#define XB_XSUB(j)  (1280 + 64 * (j))
#define XB_XGEN(j)  (2304 + 64 * (j))
#define XB_TOP      3328
#define XB_TOPGEN   3392
#define XCD_BAR_WORDS 3456
#define XB_SPIN_CAP (1u << 18)
__device__ __forceinline__ unsigned xb_ld(unsigned* p)              { return __hip_atomic_load(p, __ATOMIC_RELAXED, __HIP_MEMORY_SCOPE_AGENT); }
__device__ __forceinline__ unsigned xb_add(unsigned* p, unsigned v) { return __hip_atomic_fetch_add(p, v, __ATOMIC_RELAXED, __HIP_MEMORY_SCOPE_AGENT); }
__device__ __forceinline__ unsigned xb_xcc_id() { return (unsigned)__builtin_amdgcn_s_getreg((3 << 11) | 20) & 0xFu; }
#define XB_SPIN(cond, bar) do { unsigned _sp = 0; while (cond) { __builtin_amdgcn_s_sleep(1); \
    if ((++_sp & 255u) == 0u) { if (xb_ld(&(bar)[XB_TMO])) break; if (_sp > XB_SPIN_CAP) { atomicAdd(&(bar)[XB_TMO], 1u); break; } } } } while (0)

struct XcdBarrier {
    unsigned* bar; unsigned x;
    volatile LAS unsigned* st;
};

__device__ __forceinline__ XcdBarrier xcd_barrier_post(unsigned* bar, volatile LAS unsigned* st) {
    XcdBarrier b; b.bar = bar; b.x = xb_xcc_id(); b.st = st;
    if (threadIdx.x == 0) (void)xb_add(&bar[XB_XCNT(b.x)], 1u);
    return b;
}
__device__ __forceinline__ void xcd_barrier_complete(unsigned* bar, unsigned x, unsigned& nloc, unsigned& nx) {
    const unsigned G = gridDim.x * gridDim.y * gridDim.z;
    unsigned sum, cnt, mine, sp = 0u;
    for (;;) {
        sum = 0u; cnt = 0u; mine = 0u;
#pragma unroll
        for (unsigned j = 0; j < 16; ++j) { const unsigned c = xb_ld(&bar[XB_XCNT(j)]); sum += c; cnt += (c > 0u) ? 1u : 0u; mine = (j == x) ? c : mine; }
        if (sum == G) break;
        __builtin_amdgcn_s_sleep(1);
        if ((++sp & 255u) == 0u) { if (xb_ld(&bar[XB_TMO])) break; if (sp > XB_SPIN_CAP) { atomicAdd(&bar[XB_TMO], 1u); break; } }
    }
    nloc = mine > 0u ? mine : 1u; nx = cnt > 0u ? cnt : 1u;
}

__device__ __forceinline__ void xcd_barrier(const XcdBarrier& b) {
    asm volatile("s_waitcnt vmcnt(0)" ::: "memory");
    __syncthreads();
    if (threadIdx.x == 0) {
        unsigned* bar = b.bar;
        __builtin_amdgcn_s_waitcnt(0);
        unsigned nloc = b.st[0], nx = b.st[1];
        if (nloc == 0u) { xcd_barrier_complete(bar, b.x, nloc, nx); b.st[0] = nloc; b.st[1] = nx; }
        const unsigned old = xb_add(&bar[XB_XSUB(b.x)], 1u);
        const unsigned gen = old / nloc;
        if (old + 1u == (gen + 1u) * nloc) {
            __builtin_amdgcn_fence(__ATOMIC_RELEASE, "agent");
            asm volatile("s_waitcnt vmcnt(0)" ::: "memory");
            const unsigned og = xb_add(&bar[XB_TOP], 1u);
            const unsigned tg = og / nx;
            if (og + 1u == (tg + 1u) * nx) xb_add(&bar[XB_TOPGEN], 1u);
            else XB_SPIN(xb_ld(&bar[XB_TOPGEN]) == tg, bar);
            __builtin_amdgcn_fence(__ATOMIC_ACQUIRE, "agent");
            xb_add(&bar[XB_XGEN(b.x)], 1u);
            asm volatile("s_waitcnt vmcnt(0)" ::: "memory");
        } else {
            XB_SPIN(xb_ld(&bar[XB_XGEN(b.x)]) == gen, bar);
            __builtin_amdgcn_fence(__ATOMIC_ACQUIRE, "agent");
            asm volatile("s_waitcnt vmcnt(0)" ::: "memory");
        }
    }
    __syncthreads();
}


#define RUN_GEMM2(EpiT, epi, Aptr, Btptr, Mv, Nv, Kv, ldav, ldbv, cidx) do { const pg8::Gemm g_{(Aptr), (Btptr), (Mv), (Nv), (Kv), (ldav), (ldbv)}; pg8::StaticOrder so_; so_.init((Mv), (Nv), (int)gridDim.x, (cidx)); \
        pg8::gemm_phase<EpiT, pg8::StaticOrder, true, true>(lds, g_, so_, (epi)); } while (0)
#define RUN_GEMM(EpiT, epi, Aptr, Btptr, Mv, Nv, Kv, ldav, cidx) RUN_GEMM2(EpiT, epi, Aptr, Btptr, Mv, Nv, Kv, ldav, Kv, cidx)

__global__ void __launch_bounds__(512, 2) mega_fwd(Params p_unused) {
    extern __shared__ __attribute__((aligned(16))) unsigned char lds_raw[];
    LAS unsigned char* lds = (LAS unsigned char*)lds_raw;
    cg::grid_group grid = cg::this_grid();
    const size_t SD = (size_t)S_ * DM;
#define WSP(off) (KARGS()->ws + (off))
    LAS unsigned* bst = (LAS unsigned*)(lds + LDS_BYTES - 16);
    if (threadIdx.x < 4) bst[threadIdx.x] = 0u;
    __syncthreads();
    (void)xcd_barrier_post((unsigned*)(KARGS()->ws + WS_BAR), (volatile LAS unsigned*)bst);
#define GSYNC() do { XcdBarrier b_; b_.bar = (unsigned*)(KARGS()->ws + WS_BAR); b_.x = xb_xcc_id(); b_.st = (volatile LAS unsigned*)bst; xcd_barrier(b_); } while (0)
    prologue(KARGS(), lds);
    grid.sync();
#pragma nounroll
    for (int L = 0; L < 4; ++L) {
        const int bid = (int)blockIdx.x, G = (int)gridDim.x;
        if (L < 2) {
            { KP p = KARGS(); unsigned char* ws = p->ws; bf16_t* A0 = (bf16_t*)(ws + WS_A);
              EpiFoxQKV E{A0, (float*)(ws + WS_FLOG), p->in[I_FOXBF] + L * 16};
              RUN_GEMM(EpiFoxQKV, E, (const bf16_t*)(ws + WS_HBF), (const bf16_t*)(ws + WS_WFOXIN) + (size_t)L * NFOX * DM, S_, NFOX, DM, DM, bid); }
            GSYNC();
            scan_phase(KARGS(), lds, L == 0, L);
            GSYNC();
            fox_attn_phase(KARGS(), lds, L);
            GSYNC();
        } else {
            if (L == 2) {
                { KP p = KARGS(); unsigned char* ws = p->ws;
                  EpiKV E{(bf16_t*)(ws + WS_KV), (bf16_t*)(ws + WS_RAWK), (bf16_t*)(ws + WS_RAWV), (bf16_t*)(ws + WS_VT), (bf16_t*)(ws + WS_KF)};
                  RUN_GEMM(EpiKV, E, (const bf16_t*)(ws + WS_HBF), (const bf16_t*)(ws + WS_WKV), S_, NKV, DM, DM, bid); }
                GSYNC();
#pragma nounroll
                for (int idx = 0; idx < 16; ++idx) { KP p = KARGS(); unsigned char* ws = p->ws; const int mat = idx >> 3, ch = idx & 7;
                    EpiPart E{(float*)(ws + WS_CPART) + (size_t)idx * 4096 * 256};
                    RUN_GEMM2(EpiPart, E, (const bf16_t*)(ws + (mat ? WS_RAWV : WS_RAWK)) + ch * 512, (const bf16_t*)(ws + WS_WC1) + (size_t)mat * 256 * 4096 + ch * 512, 4096, 256, 512, 2048, 4096, (bid + G - 16 * idx) % G);
                }
                GSYNC();
                cmp2_phase(KARGS(), lds);
                GSYNC();
            }
            { KP p = KARGS(); unsigned char* ws = p->ws;
              EpiNsaQ E{(bf16_t*)(ws + WS_A), (float*)(ws + WS_GATE)};
              RUN_GEMM(EpiNsaQ, E, (const bf16_t*)(ws + WS_HBF), (const bf16_t*)(ws + WS_WNSAIN) + (size_t)(L - 2) * NNSA * DM, S_, NNSA, DM, DM, bid); }
            GSYNC();
            nsa_attn_phase(KARGS(), lds);
            GSYNC();
        }
        { KP p = KARGS(); unsigned char* ws = p->ws; bf16_t* A0 = (bf16_t*)(ws + WS_A);
          const float* hres = L == 0 ? p->in[I_X] : p->out;
          const bf16_t* attn = L < 2 ? A0 + 3 * SD : A0 + SD;
          const bf16_t* wo = L < 2 ? (const bf16_t*)(ws + WS_WFOXO) + (size_t)L * DM * DM : (const bf16_t*)(ws + WS_WNSAO) + (size_t)(L - 2) * DM * DM;
          EpiRes E{hres, (float*)(ws + WS_PRE)}; RUN_GEMM(EpiRes, E, attn, wo, S_, DM, DM, DM, bid); }
        GSYNC();
        { KP p = KARGS(); ln_phase((const float*)(p->ws + WS_PRE), p->in[I_LN1G] + L * DM, p->in[I_LN1B] + L * DM, p->out, (bf16_t*)(p->ws + WS_HBF)); }
        GSYNC();
        { KP p = KARGS(); unsigned char* ws = p->ws;
          EpiRelu2 E{(bf16_t*)(ws + WS_A)}; RUN_GEMM(EpiRelu2, E, (const bf16_t*)(ws + WS_HBF), (const bf16_t*)(ws + WS_W1) + (size_t)L * FF * DM, S_, FF, DM, DM, bid); }
        GSYNC();
        { KP p = KARGS(); unsigned char* ws = p->ws;
          EpiRes E{p->out, (float*)(ws + WS_PRE)}; RUN_GEMM(EpiRes, E, (const bf16_t*)(ws + WS_A), (const bf16_t*)(ws + WS_W2) + (size_t)L * DM * FF, S_, DM, FF, FF, bid); }
        GSYNC();
        { KP p = KARGS(); ln_phase((const float*)(p->ws + WS_PRE), p->in[I_LN2G] + L * DM, p->in[I_LN2B] + L * DM, p->out, (bf16_t*)(p->ws + WS_HBF)); }
        GSYNC();
    }
}

extern "C" void kernel_launch(void* const* d_in, const int* in_sizes, int n_in, void* d_out, int out_size, void* d_ws, size_t ws_size, hipStream_t stream) {
    static int grid = 0;
    if (grid == 0) {
        if (n_in != 20 || out_size != S_ * DM || ws_size < WS_END) { fprintf(stderr, "kernel_launch: unexpected shapes (n_in %d out %d ws %zu)\n", n_in, out_size, ws_size); grid = -1; return; }
        int dev = 0, cus = 0, per_cu = 0;
        (void)hipGetDevice(&dev); (void)hipDeviceGetAttribute(&cus, hipDeviceAttributeMultiprocessorCount, dev);
        if (hipFuncSetAttribute((const void*)mega_fwd, hipFuncAttributeMaxDynamicSharedMemorySize, LDS_BYTES) != hipSuccess) fprintf(stderr, "kernel_launch: hipFuncSetAttribute failed\n");
        if (hipOccupancyMaxActiveBlocksPerMultiprocessor(&per_cu, (const void*)mega_fwd, 512, LDS_BYTES) != hipSuccess || per_cu < 1) per_cu = 1;
        (void)hipGetLastError();
        if (cus <= 0) cus = 256;
        grid = cus * per_cu;
    }
    if (grid < 0) return;
    Params p{};
    for (int i = 0; i < 20; ++i) p.in[i] = (const float*)d_in[i];
    p.out = (float*)d_out; p.ws = (unsigned char*)d_ws;
    (void)hipMemsetAsync((unsigned char*)d_ws + WS_BAR, 0, 16384, stream);
    void* args[] = {&p};
    hipError_t e = hipLaunchCooperativeKernel((const void*)mega_fwd, dim3(grid), dim3(512), args, LDS_BYTES, stream);
    if (e != hipSuccess) fprintf(stderr, "kernel_launch: cooperative launch failed: %s (grid %d)\n", hipGetErrorString(e), grid);
}
```
